# Optimizing an MI355X kernel written in HIP

```python
import math
import jax, jax.numpy as jnp
from jax import lax
import numpy as np

D_MODEL = 1024
BATCH = 4
SEQ = 4096
DEPTH = 2

N_MIXERS = 2
GRID_W = 64
Q_BLOCK = 128
EPS = 1e-6

A_HEAD_DIM = 64
A_N_HEADS = D_MODEL // (2 * A_HEAD_DIM)
A_ROT = A_HEAD_DIM // 4
ROPE_THETA_1D = 500000.0

B_HEAD_DIM = 128
B_N_HEADS = D_MODEL // B_HEAD_DIM
B_N_KV = max(1, B_N_HEADS // 4)
B_GROUP = B_N_HEADS // B_N_KV
ROPE_THETA_AXIAL = 10000.0

D_FF = -(-8 * D_MODEL // (3 * 256)) * 256

N_A_LAYERS = (DEPTH + 1) // 2
N_B_LAYERS = DEPTH // 2

kernel_name = "hybrid_diffattn_axialgqa_adaln_encoder"


def rmsnorm(x, g):
    xf = x.astype(jnp.float32)
    y = xf * lax.rsqrt(jnp.mean(xf * xf, axis=-1, keepdims=True) + EPS)
    return (y * g.astype(jnp.float32)).astype(x.dtype)


def rope_angles(pos, dim, theta):
    half = dim // 2
    freqs = theta ** (-jnp.arange(half, dtype=jnp.float32) / half)
    ang = pos.astype(jnp.float32)[:, None] * freqs[None, :]
    return jnp.cos(ang), jnp.sin(ang)


def apply_rope(x, cos, sin):
    shape = (1, x.shape[1]) + (1,) * (x.ndim - 3) + (cos.shape[-1],)
    c = cos.reshape(shape).astype(x.dtype)
    s = sin.reshape(shape).astype(x.dtype)
    x1, x2 = jnp.split(x, 2, axis=-1)
    return jnp.concatenate([x1 * c - x2 * s, x2 * c + x1 * s], axis=-1)


def lambda_init_fn(layer_idx):
    return 0.8 - 0.6 * math.exp(-0.3 * layer_idx)


def diff_attention(h, w_qkv, w_o, lq1, lk1, lq2, lk2, subln_g, lam_init, cos, sin):
    B_, S, _ = h.shape
    qkv = h @ w_qkv
    q, k, v = jnp.split(qkv, 3, axis=-1)
    q = q.reshape(B_, S, A_N_HEADS, 2, A_HEAD_DIM)
    k = k.reshape(B_, S, A_N_HEADS, 2, A_HEAD_DIM)
    v = v.reshape(B_, S, A_N_HEADS, 2 * A_HEAD_DIM)
    q = jnp.concatenate([apply_rope(q[..., :A_ROT], cos, sin), q[..., A_ROT:]], axis=-1)
    k = jnp.concatenate([apply_rope(k[..., :A_ROT], cos, sin), k[..., A_ROT:]], axis=-1)
    q = q * (A_HEAD_DIM ** -0.5)
    lam = (jnp.exp(jnp.sum(lq1.astype(jnp.float32) * lk1.astype(jnp.float32)))
           - jnp.exp(jnp.sum(lq2.astype(jnp.float32) * lk2.astype(jnp.float32)))
           + lam_init)
    nb = S // Q_BLOCK
    qb = q.reshape(B_, nb, Q_BLOCK, A_N_HEADS, 2, A_HEAD_DIM).transpose(1, 0, 2, 3, 4, 5)

    def block(qi):
        s = jnp.einsum('bqhcd,bkhcd->bhcqk', qi, k).astype(jnp.float32)
        p = jax.nn.softmax(s, axis=-1)
        w = (p[:, :, 0] - lam * p[:, :, 1]).astype(v.dtype)
        return jnp.einsum('bhqk,bkhe->bqhe', w, v)

    o = lax.map(block, qb)
    o = o.transpose(1, 0, 2, 3, 4).reshape(B_, S, A_N_HEADS, 2 * A_HEAD_DIM)
    o = rmsnorm(o, subln_g) * (1.0 - lam_init)
    return o.reshape(B_, S, A_N_HEADS * 2 * A_HEAD_DIM) @ w_o


def axial_gqa(h, w_qkv, w_o, qnorm_g, knorm_g, cos_r, sin_r, cos_c, sin_c):
    B_, S, _ = h.shape
    qkv = h @ w_qkv
    nq = B_N_HEADS * B_HEAD_DIM
    nkv = B_N_KV * B_HEAD_DIM
    q = qkv[..., :nq].reshape(B_, S, B_N_HEADS, B_HEAD_DIM)
    k = qkv[..., nq:nq + nkv].reshape(B_, S, B_N_KV, B_HEAD_DIM)
    v = qkv[..., nq + nkv:].reshape(B_, S, B_N_KV, B_HEAD_DIM)
    q = rmsnorm(q, qnorm_g)
    k = rmsnorm(k, knorm_g)
    half = B_HEAD_DIM // 2
    q = jnp.concatenate([apply_rope(q[..., :half], cos_r, sin_r), apply_rope(q[..., half:], cos_c, sin_c)], axis=-1)
    k = jnp.concatenate([apply_rope(k[..., :half], cos_r, sin_r), apply_rope(k[..., half:], cos_c, sin_c)], axis=-1)
    q = (q * (B_HEAD_DIM ** -0.5)).reshape(B_, S, B_N_KV, B_GROUP, B_HEAD_DIM)
    nb = S // Q_BLOCK
    qb = q.reshape(B_, nb, Q_BLOCK, B_N_KV, B_GROUP, B_HEAD_DIM).transpose(1, 0, 2, 3, 4, 5)

    def block(qi):
        s = jnp.einsum('bqhgd,bkhd->bhgqk', qi, k).astype(jnp.float32)
        p = jax.nn.softmax(s, axis=-1).astype(v.dtype)
        return jnp.einsum('bhgqk,bkhd->bqhgd', p, v)

    o = lax.map(block, qb)
    o = o.transpose(1, 0, 2, 3, 4, 5).reshape(B_, S, nq)
    return o @ w_o


def swiglu(h, w_in, w_out):
    gate, up = jnp.split(h @ w_in, 2, axis=-1)
    return (jax.nn.silu(gate) * up) @ w_out


def setup_inputs(seed: int = 0) -> dict:
    key = jax.random.key(seed)
    ks = jax.random.split(key, 24)
    f32 = jnp.float32
    D = D_MODEL
    nrm = lambda k, shape, s: jax.random.normal(k, shape, f32) * s
    b_qkv_out = B_N_HEADS * B_HEAD_DIM + 2 * B_N_KV * B_HEAD_DIM
    return {
        "x": nrm(ks[0], (BATCH, SEQ, D), 1.0),
        "c": nrm(ks[1], (BATCH, D), 1.0),
        "ada_w": nrm(ks[2], (DEPTH, D, 6 * D), 0.5 * D ** -0.5),
        "ada_b": nrm(ks[3], (DEPTH, 6 * D), 0.01),
        "norm1_g": 1.0 + nrm(ks[4], (DEPTH, D), 0.02),
        "norm2_g": 1.0 + nrm(ks[5], (DEPTH, D), 0.02),
        "a_w_qkv": nrm(ks[6], (N_A_LAYERS, D, 3 * D), D ** -0.5),
        "a_w_o": nrm(ks[7], (N_A_LAYERS, D, D), D ** -0.5),
        "a_lam_q1": nrm(ks[8], (N_A_LAYERS, A_HEAD_DIM), 0.1),
        "a_lam_k1": nrm(ks[9], (N_A_LAYERS, A_HEAD_DIM), 0.1),
        "a_lam_q2": nrm(ks[10], (N_A_LAYERS, A_HEAD_DIM), 0.1),
        "a_lam_k2": nrm(ks[11], (N_A_LAYERS, A_HEAD_DIM), 0.1),
        "a_subln_g": 1.0 + nrm(ks[12], (N_A_LAYERS, 2 * A_HEAD_DIM), 0.02),
        "b_w_qkv": nrm(ks[13], (N_B_LAYERS, D, b_qkv_out), D ** -0.5),
        "b_w_o": nrm(ks[14], (N_B_LAYERS, B_N_HEADS * B_HEAD_DIM, D), (B_N_HEADS * B_HEAD_DIM) ** -0.5),
        "b_qnorm_g": 1.0 + nrm(ks[15], (N_B_LAYERS, B_HEAD_DIM), 0.02),
        "b_knorm_g": 1.0 + nrm(ks[16], (N_B_LAYERS, B_HEAD_DIM), 0.02),
        "f_w_in": nrm(ks[17], (DEPTH, D, 2 * D_FF), D ** -0.5),
        "f_w_out": nrm(ks[18], (DEPTH, D_FF, D), D_FF ** -0.5),
        "final_g": 1.0 + nrm(ks[19], (D,), 0.02),
    }


def reference(x, c, ada_w, ada_b, norm1_g, norm2_g, a_w_qkv, a_w_o, a_lam_q1, a_lam_k1,
              a_lam_q2, a_lam_k2, a_subln_g, b_w_qkv, b_w_o, b_qnorm_g, b_knorm_g,
              f_w_in, f_w_out, final_g):
    S = x.shape[1]
    rows = S // GRID_W
    t = jnp.arange(S, dtype=jnp.int32)
    row_pos = jnp.broadcast_to(jnp.arange(rows, dtype=jnp.int32)[:, None], (rows, GRID_W)).reshape(S)
    col_pos = jnp.broadcast_to(jnp.arange(GRID_W, dtype=jnp.int32)[None, :], (rows, GRID_W)).reshape(S)
    cos_a, sin_a = rope_angles(t, A_ROT, ROPE_THETA_1D)
    cos_r, sin_r = rope_angles(row_pos, B_HEAD_DIM // 2, ROPE_THETA_AXIAL)
    cos_c, sin_c = rope_angles(col_pos, B_HEAD_DIM // 2, ROPE_THETA_AXIAL)
    cond = jax.nn.silu(c)

    for i in range(DEPTH):
        mod = (cond @ ada_w[i] + ada_b[i])[:, None, :]
        shift1, scale1, gate1, shift2, scale2, gate2 = jnp.split(mod, 6, axis=-1)
        h = rmsnorm(x, norm1_g[i]) * (1.0 + scale1) + shift1
        j = i // N_MIXERS
        if i % N_MIXERS == 0:
            y = diff_attention(h, a_w_qkv[j], a_w_o[j], a_lam_q1[j], a_lam_k1[j],
                               a_lam_q2[j], a_lam_k2[j], a_subln_g[j],
                               lambda_init_fn(i), cos_a, sin_a)
        else:
            y = axial_gqa(h, b_w_qkv[j], b_w_o[j], b_qnorm_g[j], b_knorm_g[j],
                          cos_r, sin_r, cos_c, sin_c)
        x = x + gate1 * y
        h = rmsnorm(x, norm2_g[i]) * (1.0 + scale2) + shift2
        x = x + gate2 * swiglu(h, f_w_in[i], f_w_out[i])

    return rmsnorm(x, final_g)
```

```cpp
#include <hip/hip_runtime.h>
#include <hip/hip_bf16.h>
#include <cstdio>
#include <cstdint>
namespace pg8 {
#define PG8_LAS __attribute__((address_space(3)))
typedef unsigned short bf16_t;
typedef short bf16x8 __attribute__((ext_vector_type(8)));
typedef float f32x4 __attribute__((ext_vector_type(4)));
typedef unsigned u32x4 __attribute__((ext_vector_type(4)));
constexpr int BM = 256, BK = 64, HALF = 128, HTB = HALF * BK * 2  , STAGE_BYTES = 8 * HTB, NXCD = 8, WGM = 8;

__host__ __device__ __forceinline__ int lds_byte(int r, int c) { const int st = (r >> 4) * 2 + (c >> 5), rr = r & 15, cc = c & 31, ob = rr * 64 + cc * 2; return st * 1024 + (ob ^ (((ob >> 9) & 1) << 5)); }
__host__ __device__ __forceinline__ void stage_rc(int b, int& R, int& C) { const int st = b / 1024, sb = b % 1024, swz = sb ^ (((sb >> 9) & 1) << 5); R = (st >> 1) * 16 + swz / 64; C = (st & 1) * 32 + (swz % 64) / 2; }
__host__ __device__ __forceinline__ int perm32(int rho) { const int n = rho >> 4, i = rho & 15; return 8 * (i >> 2) + 4 * n + (i & 3); }

struct Unit { int pm, pn; };
struct Gemm { const bf16_t* A; const bf16_t* Bt; int M, N, K; };

struct StaticOrder {
    int nM, nN, nwg, G, c;
    __host__ __device__ void init(int M, int N, int G_, int c_) { nM = M / BM; nN = N / BM; nwg = nM * nN; G = G_; c = c_; }
    __host__ __device__ bool next(int i, Unit& u) const {
        const long L = (long)i * G + c; if (L >= nwg) return false;
        int wgid = (int)L; { const int q = nwg / NXCD, r = nwg % NXCD, xcd = wgid % NXCD, off = wgid / NXCD; wgid = (xcd < r ? xcd * (q + 1) : r * (q + 1) + (xcd - r) * q) + off; }
        const int nig = WGM * nN, gid = wgid / nig, fm = gid * WGM, gsz = (nM - fm) < WGM ? (nM - fm) : WGM;
        u.pm = fm + ((wgid % nig) % gsz); u.pn = (wgid % nig) / gsz; return true;
    }
    __device__ __forceinline__ void a_ready(const Unit&) const {}
    __device__ __forceinline__ void done(const Unit&) const {}
};


__device__ __forceinline__ unsigned cvt_pk_bf16(float lo, float hi) { unsigned r; asm volatile("v_cvt_pk_bf16_f32 %0, %1, %2" : "=v"(r) : "v"(lo), "v"(hi)); return r; }
constexpr int SEQ_ = 4096, DM_ = 1024, MODW_ = 6144;
constexpr float EPS_ = 1e-6f;

__device__ __forceinline__ void rot4(f32x4& v0, f32x4& v1, const f32x4 c, const f32x4 s) {
    f32x4 r0, r1;
    r0[0] = v0[0] * c[0] - v0[1] * s[0]; r0[1] = v0[1] * c[0] + v0[0] * s[0]; r0[2] = v0[2] * c[1] - v0[3] * s[1]; r0[3] = v0[3] * c[1] + v0[2] * s[1];
    r1[0] = v1[0] * c[2] - v1[1] * s[2]; r1[1] = v1[1] * c[2] + v1[0] * s[2]; r1[2] = v1[2] * c[3] - v1[3] * s[3]; r1[3] = v1[3] * c[3] + v1[2] * s[3];
    v0 = r0; v1 = r1;
}

struct EpiQkvA {
    static constexpr bool PERM = true, AFTER_DRAIN = false;
    bf16_t* Q; size_t tstride; const float* cs;
    __device__ __forceinline__ void operator()(const f32x4 (&acc)[2][2][4][2], const Unit& u, int wr, int wc, int fr, int fq) const {
        const int t3 = u.pn >> 2; bf16_t* base = Q + (size_t)t3 * tstride;
        const int col0 = (u.pn & 3) * BM + wc * 32 + 8 * fq, row0 = u.pm * BM + wr * 64 + fr;
        const bool rope = (t3 < 2) && ((wc & 1) == 0) && (fq < 2);
#pragma unroll
        for (int ai = 0; ai < 2; ++ai)
#pragma unroll
            for (int m = 0; m < 4; ++m) { const int row = row0 + ai * HALF + m * 16, t = row & (SEQ_ - 1);
                f32x4 cv = (f32x4){1.f, 1.f, 1.f, 1.f}, sv = (f32x4){0.f, 0.f, 0.f, 0.f};
                if (rope) { cv = *(const f32x4*)(cs + t * 16 + 4 * fq); sv = *(const f32x4*)(cs + t * 16 + 8 + 4 * fq); }
                bf16_t* rowp = base + (size_t)row * DM_ + col0;
#pragma unroll
                for (int bj = 0; bj < 2; ++bj) { f32x4 v0 = acc[ai][bj][m][0], v1 = acc[ai][bj][m][1];
                    rot4(v0, v1, cv, sv);
                    u32x4 w; w.x = cvt_pk_bf16(v0[0], v0[1]); w.y = cvt_pk_bf16(v0[2], v0[3]); w.z = cvt_pk_bf16(v1[0], v1[1]); w.w = cvt_pk_bf16(v1[2], v1[3]);
                    *(u32x4*)(rowp + bj * HALF) = w; } }
    }
};

struct EpiQkvB {
    static constexpr bool PERM = true, AFTER_DRAIN = false;
    bf16_t* Q; size_t tstride; const float* gtab; const float* cs2;
    PG8_LAS float* scr;
    __device__ __forceinline__ void operator()(const f32x4 (&acc)[2][2][4][2], const Unit& u, int wr, int wc, int fr, int fq) const {
        const int pn = u.pn; const bool nrm = pn < 5;
        bf16_t* base = Q + (size_t)(pn < 4 ? 0 : pn - 3) * tstride; const int ld = pn < 4 ? DM_ : 256; const float* g = gtab + (pn < 4 ? 0 : 128);
        const int col0 = (pn < 4 ? pn * BM : 0) + wc * 32 + 8 * fq, row0 = u.pm * BM + wr * 64 + fr;
        if (nrm) {
#pragma unroll
            for (int ai = 0; ai < 2; ++ai)
#pragma unroll
                for (int m = 0; m < 4; ++m)
#pragma unroll
                    for (int bj = 0; bj < 2; ++bj) { const f32x4 a = acc[ai][bj][m][0], b = acc[ai][bj][m][1];
                        float ss = (a[0] * a[0] + a[1] * a[1]) + (a[2] * a[2] + a[3] * a[3]) + (b[0] * b[0] + b[1] * b[1]) + (b[2] * b[2] + b[3] * b[3]);
                        ss += __shfl_xor(ss, 16); ss += __shfl_xor(ss, 32);
                        if (fq == 0) scr[((ai * HALF + wr * 64 + m * 16 + fr) * 2 + bj) * 4 + wc] = ss; }
            asm volatile("s_waitcnt lgkmcnt(0)" ::: "memory"); __builtin_amdgcn_s_barrier(); asm volatile("" ::: "memory");
        }
        const int f0 = 16 * (wc & 1) + 4 * fq, d1 = (wc < 2 ? 16 * wc : 16 * wc + 32) + 4 * fq;
        f32x4 g1 = (f32x4){1.f, 1.f, 1.f, 1.f}, g2 = g1;
        if (nrm) { g1 = *(const f32x4*)(g + d1); g2 = *(const f32x4*)(g + d1 + 32); }
#pragma unroll
        for (int ai = 0; ai < 2; ++ai)
#pragma unroll
            for (int m = 0; m < 4; ++m) { const int row = row0 + ai * HALF + m * 16, t = row & (SEQ_ - 1), pos = wc < 2 ? (t >> 6) : (t & 63);
                f32x4 cv = (f32x4){1.f, 1.f, 1.f, 1.f}, sv = (f32x4){0.f, 0.f, 0.f, 0.f};
                if (nrm) { cv = *(const f32x4*)(cs2 + pos * 64 + f0); sv = *(const f32x4*)(cs2 + pos * 64 + 32 + f0); }
                bf16_t* rowp = base + (size_t)row * ld + col0;
#pragma unroll
                for (int bj = 0; bj < 2; ++bj) { f32x4 v0 = acc[ai][bj][m][0], v1 = acc[ai][bj][m][1];
                    if (nrm) { const f32x4 p = *(const PG8_LAS f32x4*)(scr + ((ai * HALF + wr * 64 + m * 16 + fr) * 2 + bj) * 4);
                        const float rs = __builtin_amdgcn_rsqf(((p[0] + p[1]) + (p[2] + p[3])) * (1.0f / 128.0f) + EPS_);
                        v0[0] *= rs * g1[0]; v0[1] *= rs * g2[0]; v0[2] *= rs * g1[1]; v0[3] *= rs * g2[1]; v1[0] *= rs * g1[2]; v1[1] *= rs * g2[2]; v1[2] *= rs * g1[3]; v1[3] *= rs * g2[3];
                        rot4(v0, v1, cv, sv); }
                    u32x4 w; w.x = cvt_pk_bf16(v0[0], v0[1]); w.y = cvt_pk_bf16(v0[2], v0[3]); w.z = cvt_pk_bf16(v1[0], v1[1]); w.w = cvt_pk_bf16(v1[2], v1[3]);
                    *(u32x4*)(rowp + bj * HALF) = w; } }
    }
};

struct EpiResid {
    static constexpr bool PERM = false, AFTER_DRAIN = false;
    const float* base; float* out; const float* gate;
    __device__ __forceinline__ void operator()(const f32x4 (&acc)[2][2][4][2], const Unit& u, int wr, int wc, int fr, int fq) const {
        const int col0 = u.pn * BM + wc * 32 + 4 * fq, row0 = u.pm * BM + wr * 64 + fr, b = (u.pm * BM) / SEQ_;
        f32x4 gv[2][2];
#pragma unroll
        for (int bj = 0; bj < 2; ++bj)
#pragma unroll
            for (int n = 0; n < 2; ++n) gv[bj][n] = *(const f32x4*)(gate + b * MODW_ + col0 + bj * HALF + n * 16);
#pragma unroll
        for (int ai = 0; ai < 2; ++ai)
#pragma unroll
            for (int m = 0; m < 4; ++m) { const size_t off = (size_t)(row0 + ai * HALF + m * 16) * DM_ + col0;
#pragma unroll
                for (int bj = 0; bj < 2; ++bj)
#pragma unroll
                    for (int n = 0; n < 2; ++n) { const f32x4 bs = *(const f32x4*)(base + off + bj * HALF + n * 16); *(f32x4*)(out + off + bj * HALF + n * 16) = bs + gv[bj][n] * acc[ai][bj][m][n]; }
                if (m & 1) asm volatile("" ::: "memory"); }
    }
};

struct EpiSwiglu {
    static constexpr bool PERM = true, AFTER_DRAIN = false;
    bf16_t* O; int ldo;
    __device__ __forceinline__ static float sw(float g, float up) { return g * __builtin_amdgcn_rcpf(1.0f + __builtin_amdgcn_exp2f(g * -1.4426950408889634f)) * up; }
    __device__ __forceinline__ void operator()(const f32x4 (&acc)[2][2][4][2], const Unit& u, int wr, int wc, int fr, int fq) const {
        const int col0 = u.pn * HALF + wc * 32 + 8 * fq, row0 = u.pm * BM + wr * 64 + fr;
#pragma unroll
        for (int ai = 0; ai < 2; ++ai)
#pragma unroll
            for (int m = 0; m < 4; ++m) { const f32x4 g0 = acc[ai][0][m][0], g1 = acc[ai][0][m][1], u0 = acc[ai][1][m][0], u1 = acc[ai][1][m][1];
                u32x4 w; w.x = cvt_pk_bf16(sw(g0[0], u0[0]), sw(g0[1], u0[1])); w.y = cvt_pk_bf16(sw(g0[2], u0[2]), sw(g0[3], u0[3]));
                w.z = cvt_pk_bf16(sw(g1[0], u1[0]), sw(g1[1], u1[1])); w.w = cvt_pk_bf16(sw(g1[2], u1[2]), sw(g1[3], u1[3]));
                *(u32x4*)(O + (size_t)(row0 + ai * HALF + m * 16) * ldo + col0) = w; }
    }
};

template <class Epi, class Sched, bool ALIGN_EPI = false, bool SP2 = false>
__device__ __forceinline__ void gemm_phase(PG8_LAS unsigned char* lds, const Gemm g, const Sched& S, const Epi& E) {
    int tid_ = threadIdx.x; asm volatile("" : "+v"(tid_));
    const int tid = tid_, wid = __builtin_amdgcn_readfirstlane(tid >> 6), lane = tid & 63, wr = wid >> 2, wc = wid & 3, fr = lane & 15, fq = lane >> 4;
    const int K = g.K, nt = K / BK;
    unsigned voffA[2], voffB[2];
#pragma unroll
    for (int i = 0; i < 2; ++i) { int R, C; stage_rc(tid * 16 + i * 8192, R, C); const int Rb = Epi::PERM ? ((R & ~31) + perm32(R & 31)) : R;
        voffA[i] = (unsigned)(R * K + C) * 2u; voffB[i] = (unsigned)(Rb * K + C) * 2u; }
    const size_t kstep = (size_t)(BK * 2);
    const size_t hstep = (size_t)HALF * K * 2;
    const size_t tstep = 2 * hstep;
    const unsigned ldsw = (unsigned)wid * 1024u;
    const int aoff = lds_byte(wr * 64 + fr, fq * 8), boff = lds_byte(wc * 32 + fr, fq * 8);
#define PG8_SA(b, h) (((b) * 2 + (h)) * HTB)
#define PG8_SB(b, h) ((4 + (b) * 2 + (h)) * HTB)
#define PG8_STAGE(bufoff, gbase, voff) do { _Pragma("unroll") for (int _i = 0; _i < 2; ++_i) \
        __builtin_amdgcn_global_load_lds((const unsigned*)((const char*)(gbase) + (voff)[_i]), (PG8_LAS unsigned*)(lds + (bufoff) + ldsw + _i * 8192), 16, 0, 0); } while (0)
#define PG8_LDA(dst, b, h) do { _Pragma("unroll") for (int m = 0; m < 4; ++m) _Pragma("unroll") for (int k = 0; k < 2; ++k) dst[m][k] = *(const PG8_LAS bf16x8*)(lds + PG8_SA(b, h) + aoff + m * 2048 + k * 1024); } while (0)
#define PG8_LDB(dst, b, h) do { _Pragma("unroll") for (int n = 0; n < 2; ++n) _Pragma("unroll") for (int k = 0; k < 2; ++k) dst[n][k] = *(const PG8_LAS bf16x8*)(lds + PG8_SB(b, h) + boff + n * 2048 + k * 1024); } while (0)
#define PG8_MMA(ai, bj, At, Bt) do { __builtin_amdgcn_s_setprio(1); _Pragma("unroll") for (int m = 0; m < 4; ++m) _Pragma("unroll") for (int n = 0; n < 2; ++n) _Pragma("unroll") for (int k = 0; k < 2; ++k) \
        acc[ai][bj][m][n] = __builtin_amdgcn_mfma_f32_16x16x32_bf16(Bt[n][k], At[m][k], acc[ai][bj][m][n], 0, 0, 0); __builtin_amdgcn_s_setprio(0); } while (0)
#define PG8_WAIT_V(n) asm volatile("s_waitcnt vmcnt(" #n ")" ::: "memory")
#define PG8_WAIT_L(n) asm volatile("s_waitcnt lgkmcnt(" #n ")" ::: "memory")
#define PG8_BAR __builtin_amdgcn_s_barrier()
#define PG8_SCHED __builtin_amdgcn_sched_barrier(0)
    Unit cur, nxt; int ui = 0;
    if (!S.next(0, cur)) return;
    f32x4 acc[2][2][4][2];
#pragma unroll
    for (int a = 0; a < 2; ++a)
#pragma unroll
        for (int b = 0; b < 2; ++b)
#pragma unroll
            for (int m = 0; m < 4; ++m)
#pragma unroll
                for (int n = 0; n < 2; ++n) acc[a][b][m][n] = (f32x4){0.f, 0.f, 0.f, 0.f};
    bf16x8 At[4][2], B0[2][2], B1[2][2];
    const char* cA = (const char*)g.A + (size_t)cur.pm * tstep; const char* cB = (const char*)g.Bt + (size_t)cur.pn * tstep;
    S.a_ready(cur);
    if constexpr (SP2) {
        PG8_STAGE(PG8_SB(0, 0), cB, voffB); PG8_STAGE(PG8_SB(0, 1), cB + hstep, voffB); PG8_STAGE(PG8_SA(0, 0), cA, voffA); PG8_STAGE(PG8_SA(0, 1), cA + hstep, voffA);
        if (wr == 1) PG8_BAR;
        PG8_WAIT_V(2); PG8_BAR;
        PG8_STAGE(PG8_SB(1, 0), cB + kstep, voffB); PG8_STAGE(PG8_SA(1, 0), cA + kstep, voffA); PG8_STAGE(PG8_SB(1, 1), cB + hstep + kstep, voffB);
        PG8_WAIT_V(6); PG8_BAR;
    } else {
        PG8_STAGE(PG8_SB(0, 0), cB, voffB); PG8_STAGE(PG8_SA(0, 0), cA, voffA); PG8_STAGE(PG8_SB(0, 1), cB + hstep, voffB); PG8_STAGE(PG8_SA(0, 1), cA + hstep, voffA);
        if (wr == 1) PG8_BAR;
        PG8_WAIT_V(4); PG8_BAR;
        PG8_STAGE(PG8_SB(1, 0), cB + kstep, voffB); PG8_STAGE(PG8_SA(1, 0), cA + kstep, voffA); PG8_STAGE(PG8_SB(1, 1), cB + hstep + kstep, voffB);
        PG8_WAIT_V(6); PG8_BAR;
    }
    for (;;) {
        const bool has_next = S.next(ui + 1, nxt);
        const char* nA = has_next ? (const char*)g.A + (size_t)nxt.pm * tstep : cA; const char* nB = has_next ? (const char*)g.Bt + (size_t)nxt.pn * tstep : cB;
        for (int t = 0; t < nt; t += 2) {
            const bool last = (t == nt - 2);
            const char* a1 = cA + (size_t)(t + 1) * kstep;
            const char* a2 = last ? nA : cA + (size_t)(t + 2) * kstep; const char* b2 = last ? nB : cB + (size_t)(t + 2) * kstep;
            const char* a3 = a2 + kstep; const char* b3 = b2 + kstep;
            if (last && has_next) S.a_ready(nxt);
            if constexpr (SP2) {
            PG8_LDB(B0, 0, 0); PG8_LDB(B1, 0, 1); PG8_SCHED; PG8_LDA(At, 0, 0); PG8_STAGE(PG8_SA(1, 1), a1 + hstep, voffA);
            PG8_WAIT_V(8); PG8_WAIT_L(0); PG8_BAR; PG8_MMA(0, 0, At, B0); PG8_MMA(0, 1, At, B1); PG8_BAR; PG8_SCHED;
            PG8_LDA(At, 0, 1); PG8_STAGE(PG8_SB(0, 0), b2, voffB); PG8_STAGE(PG8_SB(0, 1), b2 + hstep, voffB); PG8_STAGE(PG8_SA(0, 0), a2, voffA);
            PG8_WAIT_V(8); PG8_WAIT_L(0); PG8_BAR; PG8_MMA(1, 0, At, B0); PG8_MMA(1, 1, At, B1); PG8_BAR; PG8_SCHED;
            PG8_LDB(B0, 1, 0); PG8_LDB(B1, 1, 1); PG8_SCHED; PG8_LDA(At, 1, 0); PG8_STAGE(PG8_SA(0, 1), a2 + hstep, voffA);
            PG8_WAIT_V(8); PG8_WAIT_L(0); PG8_BAR; PG8_MMA(0, 0, At, B0); PG8_MMA(0, 1, At, B1); PG8_BAR; PG8_SCHED;
            PG8_LDA(At, 1, 1); PG8_STAGE(PG8_SB(1, 0), b3, voffB); PG8_STAGE(PG8_SB(1, 1), b3 + hstep, voffB); PG8_STAGE(PG8_SA(1, 0), a3, voffA);
            PG8_WAIT_V(8); PG8_WAIT_L(0); PG8_BAR; PG8_MMA(1, 0, At, B0); PG8_MMA(1, 1, At, B1); PG8_BAR; PG8_SCHED;
            } else {
            PG8_LDB(B0, 0, 0); PG8_SCHED; PG8_LDA(At, 0, 0); PG8_STAGE(PG8_SA(1, 1), a1 + hstep, voffA);
            PG8_WAIT_L(8); PG8_BAR; PG8_WAIT_L(0); PG8_MMA(0, 0, At, B0); PG8_BAR; PG8_SCHED;
            PG8_LDB(B1, 0, 1); PG8_STAGE(PG8_SB(0, 0), b2, voffB);
            PG8_BAR; PG8_WAIT_L(0); PG8_MMA(0, 1, At, B1); PG8_BAR;
            PG8_LDA(At, 0, 1); PG8_STAGE(PG8_SA(0, 0), a2, voffA);
            PG8_BAR; PG8_WAIT_L(0); PG8_MMA(1, 0, At, B0); PG8_BAR; PG8_SCHED;
            PG8_STAGE(PG8_SB(0, 1), b2 + hstep, voffB);
            PG8_WAIT_V(6); PG8_BAR; PG8_MMA(1, 1, At, B1); PG8_BAR;
            PG8_LDB(B0, 1, 0); PG8_SCHED; PG8_LDA(At, 1, 0); PG8_STAGE(PG8_SA(0, 1), a2 + hstep, voffA);
            PG8_WAIT_L(8); PG8_BAR; PG8_WAIT_L(0); PG8_MMA(0, 0, At, B0); PG8_BAR; PG8_SCHED;
            PG8_LDB(B1, 1, 1); PG8_STAGE(PG8_SB(1, 0), b3, voffB);
            PG8_BAR; PG8_WAIT_L(0); PG8_MMA(0, 1, At, B1); PG8_BAR;
            PG8_LDA(At, 1, 1); PG8_STAGE(PG8_SA(1, 0), a3, voffA);
            PG8_BAR; PG8_WAIT_L(0); PG8_MMA(1, 0, At, B0); PG8_BAR; PG8_SCHED;
            PG8_STAGE(PG8_SB(1, 1), b3 + hstep, voffB);
            PG8_WAIT_V(6); PG8_BAR; PG8_MMA(1, 1, At, B1); PG8_BAR;
            }
        }
        if constexpr (ALIGN_EPI) { if (wr == 0) PG8_BAR; }
        if constexpr (!Epi::AFTER_DRAIN) { E(acc, cur, wr, wc, fr, fq); S.done(cur); }
        if (!has_next) break;
#pragma unroll
        for (int a = 0; a < 2; ++a)
#pragma unroll
            for (int b = 0; b < 2; ++b)
#pragma unroll
                for (int m = 0; m < 4; ++m)
#pragma unroll
                    for (int n = 0; n < 2; ++n) acc[a][b][m][n] = (f32x4){0.f, 0.f, 0.f, 0.f};
        cur = nxt; cA = nA; cB = nB; ++ui;
        if constexpr (ALIGN_EPI) { if (wr == 1) PG8_BAR; }
    }
    PG8_WAIT_V(0);
    if constexpr (!ALIGN_EPI) { if (wr == 0) PG8_BAR; }
    PG8_BAR;
    if constexpr (Epi::AFTER_DRAIN) { E.fused(acc, cur, wr, wc, fr, fq, lds, wid, lane); S.done(cur); }
#undef PG8_SA
#undef PG8_SB
#undef PG8_STAGE
#undef PG8_LDA
#undef PG8_LDB
#undef PG8_MMA
#undef PG8_WAIT_V
#undef PG8_WAIT_L
#undef PG8_BAR
#undef PG8_SCHED
}
}

namespace att {
#define ATT_LAS __attribute__((address_space(3)))
typedef unsigned short bf16_t;
using bf16x8 = __attribute__((ext_vector_type(8))) short;
using s16x4  = __attribute__((ext_vector_type(4))) short;
using f32x16 = __attribute__((ext_vector_type(16))) float;
using u32x4  = __attribute__((ext_vector_type(4))) unsigned;
using f32x4v = __attribute__((ext_vector_type(4))) float;
constexpr int NW = 8, QBLK = 32, KVBLK = 64, DV = 128, LDQ = 1024, SEQ = 4096;
constexpr int SHM_V = KVBLK * DV * 2, SHM_K = 16384;
constexpr int LDS_V = 0, LDS_K = 2 * SHM_V, LDS_WS = 2 * SHM_V + 2 * SHM_K, LDS_BYTES = LDS_WS + NW * 64 * 4;
#define ATT_SBAR() __builtin_amdgcn_sched_barrier(0)
__device__ __forceinline__ int crow(int r, int hi) { return (r & 3) + 8 * (r >> 2) + 4 * hi; }
__device__ __forceinline__ unsigned cvtpk(float lo, float hi) { unsigned r; asm volatile("v_cvt_pk_bf16_f32 %0, %1, %2" : "=v"(r) : "v"(lo), "v"(hi)); return r; }
template <int DQK> __device__ __forceinline__ int kswz(int row, int colB) {
  if constexpr (DQK == 128) return row * 256 + (colB ^ ((row & 7) << 4));
  else return row * 128 + (colB ^ (((row >> 1) & 7) << 4));
}
__device__ __forceinline__ void partialSM(f32x16& p0, f32x16& p1, float& m_reg, float& mn, float& alpha, const float C, const float thr_raw) {
  float pmax = p0[0];
#pragma unroll
  for (int r = 1; r < 16; ++r) pmax = fmaxf(pmax, p0[r]);
#pragma unroll
  for (int r = 0; r < 16; ++r) pmax = fmaxf(pmax, p1[r]);
  { auto rr = __builtin_amdgcn_permlane32_swap(__float_as_uint(pmax), __float_as_uint(pmax), false, false);
    pmax = fmaxf(__uint_as_float(rr[0]), __uint_as_float(rr[1])); }
  if (__builtin_expect(__all(pmax - m_reg <= thr_raw), 1)) { mn = m_reg; alpha = 1.f; }
  else { mn = fmaxf(m_reg, pmax); alpha = __builtin_amdgcn_exp2f((m_reg - mn) * C); m_reg = mn; }
  const float mnC = -mn * C;
#pragma unroll
  for (int r = 0; r < 16; ++r) p0[r] = fmaf(p0[r], C, mnC);
#pragma unroll
  for (int r = 0; r < 16; ++r) p1[r] = fmaf(p1[r], C, mnC);
#pragma unroll
  for (int r = 0; r < 16; ++r) p0[r] = __builtin_amdgcn_exp2f(p0[r]);
}
__device__ __forceinline__ void finishSM(f32x16& p0, f32x16& p1, float alpha, float& l_reg, bf16x8& pa0, bf16x8& pa1, bf16x8& pa2, bf16x8& pa3) {
#pragma unroll
  for (int r = 0; r < 16; ++r) p1[r] = __builtin_amdgcn_exp2f(p1[r]);
  float ps = 0;
#pragma unroll
  for (int r = 0; r < 16; ++r) ps += p0[r];
#pragma unroll
  for (int r = 0; r < 16; ++r) ps += p1[r];
  { auto rr = __builtin_amdgcn_permlane32_swap(__float_as_uint(ps), __float_as_uint(ps), false, false);
    ps = __uint_as_float(rr[0]) + __uint_as_float(rr[1]); }
  l_reg = l_reg * alpha + ps;
#define ATT_PK4(P, BASE, OUT) do { unsigned a0 = cvtpk(P[BASE + 0], P[BASE + 1]), a1 = cvtpk(P[BASE + 2], P[BASE + 3]);   \
    unsigned b0 = cvtpk(P[BASE + 4], P[BASE + 5]), b1 = cvtpk(P[BASE + 6], P[BASE + 7]);                              \
    auto r0 = __builtin_amdgcn_permlane32_swap(a0, b0, false, false); auto r1 = __builtin_amdgcn_permlane32_swap(a1, b1, false, false); \
    u32x4 w = {r0[0], r1[0], r0[1], r1[1]}; OUT = __builtin_bit_cast(bf16x8, w); } while (0)
  ATT_PK4(p0, 0, pa0); ATT_PK4(p0, 8, pa1); ATT_PK4(p1, 0, pa2); ATT_PK4(p1, 8, pa3);
#undef ATT_PK4
}
template <int DQK> __device__ __forceinline__ void qkt(f32x16& p0, f32x16& p1, const ATT_LAS char* Ks, const bf16x8* qr, int r32, int hi) {
  p0 = f32x16{}; p1 = f32x16{};
#pragma unroll
  for (int d0 = 0; d0 < DQK / 16; ++d0) { const int cb = (d0 * 16 + hi * 8) * 2;
    const bf16x8 b0 = *reinterpret_cast<const ATT_LAS bf16x8*>(Ks + kswz<DQK>(r32, cb));
    const bf16x8 b1 = *reinterpret_cast<const ATT_LAS bf16x8*>(Ks + kswz<DQK>(32 + r32, cb));
    p0 = __builtin_amdgcn_mfma_f32_32x32x16_bf16(b0, qr[d0], p0, 0, 0, 0);
    p1 = __builtin_amdgcn_mfma_f32_32x32x16_bf16(b1, qr[d0], p1, 0, 0, 0); }
}
__device__ __forceinline__ int v_st(int k, int c) { const int kk = (k & ~0xC) | ((k & 4) << 1) | ((k & 8) >> 1); return ((kk >> 3) * 4 + (c >> 5)) * 512 + ((kk & 7) * 32 + (c & 31)) * 2; }
__device__ __forceinline__ int v_rd_base(int lane) { return ((lane & 3) << 3) | (((lane >> 2) & 3) << 6) | (((lane >> 4) & 1) << 5) | (((lane >> 5) & 1) << 8); }
constexpr int v_rd_off(int d0, int ks, int half) { return d0 * 512 + ks * 4096 + half * 2048; }
template <int OFF> __device__ __forceinline__ s16x4 tr_read(int vb) {
  s16x4 r; asm volatile("ds_read_b64_tr_b16 %0, %1 offset:%2" : "=&v"(r) : "v"(vb), "i"(OFF) : "memory"); return r;
}
template <int D0> __device__ __forceinline__ void pv_one(f32x16& od, int vb, bf16x8 pa0, bf16x8 pa1, bf16x8 pa2, bf16x8 pa3) {
  const s16x4 l0 = tr_read<v_rd_off(D0, 0, 0)>(vb), h0 = tr_read<v_rd_off(D0, 0, 1)>(vb), l1 = tr_read<v_rd_off(D0, 1, 0)>(vb), h1 = tr_read<v_rd_off(D0, 1, 1)>(vb);
  const s16x4 l2 = tr_read<v_rd_off(D0, 2, 0)>(vb), h2 = tr_read<v_rd_off(D0, 2, 1)>(vb), l3 = tr_read<v_rd_off(D0, 3, 0)>(vb), h3 = tr_read<v_rd_off(D0, 3, 1)>(vb);
  asm volatile("s_waitcnt lgkmcnt(0)" ::: "memory"); ATT_SBAR();
#define ATT_PK(L, H) (bf16x8){L[0], L[1], L[2], L[3], H[0], H[1], H[2], H[3]}
  od = __builtin_amdgcn_mfma_f32_32x32x16_bf16(pa0, ATT_PK(l0, h0), od, 0, 0, 0);
  od = __builtin_amdgcn_mfma_f32_32x32x16_bf16(pa1, ATT_PK(l1, h1), od, 0, 0, 0);
  od = __builtin_amdgcn_mfma_f32_32x32x16_bf16(pa2, ATT_PK(l2, h2), od, 0, 0, 0);
  od = __builtin_amdgcn_mfma_f32_32x32x16_bf16(pa3, ATT_PK(l3, h3), od, 0, 0, 0);
#undef ATT_PK
}
__device__ __forceinline__ void pv_d0(f32x16* o, int vb, bf16x8 pa0, bf16x8 pa1, bf16x8 pa2, bf16x8 pa3) {
  pv_one<0>(o[0], vb, pa0, pa1, pa2, pa3); pv_one<1>(o[1], vb, pa0, pa1, pa2, pa3); pv_one<2>(o[2], vb, pa0, pa1, pa2, pa3); pv_one<3>(o[3], vb, pa0, pa1, pa2, pa3);
}

template <int DQK, int LDKV>
__device__ __forceinline__ void attn_core(const bf16_t* Qb, const bf16_t* Kh, const bf16_t* Vh, ATT_LAS char* lds, const float C, f32x16 (&o)[4]) {
  int tid_ = threadIdx.x; asm volatile("" : "+v"(tid_));
  const int tid = tid_, lane = tid & 63, r32 = lane & 31, hi = lane >> 5; const int wid = __builtin_amdgcn_readfirstlane(tid >> 6);
  ATT_LAS char* V_lds = lds + LDS_V; ATT_LAS char* K_lds = lds + LDS_K;
  ATT_LAS float* ws = (ATT_LAS float*)(lds + LDS_WS) + wid * 64; ATT_LAS float* li_l = ws; ATT_LAS float* al_l = ws + 32;
  const float thr_raw = 8.0f * 1.4426950408889634f / C;
  float m_reg = -1e30f, l_reg = 0;
#pragma unroll
  for (int d = 0; d < 4; ++d) o[d] = f32x16{};
  bf16x8 qr[DQK / 16];
  const bf16_t* Qw = Qb + (long)(wid * QBLK + r32) * LDQ + hi * 8;
#pragma unroll
  for (int d0 = 0; d0 < DQK / 16; ++d0) qr[d0] = *reinterpret_cast<const bf16x8*>(Qw + d0 * 16);
  const int sr = tid >> 4, sc = (tid & 15) * 8, vst0 = v_st(sr, sc), vst1 = v_st(32 + sr, sc);
  const int kr = tid >> 3, kc = (tid & 7) * 8;
  const int vb0 = (int)(size_t)V_lds + v_rd_base(lane);
  struct Slot { bf16x8 vs0, vs1, ks0, ks1; } s0_, s1_;
#define ATT_SLOAD(S, k0) do { S.vs0 = *reinterpret_cast<const bf16x8*>(&Vh[(long)((k0) + sr) * LDKV + sc]); S.vs1 = *reinterpret_cast<const bf16x8*>(&Vh[(long)((k0) + 32 + sr) * LDKV + sc]); \
    if constexpr (DQK == 128) { S.ks0 = *reinterpret_cast<const bf16x8*>(&Kh[(long)((k0) + sr) * LDKV + sc]); S.ks1 = *reinterpret_cast<const bf16x8*>(&Kh[(long)((k0) + 32 + sr) * LDKV + sc]); } \
    else { S.ks0 = *reinterpret_cast<const bf16x8*>(&Kh[(long)((k0) + kr) * LDKV + kc]); } } while (0)
#define ATT_SWRITE(b, S) do { *(ATT_LAS bf16x8*)(V_lds + (b) * SHM_V + vst0) = S.vs0; *(ATT_LAS bf16x8*)(V_lds + (b) * SHM_V + vst1) = S.vs1; \
    if constexpr (DQK == 128) { *(ATT_LAS bf16x8*)(K_lds + (b) * SHM_K + kswz<128>(sr, sc * 2)) = S.ks0; *(ATT_LAS bf16x8*)(K_lds + (b) * SHM_K + kswz<128>(32 + sr, sc * 2)) = S.ks1; } \
    else { *(ATT_LAS bf16x8*)(K_lds + (b) * SHM_K + kswz<64>(kr, kc * 2)) = S.ks0; } } while (0)
#define ATT_SWAIT() do { if constexpr (DQK == 128) asm volatile("s_waitcnt vmcnt(4)" ::: "memory"); else asm volatile("s_waitcnt vmcnt(3)" ::: "memory"); } while (0)
#define ATT_RESC(a) do { if (__any((a) < 1.f)) { if (hi == 0) al_l[r32] = (a); asm volatile("s_waitcnt lgkmcnt(0)" ::: "memory"); \
    _Pragma("unroll") for (int d = 0; d < 4; ++d) _Pragma("unroll") for (int r = 0; r < 16; ++r) o[d][r] *= al_l[crow(r, hi)]; } } while (0)
  f32x16 pA0, pA1, pB0, pB1; float mnA, mnB, alA, alB; bf16x8 pa0, pa1, pa2, pa3; constexpr int NT = SEQ / KVBLK;
  ATT_SLOAD(s0_, 0); asm volatile("s_waitcnt vmcnt(0)" ::: "memory");
  __syncthreads();
  ATT_SWRITE(0, s0_); __syncthreads();
  qkt<DQK>(pA0, pA1, K_lds, qr, r32, hi); partialSM(pA0, pA1, m_reg, mnA, alA, C, thr_raw);
  ATT_SLOAD(s1_, KVBLK); ATT_SLOAD(s0_, 2 * KVBLK);
  ATT_SWAIT(); ATT_SWRITE(1, s1_); __syncthreads();
  for (int j = 1; j + 1 < NT; j += 2) {
    ATT_SBAR(); qkt<DQK>(pB0, pB1, K_lds + SHM_K, qr, r32, hi);
    finishSM(pA0, pA1, alA, l_reg, pa0, pa1, pa2, pa3); ATT_SBAR();
    ATT_SLOAD(s1_, (j + 2) * KVBLK); ATT_SBAR();
    pv_d0(o, vb0, pa0, pa1, pa2, pa3); partialSM(pB0, pB1, m_reg, mnB, alB, C, thr_raw);
    __syncthreads(); ATT_SWAIT(); ATT_SWRITE(0, s0_);
    ATT_RESC(alB); __syncthreads();
    ATT_SBAR(); qkt<DQK>(pA0, pA1, K_lds, qr, r32, hi);
    finishSM(pB0, pB1, alB, l_reg, pa0, pa1, pa2, pa3); ATT_SBAR();
    if (j + 3 < NT) ATT_SLOAD(s0_, (j + 3) * KVBLK); ATT_SBAR();
    pv_d0(o, vb0 + SHM_V, pa0, pa1, pa2, pa3); partialSM(pA0, pA1, m_reg, mnA, alA, C, thr_raw);
    __syncthreads(); ATT_SWAIT(); ATT_SWRITE(1, s1_);
    ATT_RESC(alA); __syncthreads();
  }
  ATT_SBAR(); qkt<DQK>(pB0, pB1, K_lds + SHM_K, qr, r32, hi);
  finishSM(pA0, pA1, alA, l_reg, pa0, pa1, pa2, pa3); ATT_SBAR();
  pv_d0(o, vb0, pa0, pa1, pa2, pa3); partialSM(pB0, pB1, m_reg, mnB, alB, C, thr_raw);
  __syncthreads(); ATT_RESC(alB);
  finishSM(pB0, pB1, alB, l_reg, pa0, pa1, pa2, pa3); ATT_SBAR();
  pv_d0(o, vb0 + SHM_V, pa0, pa1, pa2, pa3);
  if (hi == 0) li_l[r32] = l_reg; asm volatile("s_waitcnt lgkmcnt(0)" ::: "memory");
#pragma unroll
  for (int r = 0; r < 16; ++r) { const float rl = __builtin_amdgcn_rcpf(li_l[crow(r, hi)]);
#pragma unroll
    for (int d = 0; d < 4; ++d) o[d][r] *= rl; }
#undef ATT_SLOAD
#undef ATT_SWRITE
#undef ATT_SWAIT
#undef ATT_RESC
}
__device__ __forceinline__ void store_o(const f32x16 (&v)[4], bf16_t* Ob, ATT_LAS char* lds) {
  int tid_ = threadIdx.x; asm volatile("" : "+v"(tid_));
  const int tid = tid_, lane = tid & 63, r32 = lane & 31, hi = lane >> 5; const int wid = __builtin_amdgcn_readfirstlane(tid >> 6);
  ATT_LAS bf16_t* stg = (ATT_LAS bf16_t*)(lds + wid * 8192);
#pragma unroll
  for (int r = 0; r < 16; ++r) { const int orow = crow(r, hi);
#pragma unroll
    for (int d0 = 0; d0 < 4; ++d0) { const unsigned b = cvtpk(v[d0][r], 0.f); stg[orow * 128 + d0 * 32 + r32] = (bf16_t)(b & 0xffffu); } }
  asm volatile("s_waitcnt lgkmcnt(0)" ::: "memory");
#pragma unroll
  for (int i = 0; i < 8; ++i) { const int row = i * 4 + (lane >> 4), ch = lane & 15;
    const u32x4 w = *(const ATT_LAS u32x4*)(stg + row * 128 + ch * 8);
    *(u32x4*)(Ob + (long)(wid * QBLK + row) * 1024 + ch * 8) = w; }
}
}

constexpr int NWAVES = 8;
constexpr int BATCH = 4, SEQ = 4096, DM = 1024, M = BATCH * SEQ, DFF = 2816, MODW = 6 * DM;
constexpr float EPS = 1e-6f, LAM_INIT0 = 0.2f;
constexpr int NPHASE = 16;
#ifndef MK_N_LAUNCHES
#define MK_N_LAUNCHES 16
#endif
constexpr size_t MiB = 1u << 20;
constexpr size_t WS_CTL = 0, CTL_ZERO_BYTES = 64 * 1024;
constexpr size_t WS_MOD = 1 * MiB;
constexpr size_t WS_CSA = 1 * MiB + 256 * 1024;
constexpr size_t WS_CSB = 1 * MiB + 512 * 1024;
constexpr size_t WS_GQK = WS_CSB + 16384;
constexpr size_t WS_WAQKV = 2 * MiB, WS_WAO = 8 * MiB, WS_WIN0 = 10 * MiB, WS_WOUT0 = 21 * MiB;
constexpr size_t WS_WBQKV = 26 * MiB + 512 * 1024, WS_WBO = 29 * MiB + 512 * 1024, WS_WIN1 = 31 * MiB + 512 * 1024, WS_WOUT1 = 42 * MiB + 512 * 1024;
constexpr size_t WS_H = 48 * MiB, WS_O = 80 * MiB, WS_Q = 112 * MiB, WS_K = 144 * MiB, WS_V = 176 * MiB, WS_END = 208 * MiB;
constexpr size_t WS_ACT = WS_Q;
static_assert(WS_ACT + (size_t)M * DFF * 2 <= WS_END, "act overlay");
constexpr int RING_BYTES = 131072;
constexpr int EPI_OFF = RING_BYTES;
constexpr int MISC_OFF = RING_BYTES + 8192;
constexpr int LDS_BYTES = 147456;
static_assert(MISC_OFF + 128 <= LDS_BYTES, "LDS map");

#define GAS __attribute__((address_space(1)))
#define LAS __attribute__((address_space(3)))
typedef unsigned short bf16;
typedef unsigned v4u __attribute__((ext_vector_type(4)));
typedef unsigned v2u __attribute__((ext_vector_type(2)));
typedef float f32x4 __attribute__((ext_vector_type(4)));
typedef GAS unsigned gu32;
#define RLX_AGENT __ATOMIC_RELAXED, __HIP_MEMORY_SCOPE_AGENT
#define LDS_WAIT() asm volatile("s_waitcnt lgkmcnt(0)" ::: "memory")
#define VM_WAIT() asm volatile("s_waitcnt vmcnt(0)" ::: "memory")
__device__ __forceinline__ unsigned f2bf(float f) { unsigned u = __builtin_bit_cast(unsigned, f); return (u + 0x7fffu + ((u >> 16) & 1u)) >> 16; }
__device__ __forceinline__ unsigned pk2(float lo, float hi) { return f2bf(lo) | (f2bf(hi) << 16); }

#define XB_TMO      128
#define XB_XCNT(j)  (256  + 64 * (j))
#define XB_XSUB(j)  (1280 + 64 * (j))
#define XB_XGEN(j)  (2304 + 64 * (j))
#define XB_TOP      3328
#define XB_TOPGEN   3392
#define XCD_BAR_WORDS 3456
#define XB_SPIN_CAP (1u << 18)

__device__ __forceinline__ unsigned xb_ld(unsigned* p)              { return __hip_atomic_load(p, __ATOMIC_RELAXED, __HIP_MEMORY_SCOPE_AGENT); }
__device__ __forceinline__ unsigned xb_add(unsigned* p, unsigned v) { return __hip_atomic_fetch_add(p, v, __ATOMIC_RELAXED, __HIP_MEMORY_SCOPE_AGENT); }
__device__ __forceinline__ unsigned xb_xcc_id() { return (unsigned)__builtin_amdgcn_s_getreg((3 << 11) | 20) & 0xFu; }
#define XB_SPIN(cond, bar) do { unsigned _sp = 0; while (cond) { __builtin_amdgcn_s_sleep(1); \
    if ((++_sp & 255u) == 0u) { if (xb_ld(&(bar)[XB_TMO])) break; if (_sp > XB_SPIN_CAP) { atomicAdd(&(bar)[XB_TMO], 1u); break; } } } } while (0)

struct XcdBarrier {
    unsigned* bar; unsigned x;
    volatile LAS unsigned* st;
};

__device__ __forceinline__ XcdBarrier xcd_barrier_post(unsigned* bar, volatile LAS unsigned* st) {
    XcdBarrier b; b.bar = bar; b.x = xb_xcc_id(); b.st = st;
    if (threadIdx.x == 0) (void)xb_add(&bar[XB_XCNT(b.x)], 1u);
    return b;
}
__device__ __forceinline__ void xcd_barrier_complete(unsigned* bar, unsigned x, unsigned& nloc, unsigned& nx) {
    const unsigned G = gridDim.x * gridDim.y * gridDim.z;
    unsigned sum, cnt, mine, sp = 0u;
    for (;;) {
        sum = 0u; cnt = 0u; mine = 0u;
#pragma unroll
        for (unsigned j = 0; j < 16; ++j) { const unsigned c = xb_ld(&bar[XB_XCNT(j)]); sum += c; cnt += (c > 0u) ? 1u : 0u; mine = (j == x) ? c : mine; }
        if (sum == G) break;
        __builtin_amdgcn_s_sleep(1);
        if ((++sp & 255u) == 0u) { if (xb_ld(&bar[XB_TMO])) break; if (sp > XB_SPIN_CAP) { atomicAdd(&bar[XB_TMO], 1u); break; } }
    }
    nloc = mine > 0u ? mine : 1u; nx = cnt > 0u ? cnt : 1u;
}

__device__ __forceinline__ void xcd_barrier(const XcdBarrier& b) {
    asm volatile("s_waitcnt vmcnt(0)" ::: "memory");
    __syncthreads();
    if (threadIdx.x == 0) {
        unsigned* bar = b.bar;
        __builtin_amdgcn_s_waitcnt(0);
        unsigned nloc = b.st[0], nx = b.st[1];
        if (nloc == 0u) { xcd_barrier_complete(bar, b.x, nloc, nx); b.st[0] = nloc; b.st[1] = nx; }
        const unsigned old = xb_add(&bar[XB_XSUB(b.x)], 1u);
        const unsigned gen = old / nloc;
        if (old + 1u == (gen + 1u) * nloc) {
            __builtin_amdgcn_fence(__ATOMIC_RELEASE, "agent");
            asm volatile("s_waitcnt vmcnt(0)" ::: "memory");
            const unsigned og = xb_add(&bar[XB_TOP], 1u);
            const unsigned tg = og / nx;
            if (og + 1u == (tg + 1u) * nx) xb_add(&bar[XB_TOPGEN], 1u);
            else XB_SPIN(xb_ld(&bar[XB_TOPGEN]) == tg, bar);
            __builtin_amdgcn_fence(__ATOMIC_ACQUIRE, "agent");
            xb_add(&bar[XB_XGEN(b.x)], 1u);
            asm volatile("s_waitcnt vmcnt(0)" ::: "memory");
        } else {
            XB_SPIN(xb_ld(&bar[XB_XGEN(b.x)]) == gen, bar);
            __builtin_amdgcn_fence(__ATOMIC_ACQUIRE, "agent");
            asm volatile("s_waitcnt vmcnt(0)" ::: "memory");
        }
    }
    __syncthreads();
}


struct Frame {
    LAS unsigned char* lds;
    volatile LAS unsigned* MISC;
    int tid, lane, wave, vcu, G;
};
__device__ __forceinline__ float wave_sum(float v) {
#pragma unroll
    for (int o = 1; o < 64; o <<= 1) v += __shfl_xor(v, o);
    return v;
}
__device__ const float FREQ_A[8] = {1.000000000e+00f, 1.939227432e-01f, 3.760603070e-02f, 7.292664610e-03f, 1.414213562e-03f, 2.742481884e-04f, 5.318296098e-05f, 1.031338616e-05f};
__device__ const float FREQ_B[32] = {1.000000000e+00f, 7.498942614e-01f, 5.623413324e-01f, 4.216965139e-01f, 3.162277639e-01f, 2.371373773e-01f, 1.778279394e-01f, 1.333521307e-01f, 1.000000015e-01f, 7.498941571e-02f, 5.623413250e-02f, 4.216965288e-02f, 3.162277490e-02f, 2.371373773e-02f, 1.778279431e-02f, 1.333521493e-02f, 9.999999776e-03f, 7.498941850e-03f, 5.623413250e-03f, 4.216964822e-03f, 3.162277630e-03f, 2.371373586e-03f, 1.778279431e-03f, 1.333521446e-03f, 1.000000047e-03f, 7.498942432e-04f, 5.623413017e-04f, 4.216965172e-04f, 3.162277571e-04f, 2.371373703e-04f, 1.778279402e-04f, 1.333521504e-04f};
__device__ __forceinline__ void sincos_acc(float a, float& c, float& s) {
    const double TWO_PI = 6.283185307179586476925286766559, x0 = (double)a;
    const double n = __builtin_rint(x0 * (1.0 / TWO_PI)), x = x0 - n * TWO_PI, x2 = x * x;
    double ts = 1.0, tc = 1.0;
#pragma unroll
    for (int k = 14; k >= 1; --k) { ts = 1.0 - x2 * ts * (1.0 / (double)((2 * k) * (2 * k + 1))); tc = 1.0 - x2 * tc * (1.0 / (double)((2 * k - 1) * (2 * k))); }
    s = (float)(x * ts); c = (float)tc;
}
__device__ __forceinline__ int colmap(int kind, int n) {
    if (kind == 1) { if (n >= 2048) return n; const int p = n & 63, d = p < 16 ? ((p & 1) ? (p >> 1) + 8 : (p >> 1)) : p; return (n & ~63) + d; }
    if (kind == 2) { if (n >= 1280) return n; const int p = n & 127, pr = p >> 1, first = pr < 32 ? pr : pr + 32; return (n & ~127) + ((p & 1) ? first + 32 : first); }
    if (kind == 3) { const int t = n >> 8, r = n & 255; return r < 128 ? t * 128 + r : DFF + t * 128 + (r - 128); }
    return n;
}
__device__ __forceinline__ void transpose_item(const float* W, int K, int N, bf16* WT, int kind, LAS float* scr, int item, int lane) {
    const int nblk = N / 32, kb = item / nblk, nb = item % nblk, k0 = 64 * kb, n0 = 32 * nb;
    const int src = colmap(kind, n0 + (lane & 31));
#pragma unroll 8
    for (int i = 0; i < 32; ++i) { const int kk = 2 * i + (lane >> 5); scr[kk * 33 + (lane & 31)] = W[(size_t)(k0 + kk) * N + src]; }
    LDS_WAIT(); asm volatile("" ::: "memory");
    const int c = lane & 7;
#pragma unroll
    for (int j = 0; j < 4; ++j) { const int n = (lane >> 3) + 8 * j; const LAS float* s = scr + (8 * c) * 33 + n;
        v4u o; o.x = pk2(s[0 * 33], s[1 * 33]); o.y = pk2(s[2 * 33], s[3 * 33]); o.z = pk2(s[4 * 33], s[5 * 33]); o.w = pk2(s[6 * 33], s[7 * 33]);
        *(GAS v4u*)(WT + (size_t)(n0 + n) * K + k0 + 8 * c) = o; }
    LDS_WAIT(); asm volatile("" ::: "memory");
}
struct Args { const float* in[20]; float* out; unsigned char* ws; int ph_lo, ph_hi; };

__device__ __forceinline__ void p0_prologue(Frame& F, const Args& a) {
    unsigned char* ws = a.ws;
    {
        LAS float* scr = (LAS float*)(F.lds + F.wave * 16384);
        const int gw = F.vcu * NWAVES + F.wave, NGW = F.G * NWAVES;
        constexpr int I0 = (DM / 64) * (3072 / 32), I1 = (DM / 64) * (DM / 32), I2 = (DM / 64) * (2 * DFF / 32), I3 = (DFF / 64) * (DM / 32), I4 = (DM / 64) * (1536 / 32);
        constexpr int NITEMS = I0 + I1 + I2 + I3 + I4 + I1 + I2 + I3;
        for (int it = gw; it < NITEMS; it += NGW) {
            int r = it;
            if (r < I0) { transpose_item(a.in[6], DM, 3072, (bf16*)(ws + WS_WAQKV), 1, scr, r, F.lane); continue; } r -= I0;
            if (r < I1) { transpose_item(a.in[7], DM, DM, (bf16*)(ws + WS_WAO), 0, scr, r, F.lane); continue; } r -= I1;
            if (r < I2) { transpose_item(a.in[17], DM, 2 * DFF, (bf16*)(ws + WS_WIN0), 3, scr, r, F.lane); continue; } r -= I2;
            if (r < I3) { transpose_item(a.in[18], DFF, DM, (bf16*)(ws + WS_WOUT0), 0, scr, r, F.lane); continue; } r -= I3;
            if (r < I4) { transpose_item(a.in[13], DM, 1536, (bf16*)(ws + WS_WBQKV), 2, scr, r, F.lane); continue; } r -= I4;
            if (r < I1) { transpose_item(a.in[14], DM, DM, (bf16*)(ws + WS_WBO), 0, scr, r, F.lane); continue; } r -= I1;
            if (r < I2) { transpose_item(a.in[17] + (size_t)DM * 2 * DFF, DM, 2 * DFF, (bf16*)(ws + WS_WIN1), 3, scr, r, F.lane); continue; } r -= I2;
            transpose_item(a.in[18] + (size_t)DFF * DM, DFF, DM, (bf16*)(ws + WS_WOUT1), 0, scr, r, F.lane);
        }
    }
    __syncthreads();
    {
        LAS float* cond = (LAS float*)F.lds;
        LAS float* part = (LAS float*)(F.lds + 16384);
        const float* c = a.in[1]; float* mod = (float*)(ws + WS_MOD);
        for (int i = F.tid; i < BATCH * DM; i += NWAVES * 64) { const float v = c[i]; cond[i] = v / (1.0f + __expf(-v)); }
        __syncthreads();
        for (int task = F.vcu; task < 2 * (MODW / 64); task += F.G) {
            const int L = task / (MODW / 64), n0 = (task % (MODW / 64)) * 64;
            const float* W = a.in[2] + (size_t)L * DM * MODW + n0 + F.lane;
            float acc0 = 0.f, acc1 = 0.f, acc2 = 0.f, acc3 = 0.f;
            const int kb = F.wave * 128;
#pragma unroll 8
            for (int k = 0; k < 128; ++k) { const float w = W[(size_t)(kb + k) * MODW];
                acc0 += cond[kb + k] * w; acc1 += cond[DM + kb + k] * w; acc2 += cond[2 * DM + kb + k] * w; acc3 += cond[3 * DM + kb + k] * w; }
            part[(F.wave * 4 + 0) * 64 + F.lane] = acc0; part[(F.wave * 4 + 1) * 64 + F.lane] = acc1; part[(F.wave * 4 + 2) * 64 + F.lane] = acc2; part[(F.wave * 4 + 3) * 64 + F.lane] = acc3;
            __syncthreads();
            if (F.tid < 256) { const int b = F.tid >> 6, l = F.tid & 63; float s = 0.f;
#pragma unroll
                for (int w = 0; w < 8; ++w) s += part[(w * 4 + b) * 64 + l];
                mod[((size_t)L * BATCH + b) * MODW + n0 + l] = s + a.in[3][(size_t)L * MODW + n0 + l]; }
            __syncthreads();
        }
    }
    {
        float* csa = (float*)(ws + WS_CSA); float* csb = (float*)(ws + WS_CSB);
        if (F.vcu == 0 && F.tid < 256) ((float*)(ws + WS_GQK))[F.tid] = F.tid < 128 ? a.in[15][F.tid] : a.in[16][F.tid - 128];
        for (int e = F.vcu * (NWAVES * 64) + F.tid; e < SEQ * 8 + 64 * 32; e += F.G * NWAVES * 64) {
            float cc, ss;
            if (e < SEQ * 8) { const int t = e >> 3, i = e & 7; sincos_acc((float)t * FREQ_A[i], cc, ss); csa[t * 16 + i] = cc; csa[t * 16 + 8 + i] = ss; }
            else { const int e2 = e - SEQ * 8, p = e2 >> 5, i = e2 & 31; sincos_acc((float)p * FREQ_B[i], cc, ss); csb[p * 64 + i] = cc; csb[p * 64 + 32 + i] = ss; }
        }
    }
}
__device__ __forceinline__ void norm_rows(Frame& F, const float* x, const float* g, const float* shift, const float* scale, bf16* h) {
    const int gw = F.vcu * NWAVES + F.wave, NGW = F.G * NWAVES;
    for (int m = gw; m < M; m += NGW) {
        const GAS f32x4* xr = (const GAS f32x4*)(x + (size_t)m * DM) + F.lane;
        f32x4 v[4]; float s = 0.f;
#pragma unroll
        for (int j = 0; j < 4; ++j) { v[j] = xr[64 * j]; s += (v[j].x * v[j].x + v[j].y * v[j].y) + (v[j].z * v[j].z + v[j].w * v[j].w); }
        const float rstd = 1.0f / sqrtf(wave_sum(s) * (1.f / DM) + EPS);
        const int b = m / SEQ; const float* sh = shift + (size_t)b * MODW; const float* sc = scale + (size_t)b * MODW;
        GAS v2u* o8 = (GAS v2u*)(h + (size_t)m * DM) + F.lane;
#pragma unroll
        for (int j = 0; j < 4; ++j) { const int col = 4 * F.lane + 256 * j;
            const f32x4 gg = *(const f32x4*)(g + col), s1 = *(const f32x4*)(sc + col), s0 = *(const f32x4*)(sh + col);
            const f32x4 y = ((v[j] * rstd) * gg) * (s1 + 1.0f) + s0;
            v2u w; w.x = pk2(y.x, y.y); w.y = pk2(y.z, y.w); o8[64 * j] = w; }
    }
}
__device__ __forceinline__ void final_norm(Frame& F, float* x, const float* g) {
    const int gw = F.vcu * NWAVES + F.wave, NGW = F.G * NWAVES;
    for (int m = gw; m < M; m += NGW) {
        GAS f32x4* xr = (GAS f32x4*)(x + (size_t)m * DM) + F.lane;
        f32x4 v[4]; float s = 0.f;
#pragma unroll
        for (int j = 0; j < 4; ++j) { v[j] = xr[64 * j]; s += (v[j].x * v[j].x + v[j].y * v[j].y) + (v[j].z * v[j].z + v[j].w * v[j].w); }
        const float rstd = 1.0f / sqrtf(wave_sum(s) * (1.f / DM) + EPS);
#pragma unroll
        for (int j = 0; j < 4; ++j) { const f32x4 gg = *(const f32x4*)(g + 4 * F.lane + 256 * j); xr[64 * j] = (v[j] * rstd) * gg; }
    }
}
__device__ __forceinline__ void attn_phase_A(Frame& F, const bf16* Q, const bf16* K, const bf16* V, bf16* O, float* scr, const float* lq1, const float* lk1, const float* lq2, const float* lk2, const float* subg) {
    const float lam = __expf(wave_sum(lq1[F.lane] * lk1[F.lane])) - __expf(wave_sum(lq2[F.lane] * lk2[F.lane])) + LAM_INIT0;
    const int wid = F.wave;
    LAS char* lds = (LAS char*)F.lds;
    constexpr float C = 0.125f * 1.4426950408889634f;
    for (int uid = F.vcu; uid < 512; uid += F.G) {
        const int bh = (uid & 255) >> 3, qb = ((uid & 7) << 1) | (uid >> 8), b = bh >> 3, h = bh & 7;
        const size_t row0 = (size_t)b * SEQ + (size_t)qb * 256, krow0 = (size_t)b * SEQ;
#pragma unroll 1
        for (int c = 0; c < 2; ++c) {
            att::f32x16 o[4];
            att::attn_core<64, 1024>(Q + row0 * DM + h * 128 + c * 64, K + krow0 * DM + h * 128 + c * 64, V + krow0 * DM + h * 128, lds, C, o);
            int ln = threadIdx.x & 63; asm volatile("" : "+v"(ln));
            att::f32x4v* sw = (att::f32x4v*)scr + ((size_t)(uid * 8 + wid) * 16) * 64 + ln;
            if (c == 0) {
#pragma unroll
                for (int r = 0; r < 16; ++r) sw[r * 64] = (att::f32x4v){o[0][r], o[1][r], o[2][r], o[3][r]};
            } else {
                float gs[4];
#pragma unroll
                for (int d0 = 0; d0 < 4; ++d0) gs[d0] = subg[d0 * 32 + (ln & 31)] * (1.0f - LAM_INIT0);
#pragma unroll
                for (int r = 0; r < 16; ++r) { const att::f32x4v o0 = sw[r * 64]; float ss = 0.f;
#pragma unroll
                    for (int d0 = 0; d0 < 4; ++d0) { const float v = o0[d0] - lam * o[d0][r]; o[d0][r] = v; ss += v * v; }
                    ss += __shfl_xor(ss, 1); ss += __shfl_xor(ss, 2); ss += __shfl_xor(ss, 4); ss += __shfl_xor(ss, 8); ss += __shfl_xor(ss, 16);
                    const float rs = 1.0f / sqrtf(ss * (1.0f / 128.0f) + EPS);
#pragma unroll
                    for (int d0 = 0; d0 < 4; ++d0) o[d0][r] *= rs * gs[d0];
                    if ((r & 3) == 3) asm volatile("" ::: "memory"); }
                __syncthreads();
                att::store_o(o, O + row0 * DM + h * 128, lds);
            }
        }
    }
}
__device__ __forceinline__ void attn_phase_B(Frame& F, const bf16* Q, const bf16* K, const bf16* V, bf16* O) {
    LAS char* lds = (LAS char*)F.lds;
    constexpr float C = 0.08838834764831845f * 1.4426950408889634f;
    for (int uid = F.vcu; uid < 512; uid += F.G) {
        const int grp = (uid & 255) >> 5, w = ((uid & 31) << 1) | (uid >> 8), b = grp >> 1, kvh = grp & 1, hq = kvh * 4 + (w >> 4), qb = w & 15;
        const size_t row0 = (size_t)b * SEQ + (size_t)qb * 256, krow0 = (size_t)b * SEQ;
        att::f32x16 o[4];
        att::attn_core<128, 256>(Q + row0 * DM + hq * 128, K + krow0 * 256 + kvh * 128, V + krow0 * 256 + kvh * 128, lds, C, o);
        __syncthreads();
        att::store_o(o, O + row0 * DM + hq * 128, lds);
    }
}

#ifndef PHMASK
#define PHMASK 0xFFFF
#endif
#define KIND(b) (((PHMASK) >> (b)) & 1)
constexpr bool USE_BAR = (MK_N_LAUNCHES != NPHASE);
#define IN(k) (lo <= (k) && (k) < hi)
#define SEAM(k) do { if (USE_BAR && IN((k) + 1)) xcd_barrier(bar); } while (0)
__device__ __forceinline__ void refresh(Frame& F) { int t = threadIdx.x; asm volatile("" : "+v"(t)); F.tid = t; F.lane = t & 63; F.wave = __builtin_amdgcn_readfirstlane(t >> 6); }

template <int L>
__device__ __forceinline__ void layer_phases(Frame& F, const Args& args, const int lo, const int hi, const XcdBarrier& bar) {
    constexpr int pb = 1 + 7 * L;
    unsigned char* ws = args.ws;
    const float* x = args.in[0]; float* out = args.out;
    const float* modL = (const float*)(ws + WS_MOD) + (size_t)L * BATCH * MODW;
    const float* xin = (L == 0) ? x : (const float*)out;
    bf16 *H = (bf16*)(ws + WS_H), *O = (bf16*)(ws + WS_O), *Qb = (bf16*)(ws + WS_Q), *Kb = (bf16*)(ws + WS_K), *Vb = (bf16*)(ws + WS_V), *ACT = (bf16*)(ws + WS_ACT);
    if (KIND(1) && IN(pb)) { refresh(F); norm_rows(F, xin, args.in[4] + L * DM, modL, modL + DM, H); SEAM(pb); }
    if (IN(pb + 1)) {
        if constexpr (L == 0) { if (KIND(2)) { pg8::Gemm g{H, (const bf16*)(ws + WS_WAQKV), M, 3072, DM}; pg8::StaticOrder S; S.init(M, 3072, F.G, (int)blockIdx.x);
            pg8::EpiQkvA E{Qb, (size_t)(WS_K - WS_Q) / 2, (const float*)(ws + WS_CSA)};
            pg8::gemm_phase<pg8::EpiQkvA, pg8::StaticOrder, true, true>(F.lds, g, S, E); } }
        else { if (KIND(3)) { pg8::Gemm g{H, (const bf16*)(ws + WS_WBQKV), M, 1536, DM}; pg8::StaticOrder S; S.init(M, 1536, F.G, (int)blockIdx.x);
            pg8::EpiQkvB E{Qb, (size_t)(WS_K - WS_Q) / 2, (const float*)(ws + WS_GQK), (const float*)(ws + WS_CSB), (LAS float*)(F.lds + EPI_OFF)};
            pg8::gemm_phase<pg8::EpiQkvB, pg8::StaticOrder, true, true>(F.lds, g, S, E); } }
        SEAM(pb + 1);
    }
    if (IN(pb + 2)) {
        refresh(F);
        if constexpr (L == 0) { if (KIND(4)) attn_phase_A(F, Qb, Kb, Vb, O, out, args.in[8], args.in[9], args.in[10], args.in[11], args.in[12]); }
        else { if (KIND(5)) attn_phase_B(F, Qb, Kb, Vb, O); }
        SEAM(pb + 2);
    }
    if (KIND(6) && IN(pb + 3)) { pg8::Gemm g{O, (const bf16*)(ws + (L == 0 ? WS_WAO : WS_WBO)), M, DM, DM}; pg8::StaticOrder S; S.init(M, DM, F.G, (int)blockIdx.x);
        pg8::EpiResid E{xin, out, modL + 2 * DM};
        pg8::gemm_phase<pg8::EpiResid, pg8::StaticOrder, true, true>(F.lds, g, S, E);
        SEAM(pb + 3); }
    if (KIND(7) && IN(pb + 4)) { refresh(F); norm_rows(F, out, args.in[5] + L * DM, modL + 3 * DM, modL + 4 * DM, H); SEAM(pb + 4); }
    if (KIND(8) && IN(pb + 5)) { pg8::Gemm g{H, (const bf16*)(ws + (L == 0 ? WS_WIN0 : WS_WIN1)), M, 2 * DFF, DM}; pg8::StaticOrder S; S.init(M, 2 * DFF, F.G, (int)blockIdx.x);
        pg8::EpiSwiglu E{ACT, DFF};
        pg8::gemm_phase<pg8::EpiSwiglu, pg8::StaticOrder, true, true>(F.lds, g, S, E);
        SEAM(pb + 5); }
    if (KIND(9) && IN(pb + 6)) { pg8::Gemm g{ACT, (const bf16*)(ws + (L == 0 ? WS_WOUT0 : WS_WOUT1)), M, DM, DFF}; pg8::StaticOrder S; S.init(M, DM, F.G, (int)blockIdx.x);
        pg8::EpiResid E{out, out, modL + 5 * DM};
        pg8::gemm_phase<pg8::EpiResid, pg8::StaticOrder, true, true>(F.lds, g, S, E);
        SEAM(pb + 6); }
}

__global__ void __launch_bounds__(NWAVES * 64, 2) mk_fwd(Args args) {
    extern __shared__ __attribute__((aligned(16))) unsigned char lds[];
    Frame F;
    F.lds = (LAS unsigned char*)lds;
    F.MISC = (volatile LAS unsigned*)(F.lds + MISC_OFF);
    F.tid = threadIdx.x; F.lane = F.tid & 63; F.wave = __builtin_amdgcn_readfirstlane(F.tid >> 6);
    F.G = gridDim.x; { const int bx = blockIdx.x; F.vcu = (F.G % 8 == 0) ? (bx % 8) * (F.G / 8) + bx / 8 : bx; }
    if (F.tid < 32) F.MISC[F.tid] = 0u;
    __syncthreads();
    const int lo = args.ph_lo, hi = args.ph_hi;
    XcdBarrier bar; bar.bar = (unsigned*)(args.ws + WS_CTL); bar.x = 0; bar.st = nullptr;
    if (USE_BAR) bar = xcd_barrier_post((unsigned*)(args.ws + WS_CTL), F.MISC + 8);
    if (KIND(0) && IN(0)) { p0_prologue(F, args); SEAM(0); }
    layer_phases<0>(F, args, lo, hi, bar);
    layer_phases<1>(F, args, lo, hi, bar);
    if (KIND(10) && IN(15)) { refresh(F); final_norm(F, args.out, args.in[19]); }
}
#undef IN
#undef SEAM

extern "C" void kernel_launch(void* const* d_in, const int* in_sizes, int n_in, void* d_out, int out_size, void* d_ws, size_t ws_size, hipStream_t stream) {
    static int grid = 0;
    if (grid == 0) {
        if (n_in != 20 || in_sizes[0] != M * DM || out_size != M * DM || ws_size < WS_END) { fprintf(stderr, "kernel_launch: unexpected shapes (n_in %d, in0 %d, out %d, ws %zu)\n", n_in, n_in > 0 ? in_sizes[0] : -1, out_size, ws_size); grid = -1; return; }
        int dev = 0, cus = 0, per_cu = 0;
        if (hipGetDevice(&dev) != hipSuccess || hipDeviceGetAttribute(&cus, hipDeviceAttributeMultiprocessorCount, dev) != hipSuccess) { grid = -1; return; }
        if (hipFuncSetAttribute((const void*)mk_fwd, hipFuncAttributeMaxDynamicSharedMemorySize, LDS_BYTES) != hipSuccess) { fprintf(stderr, "kernel_launch: hipFuncSetAttribute failed\n"); grid = -1; return; }
        if (hipOccupancyMaxActiveBlocksPerMultiprocessor(&per_cu, (const void*)mk_fwd, NWAVES * 64, LDS_BYTES) != hipSuccess || per_cu < 1) { fprintf(stderr, "kernel_launch: occupancy query says %d blocks per CU\n", per_cu); grid = -1; (void)hipGetLastError(); return; }
        grid = cus;
    }
    if (grid < 0) return;
    if (hipMemsetAsync((char*)d_ws + WS_CTL, 0, CTL_ZERO_BYTES, stream) != hipSuccess) return;
    Args a{};
    for (int i = 0; i < 20; ++i) a.in[i] = (const float*)d_in[i];
    a.out = (float*)d_out; a.ws = (unsigned char*)d_ws;
    constexpr int NL = MK_N_LAUNCHES;
    for (int li = 0; li < NL; ++li) {
        a.ph_lo = li * NPHASE / NL; a.ph_hi = (li + 1) * NPHASE / NL;
        hipLaunchKernelGGL(mk_fwd, dim3(grid), dim3(NWAVES * 64), LDS_BYTES, stream, a);
        const hipError_t le = hipPeekAtLastError();
        if (le != hipSuccess) { fprintf(stderr, "kernel_launch: launch %d failed: %s\n", li, hipGetErrorName(le)); break; }
    }
}
```

```cpp
#include <hip/hip_runtime.h>
#include <hip/hip_bf16.h>
#include <cstdio>
#include <cstdint>
namespace pg8 {
#define PG8_LAS __attribute__((address_space(3)))
typedef unsigned short bf16_t;
typedef short bf16x8 __attribute__((ext_vector_type(8)));
typedef float f32x4 __attribute__((ext_vector_type(4)));
typedef unsigned u32x4 __attribute__((ext_vector_type(4)));
constexpr int BM = 256, BK = 64, HALF = 128, HTB = HALF * BK * 2  , STAGE_BYTES = 8 * HTB, NXCD = 8, WGM = 8;

__host__ __device__ __forceinline__ int lds_byte(int r, int c) { const int st = (r >> 4) * 2 + (c >> 5), rr = r & 15, cc = c & 31, ob = rr * 64 + cc * 2; return st * 1024 + (ob ^ (((ob >> 9) & 1) << 5)); }
__host__ __device__ __forceinline__ void stage_rc(int b, int& R, int& C) { const int st = b / 1024, sb = b % 1024, swz = sb ^ (((sb >> 9) & 1) << 5); R = (st >> 1) * 16 + swz / 64; C = (st & 1) * 32 + (swz % 64) / 2; }
__host__ __device__ __forceinline__ int perm32(int rho) { const int n = rho >> 4, i = rho & 15; return 8 * (i >> 2) + 4 * n + (i & 3); }

struct Unit { int pm, pn; };
struct Gemm { const bf16_t* A; const bf16_t* Bt; int M, N, K; };

struct StaticOrder {
    int nM, nN, nwg, G, c;
    __host__ __device__ void init(int M, int N, int G_, int c_) { nM = M / BM; nN = N / BM; nwg = nM * nN; G = G_; c = c_; }
    __host__ __device__ bool next(int i, Unit& u) const {
        const long L = (long)i * G + c; if (L >= nwg) return false;
        int wgid = (int)L; { const int q = nwg / NXCD, r = nwg % NXCD, xcd = wgid % NXCD, off = wgid / NXCD; wgid = (xcd < r ? xcd * (q + 1) : r * (q + 1) + (xcd - r) * q) + off; }
        const int nig = WGM * nN, gid = wgid / nig, fm = gid * WGM, gsz = (nM - fm) < WGM ? (nM - fm) : WGM;
        u.pm = fm + ((wgid % nig) % gsz); u.pn = (wgid % nig) / gsz; return true;
    }
    __device__ __forceinline__ void a_ready(const Unit&) const {}
    __device__ __forceinline__ void done(const Unit&) const {}
};


__device__ __forceinline__ unsigned cvt_pk_bf16(float lo, float hi) { unsigned r; asm volatile("v_cvt_pk_bf16_f32 %0, %1, %2" : "=v"(r) : "v"(lo), "v"(hi)); return r; }
constexpr int SEQ_ = 4096, DM_ = 1024, MODW_ = 6144;
constexpr float EPS_ = 1e-6f;

__device__ __forceinline__ void rot4(f32x4& v0, f32x4& v1, const f32x4 c, const f32x4 s) {
    f32x4 r0, r1;
    r0[0] = v0[0] * c[0] - v0[1] * s[0]; r0[1] = v0[1] * c[0] + v0[0] * s[0]; r0[2] = v0[2] * c[1] - v0[3] * s[1]; r0[3] = v0[3] * c[1] + v0[2] * s[1];
    r1[0] = v1[0] * c[2] - v1[1] * s[2]; r1[1] = v1[1] * c[2] + v1[0] * s[2]; r1[2] = v1[2] * c[3] - v1[3] * s[3]; r1[3] = v1[3] * c[3] + v1[2] * s[3];
    v0 = r0; v1 = r1;
}

struct EpiQkvA {
    static constexpr bool PERM = true, AFTER_DRAIN = false;
    bf16_t* Q; size_t tstride; const float* cs;
    __device__ __forceinline__ void operator()(const f32x4 (&acc)[2][2][4][2], const Unit& u, int wr, int wc, int fr, int fq) const {
        const int t3 = u.pn >> 2; bf16_t* base = Q + (size_t)t3 * tstride;
        const int col0 = (u.pn & 3) * BM + wc * 32 + 8 * fq, row0 = u.pm * BM + wr * 64 + fr;
        const bool rope = (t3 < 2) && ((wc & 1) == 0) && (fq < 2);
#pragma unroll
        for (int ai = 0; ai < 2; ++ai)
#pragma unroll
            for (int m = 0; m < 4; ++m) { const int row = row0 + ai * HALF + m * 16, t = row & (SEQ_ - 1);
                f32x4 cv = (f32x4){1.f, 1.f, 1.f, 1.f}, sv = (f32x4){0.f, 0.f, 0.f, 0.f};
                if (rope) { cv = *(const f32x4*)(cs + t * 16 + 4 * fq); sv = *(const f32x4*)(cs + t * 16 + 8 + 4 * fq); }
                bf16_t* rowp = base + (size_t)row * DM_ + col0;
#pragma unroll
                for (int bj = 0; bj < 2; ++bj) { f32x4 v0 = acc[ai][bj][m][0], v1 = acc[ai][bj][m][1];
                    rot4(v0, v1, cv, sv);
                    u32x4 w; w.x = cvt_pk_bf16(v0[0], v0[1]); w.y = cvt_pk_bf16(v0[2], v0[3]); w.z = cvt_pk_bf16(v1[0], v1[1]); w.w = cvt_pk_bf16(v1[2], v1[3]);
                    *(u32x4*)(rowp + bj * HALF) = w; } }
    }
};

struct EpiQkvB {
    static constexpr bool PERM = true, AFTER_DRAIN = false;
    bf16_t* Q; size_t tstride; const float* gtab; const float* cs2;
    PG8_LAS float* scr;
    __device__ __forceinline__ void operator()(const f32x4 (&acc)[2][2][4][2], const Unit& u, int wr, int wc, int fr, int fq) const {
        const int pn = u.pn; const bool nrm = pn < 5;
        bf16_t* base = Q + (size_t)(pn < 4 ? 0 : pn - 3) * tstride; const int ld = pn < 4 ? DM_ : 256; const float* g = gtab + (pn < 4 ? 0 : 128);
        const int col0 = (pn < 4 ? pn * BM : 0) + wc * 32 + 8 * fq, row0 = u.pm * BM + wr * 64 + fr;
        if (nrm) {
#pragma unroll
            for (int ai = 0; ai < 2; ++ai)
#pragma unroll
                for (int m = 0; m < 4; ++m)
#pragma unroll
                    for (int bj = 0; bj < 2; ++bj) { const f32x4 a = acc[ai][bj][m][0], b = acc[ai][bj][m][1];
                        float ss = (a[0] * a[0] + a[1] * a[1]) + (a[2] * a[2] + a[3] * a[3]) + (b[0] * b[0] + b[1] * b[1]) + (b[2] * b[2] + b[3] * b[3]);
                        ss += __shfl_xor(ss, 16); ss += __shfl_xor(ss, 32);
                        if (fq == 0) scr[((ai * HALF + wr * 64 + m * 16 + fr) * 2 + bj) * 4 + wc] = ss; }
            asm volatile("s_waitcnt lgkmcnt(0)" ::: "memory"); __builtin_amdgcn_s_barrier(); asm volatile("" ::: "memory");
        }
        const int f0 = 16 * (wc & 1) + 4 * fq, d1 = (wc < 2 ? 16 * wc : 16 * wc + 32) + 4 * fq;
        f32x4 g1 = (f32x4){1.f, 1.f, 1.f, 1.f}, g2 = g1;
        if (nrm) { g1 = *(const f32x4*)(g + d1); g2 = *(const f32x4*)(g + d1 + 32); }
#pragma unroll
        for (int ai = 0; ai < 2; ++ai)
#pragma unroll
            for (int m = 0; m < 4; ++m) { const int row = row0 + ai * HALF + m * 16, t = row & (SEQ_ - 1), pos = wc < 2 ? (t >> 6) : (t & 63);
                f32x4 cv = (f32x4){1.f, 1.f, 1.f, 1.f}, sv = (f32x4){0.f, 0.f, 0.f, 0.f};
                if (nrm) { cv = *(const f32x4*)(cs2 + pos * 64 + f0); sv = *(const f32x4*)(cs2 + pos * 64 + 32 + f0); }
                bf16_t* rowp = base + (size_t)row * ld + col0;
#pragma unroll
                for (int bj = 0; bj < 2; ++bj) { f32x4 v0 = acc[ai][bj][m][0], v1 = acc[ai][bj][m][1];
                    if (nrm) { const f32x4 p = *(const PG8_LAS f32x4*)(scr + ((ai * HALF + wr * 64 + m * 16 + fr) * 2 + bj) * 4);
                        const float rs = __builtin_amdgcn_rsqf(((p[0] + p[1]) + (p[2] + p[3])) * (1.0f / 128.0f) + EPS_);
                        v0[0] *= rs * g1[0]; v0[1] *= rs * g2[0]; v0[2] *= rs * g1[1]; v0[3] *= rs * g2[1]; v1[0] *= rs * g1[2]; v1[1] *= rs * g2[2]; v1[2] *= rs * g1[3]; v1[3] *= rs * g2[3];
                        rot4(v0, v1, cv, sv); }
                    u32x4 w; w.x = cvt_pk_bf16(v0[0], v0[1]); w.y = cvt_pk_bf16(v0[2], v0[3]); w.z = cvt_pk_bf16(v1[0], v1[1]); w.w = cvt_pk_bf16(v1[2], v1[3]);
                    *(u32x4*)(rowp + bj * HALF) = w; } }
    }
};

struct EpiResid {
    static constexpr bool PERM = false, AFTER_DRAIN = false;
    const float* base; float* out; const float* gate;
    __device__ __forceinline__ void operator()(const f32x4 (&acc)[2][2][4][2], const Unit& u, int wr, int wc, int fr, int fq) const {
        const int col0 = u.pn * BM + wc * 32 + 4 * fq, row0 = u.pm * BM + wr * 64 + fr, b = (u.pm * BM) / SEQ_;
        f32x4 gv[2][2];
#pragma unroll
        for (int bj = 0; bj < 2; ++bj)
#pragma unroll
            for (int n = 0; n < 2; ++n) gv[bj][n] = *(const f32x4*)(gate + b * MODW_ + col0 + bj * HALF + n * 16);
#pragma unroll
        for (int ai = 0; ai < 2; ++ai)
#pragma unroll
            for (int m = 0; m < 4; ++m) { const size_t off = (size_t)(row0 + ai * HALF + m * 16) * DM_ + col0;
#pragma unroll
                for (int bj = 0; bj < 2; ++bj)
#pragma unroll
                    for (int n = 0; n < 2; ++n) { const f32x4 bs = *(const f32x4*)(base + off + bj * HALF + n * 16); *(f32x4*)(out + off + bj * HALF + n * 16) = bs + gv[bj][n] * acc[ai][bj][m][n]; }
                if (m & 1) asm volatile("" ::: "memory"); }
    }
};

struct EpiSwiglu {
    static constexpr bool PERM = true, AFTER_DRAIN = false;
    bf16_t* O; int ldo;
    __device__ __forceinline__ static float sw(float g, float up) { return g * __builtin_amdgcn_rcpf(1.0f + __builtin_amdgcn_exp2f(g * -1.4426950408889634f)) * up; }
    __device__ __forceinline__ void operator()(const f32x4 (&acc)[2][2][4][2], const Unit& u, int wr, int wc, int fr, int fq) const {
        const int col0 = u.pn * HALF + wc * 32 + 8 * fq, row0 = u.pm * BM + wr * 64 + fr;
#pragma unroll
        for (int ai = 0; ai < 2; ++ai)
#pragma unroll
            for (int m = 0; m < 4; ++m) { const f32x4 g0 = acc[ai][0][m][0], g1 = acc[ai][0][m][1], u0 = acc[ai][1][m][0], u1 = acc[ai][1][m][1];
                u32x4 w; w.x = cvt_pk_bf16(sw(g0[0], u0[0]), sw(g0[1], u0[1])); w.y = cvt_pk_bf16(sw(g0[2], u0[2]), sw(g0[3], u0[3]));
                w.z = cvt_pk_bf16(sw(g1[0], u1[0]), sw(g1[1], u1[1])); w.w = cvt_pk_bf16(sw(g1[2], u1[2]), sw(g1[3], u1[3]));
                *(u32x4*)(O + (size_t)(row0 + ai * HALF + m * 16) * ldo + col0) = w; }
    }
};

template <class Epi, class Sched, bool ALIGN_EPI = false, bool SP2 = false>
__device__ __forceinline__ void gemm_phase(PG8_LAS unsigned char* lds, const Gemm g, const Sched& S, const Epi& E) {
    int tid_ = threadIdx.x; asm volatile("" : "+v"(tid_));
    const int tid = tid_, wid = __builtin_amdgcn_readfirstlane(tid >> 6), lane = tid & 63, wr = wid >> 2, wc = wid & 3, fr = lane & 15, fq = lane >> 4;
    const int K = g.K, nt = K / BK;
    unsigned voffA[2], voffB[2];
#pragma unroll
    for (int i = 0; i < 2; ++i) { int R, C; stage_rc(tid * 16 + i * 8192, R, C); const int Rb = Epi::PERM ? ((R & ~31) + perm32(R & 31)) : R;
        voffA[i] = (unsigned)(R * K + C) * 2u; voffB[i] = (unsigned)(Rb * K + C) * 2u; }
    const size_t kstep = (size_t)(BK * 2);
    const size_t hstep = (size_t)HALF * K * 2;
    const size_t tstep = 2 * hstep;
    const unsigned ldsw = (unsigned)wid * 1024u;
    const int aoff = lds_byte(wr * 64 + fr, fq * 8), boff = lds_byte(wc * 32 + fr, fq * 8);
#define PG8_SA(b, h) (((b) * 2 + (h)) * HTB)
#define PG8_SB(b, h) ((4 + (b) * 2 + (h)) * HTB)
#define PG8_STAGE(bufoff, gbase, voff) do { _Pragma("unroll") for (int _i = 0; _i < 2; ++_i) \
        __builtin_amdgcn_global_load_lds((const unsigned*)((const char*)(gbase) + (voff)[_i]), (PG8_LAS unsigned*)(lds + (bufoff) + ldsw + _i * 8192), 16, 0, 0); } while (0)
#define PG8_LDA(dst, b, h) do { _Pragma("unroll") for (int m = 0; m < 4; ++m) _Pragma("unroll") for (int k = 0; k < 2; ++k) dst[m][k] = *(const PG8_LAS bf16x8*)(lds + PG8_SA(b, h) + aoff + m * 2048 + k * 1024); } while (0)
#define PG8_LDB(dst, b, h) do { _Pragma("unroll") for (int n = 0; n < 2; ++n) _Pragma("unroll") for (int k = 0; k < 2; ++k) dst[n][k] = *(const PG8_LAS bf16x8*)(lds + PG8_SB(b, h) + boff + n * 2048 + k * 1024); } while (0)
#define PG8_MMA(ai, bj, At, Bt) do { __builtin_amdgcn_s_setprio(1); _Pragma("unroll") for (int m = 0; m < 4; ++m) _Pragma("unroll") for (int n = 0; n < 2; ++n) _Pragma("unroll") for (int k = 0; k < 2; ++k) \
        acc[ai][bj][m][n] = __builtin_amdgcn_mfma_f32_16x16x32_bf16(Bt[n][k], At[m][k], acc[ai][bj][m][n], 0, 0, 0); __builtin_amdgcn_s_setprio(0); } while (0)
#define PG8_WAIT_V(n) asm volatile("s_waitcnt vmcnt(" #n ")" ::: "memory")
#define PG8_WAIT_L(n) asm volatile("s_waitcnt lgkmcnt(" #n ")" ::: "memory")
#define PG8_BAR __builtin_amdgcn_s_barrier()
#define PG8_SCHED __builtin_amdgcn_sched_barrier(0)
    Unit cur, nxt; int ui = 0;
    if (!S.next(0, cur)) return;
    f32x4 acc[2][2][4][2];
#pragma unroll
    for (int a = 0; a < 2; ++a)
#pragma unroll
        for (int b = 0; b < 2; ++b)
#pragma unroll
            for (int m = 0; m < 4; ++m)
#pragma unroll
                for (int n = 0; n < 2; ++n) acc[a][b][m][n] = (f32x4){0.f, 0.f, 0.f, 0.f};
    bf16x8 At[4][2], B0[2][2], B1[2][2];
    const char* cA = (const char*)g.A + (size_t)cur.pm * tstep; const char* cB = (const char*)g.Bt + (size_t)cur.pn * tstep;
    S.a_ready(cur);
    if constexpr (SP2) {
        PG8_STAGE(PG8_SB(0, 0), cB, voffB); PG8_STAGE(PG8_SB(0, 1), cB + hstep, voffB); PG8_STAGE(PG8_SA(0, 0), cA, voffA); PG8_STAGE(PG8_SA(0, 1), cA + hstep, voffA);
        if (wr == 1) PG8_BAR;
        PG8_WAIT_V(2); PG8_BAR;
        PG8_STAGE(PG8_SB(1, 0), cB + kstep, voffB); PG8_STAGE(PG8_SA(1, 0), cA + kstep, voffA); PG8_STAGE(PG8_SB(1, 1), cB + hstep + kstep, voffB);
        PG8_WAIT_V(6); PG8_BAR;
    } else {
        PG8_STAGE(PG8_SB(0, 0), cB, voffB); PG8_STAGE(PG8_SA(0, 0), cA, voffA); PG8_STAGE(PG8_SB(0, 1), cB + hstep, voffB); PG8_STAGE(PG8_SA(0, 1), cA + hstep, voffA);
        if (wr == 1) PG8_BAR;
        PG8_WAIT_V(4); PG8_BAR;
        PG8_STAGE(PG8_SB(1, 0), cB + kstep, voffB); PG8_STAGE(PG8_SA(1, 0), cA + kstep, voffA); PG8_STAGE(PG8_SB(1, 1), cB + hstep + kstep, voffB);
        PG8_WAIT_V(6); PG8_BAR;
    }
    for (;;) {
        const bool has_next = S.next(ui + 1, nxt);
        const char* nA = has_next ? (const char*)g.A + (size_t)nxt.pm * tstep : cA; const char* nB = has_next ? (const char*)g.Bt + (size_t)nxt.pn * tstep : cB;
        for (int t = 0; t < nt; t += 2) {
            const bool last = (t == nt - 2);
            const char* a1 = cA + (size_t)(t + 1) * kstep;
            const char* a2 = last ? nA : cA + (size_t)(t + 2) * kstep; const char* b2 = last ? nB : cB + (size_t)(t + 2) * kstep;
            const char* a3 = a2 + kstep; const char* b3 = b2 + kstep;
            if (last && has_next) S.a_ready(nxt);
            if constexpr (SP2) {
            PG8_LDB(B0, 0, 0); PG8_LDB(B1, 0, 1); PG8_SCHED; PG8_LDA(At, 0, 0); PG8_STAGE(PG8_SA(1, 1), a1 + hstep, voffA);
            PG8_WAIT_V(8); PG8_WAIT_L(0); PG8_BAR; PG8_MMA(0, 0, At, B0); PG8_MMA(0, 1, At, B1); PG8_BAR; PG8_SCHED;
            PG8_LDA(At, 0, 1); PG8_STAGE(PG8_SB(0, 0), b2, voffB); PG8_STAGE(PG8_SB(0, 1), b2 + hstep, voffB); PG8_STAGE(PG8_SA(0, 0), a2, voffA);
            PG8_WAIT_V(8); PG8_WAIT_L(0); PG8_BAR; PG8_MMA(1, 0, At, B0); PG8_MMA(1, 1, At, B1); PG8_BAR; PG8_SCHED;
            PG8_LDB(B0, 1, 0); PG8_LDB(B1, 1, 1); PG8_SCHED; PG8_LDA(At, 1, 0); PG8_STAGE(PG8_SA(0, 1), a2 + hstep, voffA);
            PG8_WAIT_V(8); PG8_WAIT_L(0); PG8_BAR; PG8_MMA(0, 0, At, B0); PG8_MMA(0, 1, At, B1); PG8_BAR; PG8_SCHED;
            PG8_LDA(At, 1, 1); PG8_STAGE(PG8_SB(1, 0), b3, voffB); PG8_STAGE(PG8_SB(1, 1), b3 + hstep, voffB); PG8_STAGE(PG8_SA(1, 0), a3, voffA);
            PG8_WAIT_V(8); PG8_WAIT_L(0); PG8_BAR; PG8_MMA(1, 0, At, B0); PG8_MMA(1, 1, At, B1); PG8_BAR; PG8_SCHED;
            } else {
            PG8_LDB(B0, 0, 0); PG8_SCHED; PG8_LDA(At, 0, 0); PG8_STAGE(PG8_SA(1, 1), a1 + hstep, voffA);
            PG8_WAIT_L(8); PG8_BAR; PG8_WAIT_L(0); PG8_MMA(0, 0, At, B0); PG8_BAR; PG8_SCHED;
            PG8_LDB(B1, 0, 1); PG8_STAGE(PG8_SB(0, 0), b2, voffB);
            PG8_BAR; PG8_WAIT_L(0); PG8_MMA(0, 1, At, B1); PG8_BAR;
            PG8_LDA(At, 0, 1); PG8_STAGE(PG8_SA(0, 0), a2, voffA);
            PG8_BAR; PG8_WAIT_L(0); PG8_MMA(1, 0, At, B0); PG8_BAR; PG8_SCHED;
            PG8_STAGE(PG8_SB(0, 1), b2 + hstep, voffB);
            PG8_WAIT_V(6); PG8_BAR; PG8_MMA(1, 1, At, B1); PG8_BAR;
            PG8_LDB(B0, 1, 0); PG8_SCHED; PG8_LDA(At, 1, 0); PG8_STAGE(PG8_SA(0, 1), a2 + hstep, voffA);
            PG8_WAIT_L(8); PG8_BAR; PG8_WAIT_L(0); PG8_MMA(0, 0, At, B0); PG8_BAR; PG8_SCHED;
            PG8_LDB(B1, 1, 1); PG8_STAGE(PG8_SB(1, 0), b3, voffB);
            PG8_BAR; PG8_WAIT_L(0); PG8_MMA(0, 1, At, B1); PG8_BAR;
            PG8_LDA(At, 1, 1); PG8_STAGE(PG8_SA(1, 0), a3, voffA);
            PG8_BAR; PG8_WAIT_L(0); PG8_MMA(1, 0, At, B0); PG8_BAR; PG8_SCHED;
            PG8_STAGE(PG8_SB(1, 1), b3 + hstep, voffB);
            PG8_WAIT_V(6); PG8_BAR; PG8_MMA(1, 1, At, B1); PG8_BAR;
            }
        }
        if constexpr (ALIGN_EPI) { if (wr == 0) PG8_BAR; }
        if constexpr (!Epi::AFTER_DRAIN) { E(acc, cur, wr, wc, fr, fq); S.done(cur); }
        if (!has_next) break;
#pragma unroll
        for (int a = 0; a < 2; ++a)
#pragma unroll
            for (int b = 0; b < 2; ++b)
#pragma unroll
                for (int m = 0; m < 4; ++m)
#pragma unroll
                    for (int n = 0; n < 2; ++n) acc[a][b][m][n] = (f32x4){0.f, 0.f, 0.f, 0.f};
        cur = nxt; cA = nA; cB = nB; ++ui;
        if constexpr (ALIGN_EPI) { if (wr == 1) PG8_BAR; }
    }
    PG8_WAIT_V(0);
    if constexpr (!ALIGN_EPI) { if (wr == 0) PG8_BAR; }
    PG8_BAR;
    if constexpr (Epi::AFTER_DRAIN) { E.fused(acc, cur, wr, wc, fr, fq, lds, wid, lane); S.done(cur); }
#undef PG8_SA
#undef PG8_SB
#undef PG8_STAGE
#undef PG8_LDA
#undef PG8_LDB
#undef PG8_MMA
#undef PG8_WAIT_V
#undef PG8_WAIT_L
#undef PG8_BAR
#undef PG8_SCHED
}
}

namespace att {
#define ATT_LAS __attribute__((address_space(3)))
typedef unsigned short bf16_t;
using bf16x8 = __attribute__((ext_vector_type(8))) short;
using s16x4  = __attribute__((ext_vector_type(4))) short;
using f32x16 = __attribute__((ext_vector_type(16))) float;
using u32x4  = __attribute__((ext_vector_type(4))) unsigned;
using f32x4v = __attribute__((ext_vector_type(4))) float;
constexpr int NW = 8, QBLK = 32, KVBLK = 64, DV = 128, LDQ = 1024, SEQ = 4096;
constexpr int SHM_V = KVBLK * DV * 2, SHM_K = 16384;
constexpr int LDS_V = 0, LDS_K = 2 * SHM_V, LDS_WS = 2 * SHM_V + 2 * SHM_K, LDS_BYTES = LDS_WS + NW * 64 * 4;
#define ATT_SBAR() __builtin_amdgcn_sched_barrier(0)
__device__ __forceinline__ int crow(int r, int hi) { return (r & 3) + 8 * (r >> 2) + 4 * hi; }
__device__ __forceinline__ unsigned cvtpk(float lo, float hi) { unsigned r; asm volatile("v_cvt_pk_bf16_f32 %0, %1, %2" : "=v"(r) : "v"(lo), "v"(hi)); return r; }
template <int DQK> __device__ __forceinline__ int kswz(int row, int colB) {
  if constexpr (DQK == 128) return row * 256 + (colB ^ ((row & 7) << 4));
  else return row * 128 + (colB ^ (((row >> 1) & 7) << 4));
}
__device__ __forceinline__ void partialSM(f32x16& p0, f32x16& p1, float& m_reg, float& mn, float& alpha, const float C, const float thr_raw) {
  float pmax = p0[0];
#pragma unroll
  for (int r = 1; r < 16; ++r) pmax = fmaxf(pmax, p0[r]);
#pragma unroll
  for (int r = 0; r < 16; ++r) pmax = fmaxf(pmax, p1[r]);
  { auto rr = __builtin_amdgcn_permlane32_swap(__float_as_uint(pmax), __float_as_uint(pmax), false, false);
    pmax = fmaxf(__uint_as_float(rr[0]), __uint_as_float(rr[1])); }
  if (__builtin_expect(__all(pmax - m_reg <= thr_raw), 1)) { mn = m_reg; alpha = 1.f; }
  else { mn = fmaxf(m_reg, pmax); alpha = __builtin_amdgcn_exp2f((m_reg - mn) * C); m_reg = mn; }
  const float mnC = -mn * C;
#pragma unroll
  for (int r = 0; r < 16; ++r) p0[r] = fmaf(p0[r], C, mnC);
#pragma unroll
  for (int r = 0; r < 16; ++r) p1[r] = fmaf(p1[r], C, mnC);
#pragma unroll
  for (int r = 0; r < 16; ++r) p0[r] = __builtin_amdgcn_exp2f(p0[r]);
}
__device__ __forceinline__ void finishSM(f32x16& p0, f32x16& p1, float alpha, float& l_reg, bf16x8& pa0, bf16x8& pa1, bf16x8& pa2, bf16x8& pa3) {
#pragma unroll
  for (int r = 0; r < 16; ++r) p1[r] = __builtin_amdgcn_exp2f(p1[r]);
  float ps = 0;
#pragma unroll
  for (int r = 0; r < 16; ++r) ps += p0[r];
#pragma unroll
  for (int r = 0; r < 16; ++r) ps += p1[r];
  { auto rr = __builtin_amdgcn_permlane32_swap(__float_as_uint(ps), __float_as_uint(ps), false, false);
    ps = __uint_as_float(rr[0]) + __uint_as_float(rr[1]); }
  l_reg = l_reg * alpha + ps;
#define ATT_PK4(P, BASE, OUT) do { unsigned a0 = cvtpk(P[BASE + 0], P[BASE + 1]), a1 = cvtpk(P[BASE + 2], P[BASE + 3]);   \
    unsigned b0 = cvtpk(P[BASE + 4], P[BASE + 5]), b1 = cvtpk(P[BASE + 6], P[BASE + 7]);                              \
    auto r0 = __builtin_amdgcn_permlane32_swap(a0, b0, false, false); auto r1 = __builtin_amdgcn_permlane32_swap(a1, b1, false, false); \
    u32x4 w = {r0[0], r1[0], r0[1], r1[1]}; OUT = __builtin_bit_cast(bf16x8, w); } while (0)
  ATT_PK4(p0, 0, pa0); ATT_PK4(p0, 8, pa1); ATT_PK4(p1, 0, pa2); ATT_PK4(p1, 8, pa3);
#undef ATT_PK4
}
template <int DQK> __device__ __forceinline__ void qkt(f32x16& p0, f32x16& p1, const ATT_LAS char* Ks, const bf16x8* qr, int r32, int hi) {
  p0 = f32x16{}; p1 = f32x16{};
#pragma unroll
  for (int d0 = 0; d0 < DQK / 16; ++d0) { const int cb = (d0 * 16 + hi * 8) * 2;
    const bf16x8 b0 = *reinterpret_cast<const ATT_LAS bf16x8*>(Ks + kswz<DQK>(r32, cb));
    const bf16x8 b1 = *reinterpret_cast<const ATT_LAS bf16x8*>(Ks + kswz<DQK>(32 + r32, cb));
    p0 = __builtin_amdgcn_mfma_f32_32x32x16_bf16(b0, qr[d0], p0, 0, 0, 0);
    p1 = __builtin_amdgcn_mfma_f32_32x32x16_bf16(b1, qr[d0], p1, 0, 0, 0); }
}
__device__ __forceinline__ int v_st(int k, int c) { const int kk = (k & ~0xC) | ((k & 4) << 1) | ((k & 8) >> 1); return ((kk >> 3) * 4 + (c >> 5)) * 512 + ((kk & 7) * 32 + (c & 31)) * 2; }
__device__ __forceinline__ int v_rd_base(int lane) { return ((lane & 3) << 3) | (((lane >> 2) & 3) << 6) | (((lane >> 4) & 1) << 5) | (((lane >> 5) & 1) << 8); }
constexpr int v_rd_off(int d0, int ks, int half) { return d0 * 512 + ks * 4096 + half * 2048; }
template <int OFF> __device__ __forceinline__ s16x4 tr_read(int vb) {
  s16x4 r; asm volatile("ds_read_b64_tr_b16 %0, %1 offset:%2" : "=&v"(r) : "v"(vb), "i"(OFF) : "memory"); return r;
}
template <int D0> __device__ __forceinline__ void pv_one(f32x16& od, int vb, bf16x8 pa0, bf16x8 pa1, bf16x8 pa2, bf16x8 pa3) {
  const s16x4 l0 = tr_read<v_rd_off(D0, 0, 0)>(vb), h0 = tr_read<v_rd_off(D0, 0, 1)>(vb), l1 = tr_read<v_rd_off(D0, 1, 0)>(vb), h1 = tr_read<v_rd_off(D0, 1, 1)>(vb);
  const s16x4 l2 = tr_read<v_rd_off(D0, 2, 0)>(vb), h2 = tr_read<v_rd_off(D0, 2, 1)>(vb), l3 = tr_read<v_rd_off(D0, 3, 0)>(vb), h3 = tr_read<v_rd_off(D0, 3, 1)>(vb);
  asm volatile("s_waitcnt lgkmcnt(0)" ::: "memory"); ATT_SBAR();
#define ATT_PK(L, H) (bf16x8){L[0], L[1], L[2], L[3], H[0], H[1], H[2], H[3]}
  od = __builtin_amdgcn_mfma_f32_32x32x16_bf16(pa0, ATT_PK(l0, h0), od, 0, 0, 0);
  od = __builtin_amdgcn_mfma_f32_32x32x16_bf16(pa1, ATT_PK(l1, h1), od, 0, 0, 0);
  od = __builtin_amdgcn_mfma_f32_32x32x16_bf16(pa2, ATT_PK(l2, h2), od, 0, 0, 0);
  od = __builtin_amdgcn_mfma_f32_32x32x16_bf16(pa3, ATT_PK(l3, h3), od, 0, 0, 0);
#undef ATT_PK
}
__device__ __forceinline__ void pv_d0(f32x16* o, int vb, bf16x8 pa0, bf16x8 pa1, bf16x8 pa2, bf16x8 pa3) {
  pv_one<0>(o[0], vb, pa0, pa1, pa2, pa3); pv_one<1>(o[1], vb, pa0, pa1, pa2, pa3); pv_one<2>(o[2], vb, pa0, pa1, pa2, pa3); pv_one<3>(o[3], vb, pa0, pa1, pa2, pa3);
}

template <int DQK, int LDKV>
__device__ __forceinline__ void attn_core(const bf16_t* Qb, const bf16_t* Kh, const bf16_t* Vh, ATT_LAS char* lds, const float C, f32x16 (&o)[4]) {
  int tid_ = threadIdx.x; asm volatile("" : "+v"(tid_));
  const int tid = tid_, lane = tid & 63, r32 = lane & 31, hi = lane >> 5; const int wid = __builtin_amdgcn_readfirstlane(tid >> 6);
  ATT_LAS char* V_lds = lds + LDS_V; ATT_LAS char* K_lds = lds + LDS_K;
  ATT_LAS float* ws = (ATT_LAS float*)(lds + LDS_WS) + wid * 64; ATT_LAS float* li_l = ws; ATT_LAS float* al_l = ws + 32;
  const float thr_raw = 8.0f * 1.4426950408889634f / C;
  float m_reg = -1e30f, l_reg = 0;
#pragma unroll
  for (int d = 0; d < 4; ++d) o[d] = f32x16{};
  bf16x8 qr[DQK / 16];
  const bf16_t* Qw = Qb + (long)(wid * QBLK + r32) * LDQ + hi * 8;
#pragma unroll
  for (int d0 = 0; d0 < DQK / 16; ++d0) qr[d0] = *reinterpret_cast<const bf16x8*>(Qw + d0 * 16);
  const int sr = tid >> 4, sc = (tid & 15) * 8, vst0 = v_st(sr, sc), vst1 = v_st(32 + sr, sc);
  const int kr = tid >> 3, kc = (tid & 7) * 8;
  const int vb0 = (int)(size_t)V_lds + v_rd_base(lane);
  struct Slot { bf16x8 vs0, vs1, ks0, ks1; } s0_, s1_;
#define ATT_SLOAD(S, k0) do { S.vs0 = *reinterpret_cast<const bf16x8*>(&Vh[(long)((k0) + sr) * LDKV + sc]); S.vs1 = *reinterpret_cast<const bf16x8*>(&Vh[(long)((k0) + 32 + sr) * LDKV + sc]); \
    if constexpr (DQK == 128) { S.ks0 = *reinterpret_cast<const bf16x8*>(&Kh[(long)((k0) + sr) * LDKV + sc]); S.ks1 = *reinterpret_cast<const bf16x8*>(&Kh[(long)((k0) + 32 + sr) * LDKV + sc]); } \
    else { S.ks0 = *reinterpret_cast<const bf16x8*>(&Kh[(long)((k0) + kr) * LDKV + kc]); } } while (0)
#define ATT_SWRITE(b, S) do { *(ATT_LAS bf16x8*)(V_lds + (b) * SHM_V + vst0) = S.vs0; *(ATT_LAS bf16x8*)(V_lds + (b) * SHM_V + vst1) = S.vs1; \
    if constexpr (DQK == 128) { *(ATT_LAS bf16x8*)(K_lds + (b) * SHM_K + kswz<128>(sr, sc * 2)) = S.ks0; *(ATT_LAS bf16x8*)(K_lds + (b) * SHM_K + kswz<128>(32 + sr, sc * 2)) = S.ks1; } \
    else { *(ATT_LAS bf16x8*)(K_lds + (b) * SHM_K + kswz<64>(kr, kc * 2)) = S.ks0; } } while (0)
#define ATT_SWAIT() do { if constexpr (DQK == 128) asm volatile("s_waitcnt vmcnt(4)" ::: "memory"); else asm volatile("s_waitcnt vmcnt(3)" ::: "memory"); } while (0)
#define ATT_RESC(a) do { if (__any((a) < 1.f)) { if (hi == 0) al_l[r32] = (a); asm volatile("s_waitcnt lgkmcnt(0)" ::: "memory"); \
    _Pragma("unroll") for (int d = 0; d < 4; ++d) _Pragma("unroll") for (int r = 0; r < 16; ++r) o[d][r] *= al_l[crow(r, hi)]; } } while (0)
  f32x16 pA0, pA1, pB0, pB1; float mnA, mnB, alA, alB; bf16x8 pa0, pa1, pa2, pa3; constexpr int NT = SEQ / KVBLK;
  ATT_SLOAD(s0_, 0); asm volatile("s_waitcnt vmcnt(0)" ::: "memory");
  __syncthreads();
  ATT_SWRITE(0, s0_); __syncthreads();
  qkt<DQK>(pA0, pA1, K_lds, qr, r32, hi); partialSM(pA0, pA1, m_reg, mnA, alA, C, thr_raw);
  ATT_SLOAD(s1_, KVBLK); ATT_SLOAD(s0_, 2 * KVBLK);
  ATT_SWAIT(); ATT_SWRITE(1, s1_); __syncthreads();
  for (int j = 1; j + 1 < NT; j += 2) {
    ATT_SBAR(); qkt<DQK>(pB0, pB1, K_lds + SHM_K, qr, r32, hi);
    finishSM(pA0, pA1, alA, l_reg, pa0, pa1, pa2, pa3); ATT_SBAR();
    ATT_SLOAD(s1_, (j + 2) * KVBLK); ATT_SBAR();
    pv_d0(o, vb0, pa0, pa1, pa2, pa3); partialSM(pB0, pB1, m_reg, mnB, alB, C, thr_raw);
    __syncthreads(); ATT_SWAIT(); ATT_SWRITE(0, s0_);
    ATT_RESC(alB); __syncthreads();
    ATT_SBAR(); qkt<DQK>(pA0, pA1, K_lds, qr, r32, hi);
    finishSM(pB0, pB1, alB, l_reg, pa0, pa1, pa2, pa3); ATT_SBAR();
    if (j + 3 < NT) ATT_SLOAD(s0_, (j + 3) * KVBLK); ATT_SBAR();
    pv_d0(o, vb0 + SHM_V, pa0, pa1, pa2, pa3); partialSM(pA0, pA1, m_reg, mnA, alA, C, thr_raw);
    __syncthreads(); ATT_SWAIT(); ATT_SWRITE(1, s1_);
    ATT_RESC(alA); __syncthreads();
  }
  ATT_SBAR(); qkt<DQK>(pB0, pB1, K_lds + SHM_K, qr, r32, hi);
  finishSM(pA0, pA1, alA, l_reg, pa0, pa1, pa2, pa3); ATT_SBAR();
  pv_d0(o, vb0, pa0, pa1, pa2, pa3); partialSM(pB0, pB1, m_reg, mnB, alB, C, thr_raw);
  __syncthreads(); ATT_RESC(alB);
  finishSM(pB0, pB1, alB, l_reg, pa0, pa1, pa2, pa3); ATT_SBAR();
  pv_d0(o, vb0 + SHM_V, pa0, pa1, pa2, pa3);
  if (hi == 0) li_l[r32] = l_reg; asm volatile("s_waitcnt lgkmcnt(0)" ::: "memory");
#pragma unroll
  for (int r = 0; r < 16; ++r) { const float rl = __builtin_amdgcn_rcpf(li_l[crow(r, hi)]);
#pragma unroll
    for (int d = 0; d < 4; ++d) o[d][r] *= rl; }
#undef ATT_SLOAD
#undef ATT_SWRITE
#undef ATT_SWAIT
#undef ATT_RESC
}
__device__ __forceinline__ void store_o(const f32x16 (&v)[4], bf16_t* Ob, ATT_LAS char* lds) {
  int tid_ = threadIdx.x; asm volatile("" : "+v"(tid_));
  const int tid = tid_, lane = tid & 63, r32 = lane & 31, hi = lane >> 5; const int wid = __builtin_amdgcn_readfirstlane(tid >> 6);
  ATT_LAS bf16_t* stg = (ATT_LAS bf16_t*)(lds + wid * 8192);
#pragma unroll
  for (int r = 0; r < 16; ++r) { const int orow = crow(r, hi);
#pragma unroll
    for (int d0 = 0; d0 < 4; ++d0) { const unsigned b = cvtpk(v[d0][r], 0.f); stg[orow * 128 + d0 * 32 + r32] = (bf16_t)(b & 0xffffu); } }
  asm volatile("s_waitcnt lgkmcnt(0)" ::: "memory");
#pragma unroll
  for (int i = 0; i < 8; ++i) { const int row = i * 4 + (lane >> 4), ch = lane & 15;
    const u32x4 w = *(const ATT_LAS u32x4*)(stg + row * 128 + ch * 8);
    *(u32x4*)(Ob + (long)(wid * QBLK + row) * 1024 + ch * 8) = w; }
}
}

constexpr int NWAVES = 8;
constexpr int BATCH = 4, SEQ = 4096, DM = 1024, M = BATCH * SEQ, DFF = 2816, MODW = 6 * DM;
constexpr float EPS = 1e-6f, LAM_INIT0 = 0.2f;
constexpr int NPHASE = 16;
#ifndef MK_N_LAUNCHES
#define MK_N_LAUNCHES 1
#endif
constexpr size_t MiB = 1u << 20;
constexpr size_t WS_CTL = 0, CTL_ZERO_BYTES = 64 * 1024;
constexpr size_t WS_MOD = 1 * MiB;
constexpr size_t WS_CSA = 1 * MiB + 256 * 1024;
constexpr size_t WS_CSB = 1 * MiB + 512 * 1024;
constexpr size_t WS_GQK = WS_CSB + 16384;
constexpr size_t WS_WAQKV = 2 * MiB, WS_WAO = 8 * MiB, WS_WIN0 = 10 * MiB, WS_WOUT0 = 21 * MiB;
constexpr size_t WS_WBQKV = 26 * MiB + 512 * 1024, WS_WBO = 29 * MiB + 512 * 1024, WS_WIN1 = 31 * MiB + 512 * 1024, WS_WOUT1 = 42 * MiB + 512 * 1024;
constexpr size_t WS_H = 48 * MiB, WS_O = 80 * MiB, WS_Q = 112 * MiB, WS_K = 144 * MiB, WS_V = 176 * MiB, WS_END = 208 * MiB;
constexpr size_t WS_ACT = WS_Q;
static_assert(WS_ACT + (size_t)M * DFF * 2 <= WS_END, "act overlay");
constexpr int RING_BYTES = 131072;
constexpr int EPI_OFF = RING_BYTES;
constexpr int MISC_OFF = RING_BYTES + 8192;
constexpr int LDS_BYTES = 147456;
static_assert(MISC_OFF + 128 <= LDS_BYTES, "LDS map");

#define GAS __attribute__((address_space(1)))
#define LAS __attribute__((address_space(3)))
typedef unsigned short bf16;
typedef unsigned v4u __attribute__((ext_vector_type(4)));
typedef unsigned v2u __attribute__((ext_vector_type(2)));
typedef float f32x4 __attribute__((ext_vector_type(4)));
typedef GAS unsigned gu32;
#define RLX_AGENT __ATOMIC_RELAXED, __HIP_MEMORY_SCOPE_AGENT
#define LDS_WAIT() asm volatile("s_waitcnt lgkmcnt(0)" ::: "memory")
#define VM_WAIT() asm volatile("s_waitcnt vmcnt(0)" ::: "memory")
__device__ __forceinline__ unsigned f2bf(float f) { unsigned u = __builtin_bit_cast(unsigned, f); return (u + 0x7fffu + ((u >> 16) & 1u)) >> 16; }
__device__ __forceinline__ unsigned pk2(float lo, float hi) { return f2bf(lo) | (f2bf(hi) << 16); }

#define XB_TMO      128
#define XB_XCNT(j)  (256  + 64 * (j))
#define XB_XSUB(j)  (1280 + 64 * (j))
#define XB_XGEN(j)  (2304 + 64 * (j))
#define XB_TOP      3328
#define XB_TOPGEN   3392
#define XCD_BAR_WORDS 3456
#define XB_SPIN_CAP (1u << 18)

__device__ __forceinline__ unsigned xb_ld(unsigned* p)              { return __hip_atomic_load(p, __ATOMIC_RELAXED, __HIP_MEMORY_SCOPE_AGENT); }
__device__ __forceinline__ unsigned xb_add(unsigned* p, unsigned v) { return __hip_atomic_fetch_add(p, v, __ATOMIC_RELAXED, __HIP_MEMORY_SCOPE_AGENT); }
__device__ __forceinline__ unsigned xb_xcc_id() { return (unsigned)__builtin_amdgcn_s_getreg((3 << 11) | 20) & 0xFu; }
#define XB_SPIN(cond, bar) do { unsigned _sp = 0; while (cond) { __builtin_amdgcn_s_sleep(1); \
    if ((++_sp & 255u) == 0u) { if (xb_ld(&(bar)[XB_TMO])) break; if (_sp > XB_SPIN_CAP) { atomicAdd(&(bar)[XB_TMO], 1u); break; } } } } while (0)

struct XcdBarrier {
    unsigned* bar; unsigned x;
    volatile LAS unsigned* st;
};

__device__ __forceinline__ XcdBarrier xcd_barrier_post(unsigned* bar, volatile LAS unsigned* st) {
    XcdBarrier b; b.bar = bar; b.x = xb_xcc_id(); b.st = st;
    if (threadIdx.x == 0) (void)xb_add(&bar[XB_XCNT(b.x)], 1u);
    return b;
}
__device__ __forceinline__ void xcd_barrier_complete(unsigned* bar, unsigned x, unsigned& nloc, unsigned& nx) {
    const unsigned G = gridDim.x * gridDim.y * gridDim.z;
    unsigned sum, cnt, mine, sp = 0u;
    for (;;) {
        sum = 0u; cnt = 0u; mine = 0u;
#pragma unroll
        for (unsigned j = 0; j < 16; ++j) { const unsigned c = xb_ld(&bar[XB_XCNT(j)]); sum += c; cnt += (c > 0u) ? 1u : 0u; mine = (j == x) ? c : mine; }
        if (sum == G) break;
        __builtin_amdgcn_s_sleep(1);
        if ((++sp & 255u) == 0u) { if (xb_ld(&bar[XB_TMO])) break; if (sp > XB_SPIN_CAP) { atomicAdd(&bar[XB_TMO], 1u); break; } }
    }
    nloc = mine > 0u ? mine : 1u; nx = cnt > 0u ? cnt : 1u;
}

__device__ __forceinline__ void xcd_barrier(const XcdBarrier& b) {
    asm volatile("s_waitcnt vmcnt(0)" ::: "memory");
    __syncthreads();
    if (threadIdx.x == 0) {
        unsigned* bar = b.bar;
        __builtin_amdgcn_s_waitcnt(0);
        unsigned nloc = b.st[0], nx = b.st[1];
        if (nloc == 0u) { xcd_barrier_complete(bar, b.x, nloc, nx); b.st[0] = nloc; b.st[1] = nx; }
        const unsigned old = xb_add(&bar[XB_XSUB(b.x)], 1u);
        const unsigned gen = old / nloc;
        if (old + 1u == (gen + 1u) * nloc) {
            __builtin_amdgcn_fence(__ATOMIC_RELEASE, "agent");
            asm volatile("s_waitcnt vmcnt(0)" ::: "memory");
            const unsigned og = xb_add(&bar[XB_TOP], 1u);
            const unsigned tg = og / nx;
            if (og + 1u == (tg + 1u) * nx) xb_add(&bar[XB_TOPGEN], 1u);
            else XB_SPIN(xb_ld(&bar[XB_TOPGEN]) == tg, bar);
            __builtin_amdgcn_fence(__ATOMIC_ACQUIRE, "agent");
            xb_add(&bar[XB_XGEN(b.x)], 1u);
            asm volatile("s_waitcnt vmcnt(0)" ::: "memory");
        } else {
            XB_SPIN(xb_ld(&bar[XB_XGEN(b.x)]) == gen, bar);
            __builtin_amdgcn_fence(__ATOMIC_ACQUIRE, "agent");
            asm volatile("s_waitcnt vmcnt(0)" ::: "memory");
        }
    }
    __syncthreads();
}


struct Frame {
    LAS unsigned char* lds;
    volatile LAS unsigned* MISC;
    int tid, lane, wave, vcu, G;
};
__device__ __forceinline__ float wave_sum(float v) {
#pragma unroll
    for (int o = 1; o < 64; o <<= 1) v += __shfl_xor(v, o);
    return v;
}
__device__ const float FREQ_A[8] = {1.000000000e+00f, 1.939227432e-01f, 3.760603070e-02f, 7.292664610e-03f, 1.414213562e-03f, 2.742481884e-04f, 5.318296098e-05f, 1.031338616e-05f};
__device__ const float FREQ_B[32] = {1.000000000e+00f, 7.498942614e-01f, 5.623413324e-01f, 4.216965139e-01f, 3.162277639e-01f, 2.371373773e-01f, 1.778279394e-01f, 1.333521307e-01f, 1.000000015e-01f, 7.498941571e-02f, 5.623413250e-02f, 4.216965288e-02f, 3.162277490e-02f, 2.371373773e-02f, 1.778279431e-02f, 1.333521493e-02f, 9.999999776e-03f, 7.498941850e-03f, 5.623413250e-03f, 4.216964822e-03f, 3.162277630e-03f, 2.371373586e-03f, 1.778279431e-03f, 1.333521446e-03f, 1.000000047e-03f, 7.498942432e-04f, 5.623413017e-04f, 4.216965172e-04f, 3.162277571e-04f, 2.371373703e-04f, 1.778279402e-04f, 1.333521504e-04f};
__device__ __forceinline__ void sincos_acc(float a, float& c, float& s) {
    const double TWO_PI = 6.283185307179586476925286766559, x0 = (double)a;
    const double n = __builtin_rint(x0 * (1.0 / TWO_PI)), x = x0 - n * TWO_PI, x2 = x * x;
    double ts = 1.0, tc = 1.0;
#pragma unroll
    for (int k = 14; k >= 1; --k) { ts = 1.0 - x2 * ts * (1.0 / (double)((2 * k) * (2 * k + 1))); tc = 1.0 - x2 * tc * (1.0 / (double)((2 * k - 1) * (2 * k))); }
    s = (float)(x * ts); c = (float)tc;
}
__device__ __forceinline__ int colmap(int kind, int n) {
    if (kind == 1) { if (n >= 2048) return n; const int p = n & 63, d = p < 16 ? ((p & 1) ? (p >> 1) + 8 : (p >> 1)) : p; return (n & ~63) + d; }
    if (kind == 2) { if (n >= 1280) return n; const int p = n & 127, pr = p >> 1, first = pr < 32 ? pr : pr + 32; return (n & ~127) + ((p & 1) ? first + 32 : first); }
    if (kind == 3) { const int t = n >> 8, r = n & 255; return r < 128 ? t * 128 + r : DFF + t * 128 + (r - 128); }
    return n;
}
__device__ __forceinline__ void transpose_item(const float* W, int K, int N, bf16* WT, int kind, LAS float* scr, int item, int lane) {
    const int nblk = N / 32, kb = item / nblk, nb = item % nblk, k0 = 64 * kb, n0 = 32 * nb;
    const int src = colmap(kind, n0 + (lane & 31));
#pragma unroll 8
    for (int i = 0; i < 32; ++i) { const int kk = 2 * i + (lane >> 5); scr[kk * 33 + (lane & 31)] = W[(size_t)(k0 + kk) * N + src]; }
    LDS_WAIT(); asm volatile("" ::: "memory");
    const int c = lane & 7;
#pragma unroll
    for (int j = 0; j < 4; ++j) { const int n = (lane >> 3) + 8 * j; const LAS float* s = scr + (8 * c) * 33 + n;
        v4u o; o.x = pk2(s[0 * 33], s[1 * 33]); o.y = pk2(s[2 * 33], s[3 * 33]); o.z = pk2(s[4 * 33], s[5 * 33]); o.w = pk2(s[6 * 33], s[7 * 33]);
        *(GAS v4u*)(WT + (size_t)(n0 + n) * K + k0 + 8 * c) = o; }
    LDS_WAIT(); asm volatile("" ::: "memory");
}
struct Args { const float* in[20]; float* out; unsigned char* ws; int ph_lo, ph_hi; };

__device__ __forceinline__ void p0_prologue(Frame& F, const Args& a) {
    unsigned char* ws = a.ws;
    {
        LAS float* scr = (LAS float*)(F.lds + F.wave * 16384);
        const int gw = F.vcu * NWAVES + F.wave, NGW = F.G * NWAVES;
        constexpr int I0 = (DM / 64) * (3072 / 32), I1 = (DM / 64) * (DM / 32), I2 = (DM / 64) * (2 * DFF / 32), I3 = (DFF / 64) * (DM / 32), I4 = (DM / 64) * (1536 / 32);
        constexpr int NITEMS = I0 + I1 + I2 + I3 + I4 + I1 + I2 + I3;
        for (int it = gw; it < NITEMS; it += NGW) {
            int r = it;
            if (r < I0) { transpose_item(a.in[6], DM, 3072, (bf16*)(ws + WS_WAQKV), 1, scr, r, F.lane); continue; } r -= I0;
            if (r < I1) { transpose_item(a.in[7], DM, DM, (bf16*)(ws + WS_WAO), 0, scr, r, F.lane); continue; } r -= I1;
            if (r < I2) { transpose_item(a.in[17], DM, 2 * DFF, (bf16*)(ws + WS_WIN0), 3, scr, r, F.lane); continue; } r -= I2;
            if (r < I3) { transpose_item(a.in[18], DFF, DM, (bf16*)(ws + WS_WOUT0), 0, scr, r, F.lane); continue; } r -= I3;
            if (r < I4) { transpose_item(a.in[13], DM, 1536, (bf16*)(ws + WS_WBQKV), 2, scr, r, F.lane); continue; } r -= I4;
            if (r < I1) { transpose_item(a.in[14], DM, DM, (bf16*)(ws + WS_WBO), 0, scr, r, F.lane); continue; } r -= I1;
            if (r < I2) { transpose_item(a.in[17] + (size_t)DM * 2 * DFF, DM, 2 * DFF, (bf16*)(ws + WS_WIN1), 3, scr, r, F.lane); continue; } r -= I2;
            transpose_item(a.in[18] + (size_t)DFF * DM, DFF, DM, (bf16*)(ws + WS_WOUT1), 0, scr, r, F.lane);
        }
    }
    __syncthreads();
    {
        LAS float* cond = (LAS float*)F.lds;
        LAS float* part = (LAS float*)(F.lds + 16384);
        const float* c = a.in[1]; float* mod = (float*)(ws + WS_MOD);
        for (int i = F.tid; i < BATCH * DM; i += NWAVES * 64) { const float v = c[i]; cond[i] = v / (1.0f + __expf(-v)); }
        __syncthreads();
        for (int task = F.vcu; task < 2 * (MODW / 64); task += F.G) {
            const int L = task / (MODW / 64), n0 = (task % (MODW / 64)) * 64;
            const float* W = a.in[2] + (size_t)L * DM * MODW + n0 + F.lane;
            float acc0 = 0.f, acc1 = 0.f, acc2 = 0.f, acc3 = 0.f;
            const int kb = F.wave * 128;
#pragma unroll 8
            for (int k = 0; k < 128; ++k) { const float w = W[(size_t)(kb + k) * MODW];
                acc0 += cond[kb + k] * w; acc1 += cond[DM + kb + k] * w; acc2 += cond[2 * DM + kb + k] * w; acc3 += cond[3 * DM + kb + k] * w; }
            part[(F.wave * 4 + 0) * 64 + F.lane] = acc0; part[(F.wave * 4 + 1) * 64 + F.lane] = acc1; part[(F.wave * 4 + 2) * 64 + F.lane] = acc2; part[(F.wave * 4 + 3) * 64 + F.lane] = acc3;
            __syncthreads();
            if (F.tid < 256) { const int b = F.tid >> 6, l = F.tid & 63; float s = 0.f;
#pragma unroll
                for (int w = 0; w < 8; ++w) s += part[(w * 4 + b) * 64 + l];
                mod[((size_t)L * BATCH + b) * MODW + n0 + l] = s + a.in[3][(size_t)L * MODW + n0 + l]; }
            __syncthreads();
        }
    }
    {
        float* csa = (float*)(ws + WS_CSA); float* csb = (float*)(ws + WS_CSB);
        if (F.vcu == 0 && F.tid < 256) ((float*)(ws + WS_GQK))[F.tid] = F.tid < 128 ? a.in[15][F.tid] : a.in[16][F.tid - 128];
        for (int e = F.vcu * (NWAVES * 64) + F.tid; e < SEQ * 8 + 64 * 32; e += F.G * NWAVES * 64) {
            float cc, ss;
            if (e < SEQ * 8) { const int t = e >> 3, i = e & 7; sincos_acc((float)t * FREQ_A[i], cc, ss); csa[t * 16 + i] = cc; csa[t * 16 + 8 + i] = ss; }
            else { const int e2 = e - SEQ * 8, p = e2 >> 5, i = e2 & 31; sincos_acc((float)p * FREQ_B[i], cc, ss); csb[p * 64 + i] = cc; csb[p * 64 + 32 + i] = ss; }
        }
    }
}
__device__ __forceinline__ void norm_rows(Frame& F, const float* x, const float* g, const float* shift, const float* scale, bf16* h) {
    const int gw = F.vcu * NWAVES + F.wave, NGW = F.G * NWAVES;
    for (int m = gw; m < M; m += NGW) {
        const GAS f32x4* xr = (const GAS f32x4*)(x + (size_t)m * DM) + F.lane;
        f32x4 v[4]; float s = 0.f;
#pragma unroll
        for (int j = 0; j < 4; ++j) { v[j] = xr[64 * j]; s += (v[j].x * v[j].x + v[j].y * v[j].y) + (v[j].z * v[j].z + v[j].w * v[j].w); }
        const float rstd = 1.0f / sqrtf(wave_sum(s) * (1.f / DM) + EPS);
        const int b = m / SEQ; const float* sh = shift + (size_t)b * MODW; const float* sc = scale + (size_t)b * MODW;
        GAS v2u* o8 = (GAS v2u*)(h + (size_t)m * DM) + F.lane;
#pragma unroll
        for (int j = 0; j < 4; ++j) { const int col = 4 * F.lane + 256 * j;
            const f32x4 gg = *(const f32x4*)(g + col), s1 = *(const f32x4*)(sc + col), s0 = *(const f32x4*)(sh + col);
            const f32x4 y = ((v[j] * rstd) * gg) * (s1 + 1.0f) + s0;
            v2u w; w.x = pk2(y.x, y.y); w.y = pk2(y.z, y.w); o8[64 * j] = w; }
    }
}
__device__ __forceinline__ void final_norm(Frame& F, float* x, const float* g) {
    const int gw = F.vcu * NWAVES + F.wave, NGW = F.G * NWAVES;
    for (int m = gw; m < M; m += NGW) {
        GAS f32x4* xr = (GAS f32x4*)(x + (size_t)m * DM) + F.lane;
        f32x4 v[4]; float s = 0.f;
#pragma unroll
        for (int j = 0; j < 4; ++j) { v[j] = xr[64 * j]; s += (v[j].x * v[j].x + v[j].y * v[j].y) + (v[j].z * v[j].z + v[j].w * v[j].w); }
        const float rstd = 1.0f / sqrtf(wave_sum(s) * (1.f / DM) + EPS);
#pragma unroll
        for (int j = 0; j < 4; ++j) { const f32x4 gg = *(const f32x4*)(g + 4 * F.lane + 256 * j); xr[64 * j] = (v[j] * rstd) * gg; }
    }
}
__device__ __forceinline__ void attn_phase_A(Frame& F, const bf16* Q, const bf16* K, const bf16* V, bf16* O, float* scr, const float* lq1, const float* lk1, const float* lq2, const float* lk2, const float* subg) {
    const float lam = __expf(wave_sum(lq1[F.lane] * lk1[F.lane])) - __expf(wave_sum(lq2[F.lane] * lk2[F.lane])) + LAM_INIT0;
    const int wid = F.wave;
    LAS char* lds = (LAS char*)F.lds;
    constexpr float C = 0.125f * 1.4426950408889634f;
    for (int uid = F.vcu; uid < 512; uid += F.G) {
        const int bh = (uid & 255) >> 3, qb = ((uid & 7) << 1) | (uid >> 8), b = bh >> 3, h = bh & 7;
        const size_t row0 = (size_t)b * SEQ + (size_t)qb * 256, krow0 = (size_t)b * SEQ;
#pragma unroll 1
        for (int c = 0; c < 2; ++c) {
            att::f32x16 o[4];
            att::attn_core<64, 1024>(Q + row0 * DM + h * 128 + c * 64, K + krow0 * DM + h * 128 + c * 64, V + krow0 * DM + h * 128, lds, C, o);
            int ln = threadIdx.x & 63; asm volatile("" : "+v"(ln));
            att::f32x4v* sw = (att::f32x4v*)scr + ((size_t)(uid * 8 + wid) * 16) * 64 + ln;
            if (c == 0) {
#pragma unroll
                for (int r = 0; r < 16; ++r) sw[r * 64] = (att::f32x4v){o[0][r], o[1][r], o[2][r], o[3][r]};
            } else {
                float gs[4];
#pragma unroll
                for (int d0 = 0; d0 < 4; ++d0) gs[d0] = subg[d0 * 32 + (ln & 31)] * (1.0f - LAM_INIT0);
#pragma unroll
                for (int r = 0; r < 16; ++r) { const att::f32x4v o0 = sw[r * 64]; float ss = 0.f;
#pragma unroll
                    for (int d0 = 0; d0 < 4; ++d0) { const float v = o0[d0] - lam * o[d0][r]; o[d0][r] = v; ss += v * v; }
                    ss += __shfl_xor(ss, 1); ss += __shfl_xor(ss, 2); ss += __shfl_xor(ss, 4); ss += __shfl_xor(ss, 8); ss += __shfl_xor(ss, 16);
                    const float rs = 1.0f / sqrtf(ss * (1.0f / 128.0f) + EPS);
#pragma unroll
                    for (int d0 = 0; d0 < 4; ++d0) o[d0][r] *= rs * gs[d0];
                    if ((r & 3) == 3) asm volatile("" ::: "memory"); }
                __syncthreads();
                att::store_o(o, O + row0 * DM + h * 128, lds);
            }
        }
    }
}
__device__ __forceinline__ void attn_phase_B(Frame& F, const bf16* Q, const bf16* K, const bf16* V, bf16* O) {
    LAS char* lds = (LAS char*)F.lds;
    constexpr float C = 0.08838834764831845f * 1.4426950408889634f;
    for (int uid = F.vcu; uid < 512; uid += F.G) {
        const int grp = (uid & 255) >> 5, w = ((uid & 31) << 1) | (uid >> 8), b = grp >> 1, kvh = grp & 1, hq = kvh * 4 + (w >> 4), qb = w & 15;
        const size_t row0 = (size_t)b * SEQ + (size_t)qb * 256, krow0 = (size_t)b * SEQ;
        att::f32x16 o[4];
        att::attn_core<128, 256>(Q + row0 * DM + hq * 128, K + krow0 * 256 + kvh * 128, V + krow0 * 256 + kvh * 128, lds, C, o);
        __syncthreads();
        att::store_o(o, O + row0 * DM + hq * 128, lds);
    }
}

#ifndef PHMASK
#define PHMASK 0xFFFF
#endif
#define KIND(b) (((PHMASK) >> (b)) & 1)
constexpr bool USE_BAR = (MK_N_LAUNCHES != NPHASE);
#define IN(k) (lo <= (k) && (k) < hi)
#define SEAM(k) do { if (USE_BAR && IN((k) + 1)) xcd_barrier(bar); } while (0)
__device__ __forceinline__ void refresh(Frame& F) { int t = threadIdx.x; asm volatile("" : "+v"(t)); F.tid = t; F.lane = t & 63; F.wave = __builtin_amdgcn_readfirstlane(t >> 6); }

template <int L>
__device__ __forceinline__ void layer_phases(Frame& F, const Args& args, const int lo, const int hi, const XcdBarrier& bar) {
    constexpr int pb = 1 + 7 * L;
    unsigned char* ws = args.ws;
    const float* x = args.in[0]; float* out = args.out;
    const float* modL = (const float*)(ws + WS_MOD) + (size_t)L * BATCH * MODW;
    const float* xin = (L == 0) ? x : (const float*)out;
    bf16 *H = (bf16*)(ws + WS_H), *O = (bf16*)(ws + WS_O), *Qb = (bf16*)(ws + WS_Q), *Kb = (bf16*)(ws + WS_K), *Vb = (bf16*)(ws + WS_V), *ACT = (bf16*)(ws + WS_ACT);
    if (KIND(1) && IN(pb)) { refresh(F); norm_rows(F, xin, args.in[4] + L * DM, modL, modL + DM, H); SEAM(pb); }
    if (IN(pb + 1)) {
        if constexpr (L == 0) { if (KIND(2)) { pg8::Gemm g{H, (const bf16*)(ws + WS_WAQKV), M, 3072, DM}; pg8::StaticOrder S; S.init(M, 3072, F.G, (int)blockIdx.x);
            pg8::EpiQkvA E{Qb, (size_t)(WS_K - WS_Q) / 2, (const float*)(ws + WS_CSA)};
            pg8::gemm_phase<pg8::EpiQkvA, pg8::StaticOrder, true, true>(F.lds, g, S, E); } }
        else { if (KIND(3)) { pg8::Gemm g{H, (const bf16*)(ws + WS_WBQKV), M, 1536, DM}; pg8::StaticOrder S; S.init(M, 1536, F.G, (int)blockIdx.x);
            pg8::EpiQkvB E{Qb, (size_t)(WS_K - WS_Q) / 2, (const float*)(ws + WS_GQK), (const float*)(ws + WS_CSB), (LAS float*)(F.lds + EPI_OFF)};
            pg8::gemm_phase<pg8::EpiQkvB, pg8::StaticOrder, true, true>(F.lds, g, S, E); } }
        SEAM(pb + 1);
    }
    if (IN(pb + 2)) {
        refresh(F);
        if constexpr (L == 0) { if (KIND(4)) attn_phase_A(F, Qb, Kb, Vb, O, out, args.in[8], args.in[9], args.in[10], args.in[11], args.in[12]); }
        else { if (KIND(5)) attn_phase_B(F, Qb, Kb, Vb, O); }
        SEAM(pb + 2);
    }
    if (KIND(6) && IN(pb + 3)) { pg8::Gemm g{O, (const bf16*)(ws + (L == 0 ? WS_WAO : WS_WBO)), M, DM, DM}; pg8::StaticOrder S; S.init(M, DM, F.G, (int)blockIdx.x);
        pg8::EpiResid E{xin, out, modL + 2 * DM};
        pg8::gemm_phase<pg8::EpiResid, pg8::StaticOrder, true, true>(F.lds, g, S, E);
        SEAM(pb + 3); }
    if (KIND(7) && IN(pb + 4)) { refresh(F); norm_rows(F, out, args.in[5] + L * DM, modL + 3 * DM, modL + 4 * DM, H); SEAM(pb + 4); }
    if (KIND(8) && IN(pb + 5)) { pg8::Gemm g{H, (const bf16*)(ws + (L == 0 ? WS_WIN0 : WS_WIN1)), M, 2 * DFF, DM}; pg8::StaticOrder S; S.init(M, 2 * DFF, F.G, (int)blockIdx.x);
        pg8::EpiSwiglu E{ACT, DFF};
        pg8::gemm_phase<pg8::EpiSwiglu, pg8::StaticOrder, true, true>(F.lds, g, S, E);
        SEAM(pb + 5); }
    if (KIND(9) && IN(pb + 6)) { pg8::Gemm g{ACT, (const bf16*)(ws + (L == 0 ? WS_WOUT0 : WS_WOUT1)), M, DM, DFF}; pg8::StaticOrder S; S.init(M, DM, F.G, (int)blockIdx.x);
        pg8::EpiResid E{out, out, modL + 5 * DM};
        pg8::gemm_phase<pg8::EpiResid, pg8::StaticOrder, true, true>(F.lds, g, S, E);
        SEAM(pb + 6); }
}

__global__ void __launch_bounds__(NWAVES * 64, 2) mk_fwd(Args args) {
    extern __shared__ __attribute__((aligned(16))) unsigned char lds[];
    Frame F;
    F.lds = (LAS unsigned char*)lds;
    F.MISC = (volatile LAS unsigned*)(F.lds + MISC_OFF);
    F.tid = threadIdx.x; F.lane = F.tid & 63; F.wave = __builtin_amdgcn_readfirstlane(F.tid >> 6);
    F.G = gridDim.x; { const int bx = blockIdx.x; F.vcu = (F.G % 8 == 0) ? (bx % 8) * (F.G / 8) + bx / 8 : bx; }
    if (F.tid < 32) F.MISC[F.tid] = 0u;
    __syncthreads();
    const int lo = args.ph_lo, hi = args.ph_hi;
    XcdBarrier bar; bar.bar = (unsigned*)(args.ws + WS_CTL); bar.x = 0; bar.st = nullptr;
    if (USE_BAR) bar = xcd_barrier_post((unsigned*)(args.ws + WS_CTL), F.MISC + 8);
    if (KIND(0) && IN(0)) { p0_prologue(F, args); SEAM(0); }
    layer_phases<0>(F, args, lo, hi, bar);
    layer_phases<1>(F, args, lo, hi, bar);
    if (KIND(10) && IN(15)) { refresh(F); final_norm(F, args.out, args.in[19]); }
}
#undef IN
#undef SEAM

extern "C" void kernel_launch(void* const* d_in, const int* in_sizes, int n_in, void* d_out, int out_size, void* d_ws, size_t ws_size, hipStream_t stream) {
    static int grid = 0;
    if (grid == 0) {
        if (n_in != 20 || in_sizes[0] != M * DM || out_size != M * DM || ws_size < WS_END) { fprintf(stderr, "kernel_launch: unexpected shapes (n_in %d, in0 %d, out %d, ws %zu)\n", n_in, n_in > 0 ? in_sizes[0] : -1, out_size, ws_size); grid = -1; return; }
        int dev = 0, cus = 0, per_cu = 0;
        if (hipGetDevice(&dev) != hipSuccess || hipDeviceGetAttribute(&cus, hipDeviceAttributeMultiprocessorCount, dev) != hipSuccess) { grid = -1; return; }
        if (hipFuncSetAttribute((const void*)mk_fwd, hipFuncAttributeMaxDynamicSharedMemorySize, LDS_BYTES) != hipSuccess) { fprintf(stderr, "kernel_launch: hipFuncSetAttribute failed\n"); grid = -1; return; }
        if (hipOccupancyMaxActiveBlocksPerMultiprocessor(&per_cu, (const void*)mk_fwd, NWAVES * 64, LDS_BYTES) != hipSuccess || per_cu < 1) { fprintf(stderr, "kernel_launch: occupancy query says %d blocks per CU\n", per_cu); grid = -1; (void)hipGetLastError(); return; }
        grid = cus;
    }
    if (grid < 0) return;
    if (hipMemsetAsync((char*)d_ws + WS_CTL, 0, CTL_ZERO_BYTES, stream) != hipSuccess) return;
    Args a{};
    for (int i = 0; i < 20; ++i) a.in[i] = (const float*)d_in[i];
    a.out = (float*)d_out; a.ws = (unsigned char*)d_ws;
    constexpr int NL = MK_N_LAUNCHES;
    for (int li = 0; li < NL; ++li) {
        a.ph_lo = li * NPHASE / NL; a.ph_hi = (li + 1) * NPHASE / NL;
        hipLaunchKernelGGL(mk_fwd, dim3(grid), dim3(NWAVES * 64), LDS_BYTES, stream, a);
        const hipError_t le = hipPeekAtLastError();
        if (le != hipSuccess) { fprintf(stderr, "kernel_launch: launch %d failed: %s\n", li, hipGetErrorName(le)); break; }
    }
}
```

```cpp
#include <hip/hip_runtime.h>
#include <hip/hip_bf16.h>
#include <cstdio>
#include <cstdint>
namespace pg8 {
#define PG8_LAS __attribute__((address_space(3)))
typedef unsigned short bf16_t;
typedef short bf16x8 __attribute__((ext_vector_type(8)));
typedef float f32x4 __attribute__((ext_vector_type(4)));
typedef unsigned u32x4 __attribute__((ext_vector_type(4)));
constexpr int BM = 256, BK = 64, HALF = 128, HTB = HALF * BK * 2  , STAGE_BYTES = 8 * HTB, NXCD = 8, WGM = 8;

__host__ __device__ __forceinline__ int lds_byte(int r, int c) { const int st = (r >> 4) * 2 + (c >> 5), rr = r & 15, cc = c & 31, ob = rr * 64 + cc * 2; return st * 1024 + (ob ^ (((ob >> 9) & 1) << 5)); }
__host__ __device__ __forceinline__ void stage_rc(int b, int& R, int& C) { const int st = b / 1024, sb = b % 1024, swz = sb ^ (((sb >> 9) & 1) << 5); R = (st >> 1) * 16 + swz / 64; C = (st & 1) * 32 + (swz % 64) / 2; }
__host__ __device__ __forceinline__ int perm32(int rho) { const int n = rho >> 4, i = rho & 15; return 8 * (i >> 2) + 4 * n + (i & 3); }

struct Unit { int pm, pn; };
struct Gemm { const bf16_t* A; const bf16_t* Bt; int M, N, K; };

struct StaticOrder {
    int nM, nN, nwg, G, c;
    __host__ __device__ void init(int M, int N, int G_, int c_) { nM = M / BM; nN = N / BM; nwg = nM * nN; G = G_; c = c_; }
    __host__ __device__ bool next(int i, Unit& u) const {
        const long L = (long)i * G + c; if (L >= nwg) return false;
        int wgid = (int)L; { const int q = nwg / NXCD, r = nwg % NXCD, xcd = wgid % NXCD, off = wgid / NXCD; wgid = (xcd < r ? xcd * (q + 1) : r * (q + 1) + (xcd - r) * q) + off; }
        const int nig = WGM * nN, gid = wgid / nig, fm = gid * WGM, gsz = (nM - fm) < WGM ? (nM - fm) : WGM;
        u.pm = fm + ((wgid % nig) % gsz); u.pn = (wgid % nig) / gsz; return true;
    }
    __device__ __forceinline__ void a_ready(const Unit&) const {}
    __device__ __forceinline__ void done(const Unit&) const {}
};


__device__ __forceinline__ unsigned cvt_pk_bf16(float lo, float hi) { unsigned r; asm volatile("v_cvt_pk_bf16_f32 %0, %1, %2" : "=v"(r) : "v"(lo), "v"(hi)); return r; }
constexpr int SEQ_ = 4096, DM_ = 1024, MODW_ = 6144;
constexpr float EPS_ = 1e-6f;
typedef unsigned u32x2 __attribute__((ext_vector_type(2)));

__device__ __forceinline__ void rot4(f32x4& v0, f32x4& v1, const f32x4 c, const f32x4 s) {
    f32x4 r0, r1;
    r0[0] = v0[0] * c[0] - v0[1] * s[0]; r0[1] = v0[1] * c[0] + v0[0] * s[0]; r0[2] = v0[2] * c[1] - v0[3] * s[1]; r0[3] = v0[3] * c[1] + v0[2] * s[1];
    r1[0] = v1[0] * c[2] - v1[1] * s[2]; r1[1] = v1[1] * c[2] + v1[0] * s[2]; r1[2] = v1[2] * c[3] - v1[3] * s[3]; r1[3] = v1[3] * c[3] + v1[2] * s[3];
    v0 = r0; v1 = r1;
}

struct EpiQkvA {
    static constexpr bool PERM = true, AFTER_DRAIN = false;
    bf16_t* Q; size_t tstride; const float* cs;
    __device__ __forceinline__ void operator()(const f32x4 (&acc)[2][2][4][2], const Unit& u, int wr, int wc, int fr, int fq) const {
        const int t3 = u.pn >> 2; bf16_t* base = Q + (size_t)t3 * tstride;
        const int col0 = (u.pn & 3) * BM + wc * 32 + 8 * fq, row0 = u.pm * BM + wr * 64 + fr;
        const bool rope = (t3 < 2) && ((wc & 1) == 0) && (fq < 2);
#pragma unroll
        for (int ai = 0; ai < 2; ++ai)
#pragma unroll
            for (int m = 0; m < 4; ++m) { const int row = row0 + ai * HALF + m * 16, t = row & (SEQ_ - 1);
                f32x4 cv = (f32x4){1.f, 1.f, 1.f, 1.f}, sv = (f32x4){0.f, 0.f, 0.f, 0.f};
                if (rope) { cv = *(const f32x4*)(cs + t * 16 + 4 * fq); sv = *(const f32x4*)(cs + t * 16 + 8 + 4 * fq); }
                bf16_t* rowp = base + (size_t)row * DM_ + col0;
#pragma unroll
                for (int bj = 0; bj < 2; ++bj) { f32x4 v0 = acc[ai][bj][m][0], v1 = acc[ai][bj][m][1];
                    rot4(v0, v1, cv, sv);
                    u32x4 w; w.x = cvt_pk_bf16(v0[0], v0[1]); w.y = cvt_pk_bf16(v0[2], v0[3]); w.z = cvt_pk_bf16(v1[0], v1[1]); w.w = cvt_pk_bf16(v1[2], v1[3]);
                    *(u32x4*)(rowp + bj * HALF) = w; } }
    }
};

struct EpiQkvB {
    static constexpr bool PERM = true, AFTER_DRAIN = false;
    const float* stat; const float* bias;
    bf16_t* Q; size_t tstride; const float* gtab; const float* cs2;
    PG8_LAS float* scr;
    __device__ __forceinline__ void operator()(f32x4 (&acc)[2][2][4][2], const Unit& u, int wr, int wc, int fr, int fq) const {
        const int pn = u.pn; const bool nrm = pn < 5;
        bf16_t* base = Q + (size_t)(pn < 4 ? 0 : pn - 3) * tstride; const int ld = pn < 4 ? DM_ : 256; const float* g = gtab + (pn < 4 ? 0 : 128);
        const int col0 = (pn < 4 ? pn * BM : 0) + wc * 32 + 8 * fq, row0 = u.pm * BM + wr * 64 + fr;
        {
            const float* bp = bias + ((u.pm * BM) / SEQ_) * 1536 + pn * BM + wc * 32 + 8 * fq;
            f32x4 bv[2][2];
#pragma unroll
            for (int bj = 0; bj < 2; ++bj) { bv[bj][0] = *(const f32x4*)(bp + bj * HALF); bv[bj][1] = *(const f32x4*)(bp + bj * HALF + 4); }
#pragma unroll
            for (int ai = 0; ai < 2; ++ai)
#pragma unroll
                for (int m = 0; m < 4; ++m) { const f32x4 st = *(const f32x4*)(stat + (size_t)(row0 + ai * HALF + m * 16) * 4);
                    const float rr = __builtin_amdgcn_rsqf(((st[0] + st[1]) + (st[2] + st[3])) * (1.0f / DM_) + EPS_);
#pragma unroll
                    for (int bj = 0; bj < 2; ++bj) { acc[ai][bj][m][0] = acc[ai][bj][m][0] * rr + bv[bj][0]; acc[ai][bj][m][1] = acc[ai][bj][m][1] * rr + bv[bj][1]; } }
        }
        if (nrm) {
#pragma unroll
            for (int ai = 0; ai < 2; ++ai)
#pragma unroll
                for (int m = 0; m < 4; ++m)
#pragma unroll
                    for (int bj = 0; bj < 2; ++bj) { const f32x4 a = acc[ai][bj][m][0], b = acc[ai][bj][m][1];
                        float ss = (a[0] * a[0] + a[1] * a[1]) + (a[2] * a[2] + a[3] * a[3]) + (b[0] * b[0] + b[1] * b[1]) + (b[2] * b[2] + b[3] * b[3]);
                        ss += __shfl_xor(ss, 16); ss += __shfl_xor(ss, 32);
                        if (fq == 0) scr[((ai * HALF + wr * 64 + m * 16 + fr) * 2 + bj) * 4 + wc] = ss; }
            asm volatile("s_waitcnt lgkmcnt(0)" ::: "memory"); __builtin_amdgcn_s_barrier(); asm volatile("" ::: "memory");
        }
        const int f0 = 16 * (wc & 1) + 4 * fq, d1 = (wc < 2 ? 16 * wc : 16 * wc + 32) + 4 * fq;
        f32x4 g1 = (f32x4){1.f, 1.f, 1.f, 1.f}, g2 = g1;
        if (nrm) { g1 = *(const f32x4*)(g + d1); g2 = *(const f32x4*)(g + d1 + 32); }
#pragma unroll
        for (int ai = 0; ai < 2; ++ai)
#pragma unroll
            for (int m = 0; m < 4; ++m) { const int row = row0 + ai * HALF + m * 16, t = row & (SEQ_ - 1), pos = wc < 2 ? (t >> 6) : (t & 63);
                f32x4 cv = (f32x4){1.f, 1.f, 1.f, 1.f}, sv = (f32x4){0.f, 0.f, 0.f, 0.f};
                if (nrm) { cv = *(const f32x4*)(cs2 + pos * 64 + f0); sv = *(const f32x4*)(cs2 + pos * 64 + 32 + f0); }
                bf16_t* rowp = base + (size_t)row * ld + col0;
#pragma unroll
                for (int bj = 0; bj < 2; ++bj) { f32x4 v0 = acc[ai][bj][m][0], v1 = acc[ai][bj][m][1];
                    if (nrm) { const f32x4 p = *(const PG8_LAS f32x4*)(scr + ((ai * HALF + wr * 64 + m * 16 + fr) * 2 + bj) * 4);
                        const float rs = __builtin_amdgcn_rsqf(((p[0] + p[1]) + (p[2] + p[3])) * (1.0f / 128.0f) + EPS_);
                        v0[0] *= rs * g1[0]; v0[1] *= rs * g2[0]; v0[2] *= rs * g1[1]; v0[3] *= rs * g2[1]; v1[0] *= rs * g1[2]; v1[1] *= rs * g2[2]; v1[2] *= rs * g1[3]; v1[3] *= rs * g2[3];
                        rot4(v0, v1, cv, sv); }
                    u32x4 w; w.x = cvt_pk_bf16(v0[0], v0[1]); w.y = cvt_pk_bf16(v0[2], v0[3]); w.z = cvt_pk_bf16(v1[0], v1[1]); w.w = cvt_pk_bf16(v1[2], v1[3]);
                    *(u32x4*)(rowp + bj * HALF) = w; } }
    }
};

template <bool EMIT> struct EpiResid {
    static constexpr bool PERM = false, AFTER_DRAIN = false;
    const float* base; float* out; const float* gate;
    const float* g; const float* scale; bf16_t* xm; float* stat; PG8_LAS float* scr;
    __device__ __forceinline__ void operator()(const f32x4 (&acc)[2][2][4][2], const Unit& u, int wr, int wc, int fr, int fq) const {
        const int col0 = u.pn * BM + wc * 32 + 4 * fq, row0 = u.pm * BM + wr * 64 + fr, b = (u.pm * BM) / SEQ_;
        f32x4 gv[2][2], mv[2][2];
#pragma unroll
        for (int bj = 0; bj < 2; ++bj)
#pragma unroll
            for (int n = 0; n < 2; ++n) { gv[bj][n] = *(const f32x4*)(gate + b * MODW_ + col0 + bj * HALF + n * 16);
                if (EMIT) mv[bj][n] = *(const f32x4*)(g + col0 + bj * HALF + n * 16) * (*(const f32x4*)(scale + b * MODW_ + col0 + bj * HALF + n * 16) + 1.0f); }
#pragma unroll
        for (int ai = 0; ai < 2; ++ai)
#pragma unroll
            for (int m = 0; m < 4; ++m) { const size_t off = (size_t)(row0 + ai * HALF + m * 16) * DM_ + col0; float ss = 0.f;
#pragma unroll
                for (int bj = 0; bj < 2; ++bj)
#pragma unroll
                    for (int n = 0; n < 2; ++n) { const f32x4 bs = *(const f32x4*)(base + off + bj * HALF + n * 16); const f32x4 o = bs + gv[bj][n] * acc[ai][bj][m][n];
                        *(f32x4*)(out + off + bj * HALF + n * 16) = o;
                        if (EMIT) { ss += (o[0] * o[0] + o[1] * o[1]) + (o[2] * o[2] + o[3] * o[3]); const f32x4 a = o * mv[bj][n];
                            u32x2 w; w.x = cvt_pk_bf16(a[0], a[1]); w.y = cvt_pk_bf16(a[2], a[3]); *(u32x2*)(xm + off + bj * HALF + n * 16) = w; } }
                if (EMIT) { ss += __shfl_xor(ss, 16); ss += __shfl_xor(ss, 32); if (fq == 0) scr[(ai * HALF + wr * 64 + m * 16 + fr) * 4 + wc] = ss; }
                if (m & 1) asm volatile("" ::: "memory"); }
        if (EMIT) {
            asm volatile("s_waitcnt lgkmcnt(0)" ::: "memory"); __builtin_amdgcn_s_barrier(); asm volatile("" ::: "memory");
            const int t = (wr * 4 + wc) * 64 + (fq * 16 + fr);
            if (t < BM) { const f32x4 p = *(const PG8_LAS f32x4*)(scr + t * 4); stat[(size_t)(u.pm * BM + t) * 4 + u.pn] = (p[0] + p[1]) + (p[2] + p[3]); }
        }
    }
};

struct EpiSwiglu {
    static constexpr bool PERM = true, AFTER_DRAIN = false;
    bf16_t* O; int ldo; const float* stat; const float* bias;
    __device__ __forceinline__ static float sw(float g, float up) { return g * __builtin_amdgcn_rcpf(1.0f + __builtin_amdgcn_exp2f(g * -1.4426950408889634f)) * up; }
    __device__ __forceinline__ void operator()(const f32x4 (&acc)[2][2][4][2], const Unit& u, int wr, int wc, int fr, int fq) const {
        const int col0 = u.pn * HALF + wc * 32 + 8 * fq, row0 = u.pm * BM + wr * 64 + fr;
        const float* bp = bias + ((u.pm * BM) / SEQ_) * (2 * ldo) + u.pn * BM + wc * 32 + 8 * fq;
        const f32x4 bg0 = *(const f32x4*)(bp), bg1 = *(const f32x4*)(bp + 4), bu0 = *(const f32x4*)(bp + HALF), bu1 = *(const f32x4*)(bp + HALF + 4);
#pragma unroll
        for (int ai = 0; ai < 2; ++ai)
#pragma unroll
            for (int m = 0; m < 4; ++m) { const f32x4 st = *(const f32x4*)(stat + (size_t)(row0 + ai * HALF + m * 16) * 4);
                const float rr = __builtin_amdgcn_rsqf(((st[0] + st[1]) + (st[2] + st[3])) * (1.0f / DM_) + EPS_);
                const f32x4 g0 = acc[ai][0][m][0] * rr + bg0, g1 = acc[ai][0][m][1] * rr + bg1, u0 = acc[ai][1][m][0] * rr + bu0, u1 = acc[ai][1][m][1] * rr + bu1;
                u32x4 w; w.x = cvt_pk_bf16(sw(g0[0], u0[0]), sw(g0[1], u0[1])); w.y = cvt_pk_bf16(sw(g0[2], u0[2]), sw(g0[3], u0[3]));
                w.z = cvt_pk_bf16(sw(g1[0], u1[0]), sw(g1[1], u1[1])); w.w = cvt_pk_bf16(sw(g1[2], u1[2]), sw(g1[3], u1[3]));
                *(u32x4*)(O + (size_t)(row0 + ai * HALF + m * 16) * ldo + col0) = w; }
    }
};

template <class Epi, class Sched, bool ALIGN_EPI = false, bool SP2 = false>
__device__ __forceinline__ void gemm_phase(PG8_LAS unsigned char* lds, const Gemm g, const Sched& S, const Epi& E) {
    int tid_ = threadIdx.x; asm volatile("" : "+v"(tid_));
    const int tid = tid_, wid = __builtin_amdgcn_readfirstlane(tid >> 6), lane = tid & 63, wr = wid >> 2, wc = wid & 3, fr = lane & 15, fq = lane >> 4;
    const int K = g.K, nt = K / BK;
    unsigned voffA[2], voffB[2];
#pragma unroll
    for (int i = 0; i < 2; ++i) { int R, C; stage_rc(tid * 16 + i * 8192, R, C); const int Rb = Epi::PERM ? ((R & ~31) + perm32(R & 31)) : R;
        voffA[i] = (unsigned)(R * K + C) * 2u; voffB[i] = (unsigned)(Rb * K + C) * 2u; }
    const size_t kstep = (size_t)(BK * 2);
    const size_t hstep = (size_t)HALF * K * 2;
    const size_t tstep = 2 * hstep;
    const unsigned ldsw = (unsigned)wid * 1024u;
    const int aoff = lds_byte(wr * 64 + fr, fq * 8), boff = lds_byte(wc * 32 + fr, fq * 8);
#define PG8_SA(b, h) (((b) * 2 + (h)) * HTB)
#define PG8_SB(b, h) ((4 + (b) * 2 + (h)) * HTB)
#define PG8_STAGE(bufoff, gbase, voff) do { _Pragma("unroll") for (int _i = 0; _i < 2; ++_i) \
        __builtin_amdgcn_global_load_lds((const unsigned*)((const char*)(gbase) + (voff)[_i]), (PG8_LAS unsigned*)(lds + (bufoff) + ldsw + _i * 8192), 16, 0, 0); } while (0)
#define PG8_LDA(dst, b, h) do { _Pragma("unroll") for (int m = 0; m < 4; ++m) _Pragma("unroll") for (int k = 0; k < 2; ++k) dst[m][k] = *(const PG8_LAS bf16x8*)(lds + PG8_SA(b, h) + aoff + m * 2048 + k * 1024); } while (0)
#define PG8_LDB(dst, b, h) do { _Pragma("unroll") for (int n = 0; n < 2; ++n) _Pragma("unroll") for (int k = 0; k < 2; ++k) dst[n][k] = *(const PG8_LAS bf16x8*)(lds + PG8_SB(b, h) + boff + n * 2048 + k * 1024); } while (0)
#define PG8_MMA(ai, bj, At, Bt) do { __builtin_amdgcn_s_setprio(1); _Pragma("unroll") for (int m = 0; m < 4; ++m) _Pragma("unroll") for (int n = 0; n < 2; ++n) _Pragma("unroll") for (int k = 0; k < 2; ++k) \
        acc[ai][bj][m][n] = __builtin_amdgcn_mfma_f32_16x16x32_bf16(Bt[n][k], At[m][k], acc[ai][bj][m][n], 0, 0, 0); __builtin_amdgcn_s_setprio(0); } while (0)
#define PG8_WAIT_V(n) asm volatile("s_waitcnt vmcnt(" #n ")" ::: "memory")
#define PG8_WAIT_L(n) asm volatile("s_waitcnt lgkmcnt(" #n ")" ::: "memory")
#define PG8_BAR __builtin_amdgcn_s_barrier()
#define PG8_SCHED __builtin_amdgcn_sched_barrier(0)
    Unit cur, nxt; int ui = 0;
    if (!S.next(0, cur)) return;
    f32x4 acc[2][2][4][2];
#pragma unroll
    for (int a = 0; a < 2; ++a)
#pragma unroll
        for (int b = 0; b < 2; ++b)
#pragma unroll
            for (int m = 0; m < 4; ++m)
#pragma unroll
                for (int n = 0; n < 2; ++n) acc[a][b][m][n] = (f32x4){0.f, 0.f, 0.f, 0.f};
    bf16x8 At[4][2], B0[2][2], B1[2][2];
    const char* cA = (const char*)g.A + (size_t)cur.pm * tstep; const char* cB = (const char*)g.Bt + (size_t)cur.pn * tstep;
    S.a_ready(cur);
    if constexpr (SP2) {
        PG8_STAGE(PG8_SB(0, 0), cB, voffB); PG8_STAGE(PG8_SB(0, 1), cB + hstep, voffB); PG8_STAGE(PG8_SA(0, 0), cA, voffA); PG8_STAGE(PG8_SA(0, 1), cA + hstep, voffA);
        if (wr == 1) PG8_BAR;
        PG8_WAIT_V(2); PG8_BAR;
        PG8_STAGE(PG8_SB(1, 0), cB + kstep, voffB); PG8_STAGE(PG8_SA(1, 0), cA + kstep, voffA); PG8_STAGE(PG8_SB(1, 1), cB + hstep + kstep, voffB);
        PG8_WAIT_V(6); PG8_BAR;
    } else {
        PG8_STAGE(PG8_SB(0, 0), cB, voffB); PG8_STAGE(PG8_SA(0, 0), cA, voffA); PG8_STAGE(PG8_SB(0, 1), cB + hstep, voffB); PG8_STAGE(PG8_SA(0, 1), cA + hstep, voffA);
        if (wr == 1) PG8_BAR;
        PG8_WAIT_V(4); PG8_BAR;
        PG8_STAGE(PG8_SB(1, 0), cB + kstep, voffB); PG8_STAGE(PG8_SA(1, 0), cA + kstep, voffA); PG8_STAGE(PG8_SB(1, 1), cB + hstep + kstep, voffB);
        PG8_WAIT_V(6); PG8_BAR;
    }
    for (;;) {
        const bool has_next = S.next(ui + 1, nxt);
        const char* nA = has_next ? (const char*)g.A + (size_t)nxt.pm * tstep : cA; const char* nB = has_next ? (const char*)g.Bt + (size_t)nxt.pn * tstep : cB;
        for (int t = 0; t < nt; t += 2) {
            const bool last = (t == nt - 2);
            const char* a1 = cA + (size_t)(t + 1) * kstep;
            const char* a2 = last ? nA : cA + (size_t)(t + 2) * kstep; const char* b2 = last ? nB : cB + (size_t)(t + 2) * kstep;
            const char* a3 = a2 + kstep; const char* b3 = b2 + kstep;
            if (last && has_next) S.a_ready(nxt);
            if constexpr (SP2) {
            PG8_LDB(B0, 0, 0); PG8_LDB(B1, 0, 1); PG8_SCHED; PG8_LDA(At, 0, 0); PG8_STAGE(PG8_SA(1, 1), a1 + hstep, voffA);
            PG8_WAIT_V(8); PG8_WAIT_L(0); PG8_BAR; PG8_MMA(0, 0, At, B0); PG8_MMA(0, 1, At, B1); PG8_BAR; PG8_SCHED;
            PG8_LDA(At, 0, 1); PG8_STAGE(PG8_SB(0, 0), b2, voffB); PG8_STAGE(PG8_SB(0, 1), b2 + hstep, voffB); PG8_STAGE(PG8_SA(0, 0), a2, voffA);
            PG8_WAIT_V(8); PG8_WAIT_L(0); PG8_BAR; PG8_MMA(1, 0, At, B0); PG8_MMA(1, 1, At, B1); PG8_BAR; PG8_SCHED;
            PG8_LDB(B0, 1, 0); PG8_LDB(B1, 1, 1); PG8_SCHED; PG8_LDA(At, 1, 0); PG8_STAGE(PG8_SA(0, 1), a2 + hstep, voffA);
            PG8_WAIT_V(8); PG8_WAIT_L(0); PG8_BAR; PG8_MMA(0, 0, At, B0); PG8_MMA(0, 1, At, B1); PG8_BAR; PG8_SCHED;
            PG8_LDA(At, 1, 1); PG8_STAGE(PG8_SB(1, 0), b3, voffB); PG8_STAGE(PG8_SB(1, 1), b3 + hstep, voffB); PG8_STAGE(PG8_SA(1, 0), a3, voffA);
            PG8_WAIT_V(8); PG8_WAIT_L(0); PG8_BAR; PG8_MMA(1, 0, At, B0); PG8_MMA(1, 1, At, B1); PG8_BAR; PG8_SCHED;
            } else {
            PG8_LDB(B0, 0, 0); PG8_SCHED; PG8_LDA(At, 0, 0); PG8_STAGE(PG8_SA(1, 1), a1 + hstep, voffA);
            PG8_WAIT_L(8); PG8_BAR; PG8_WAIT_L(0); PG8_MMA(0, 0, At, B0); PG8_BAR; PG8_SCHED;
            PG8_LDB(B1, 0, 1); PG8_STAGE(PG8_SB(0, 0), b2, voffB);
            PG8_BAR; PG8_WAIT_L(0); PG8_MMA(0, 1, At, B1); PG8_BAR;
            PG8_LDA(At, 0, 1); PG8_STAGE(PG8_SA(0, 0), a2, voffA);
            PG8_BAR; PG8_WAIT_L(0); PG8_MMA(1, 0, At, B0); PG8_BAR; PG8_SCHED;
            PG8_STAGE(PG8_SB(0, 1), b2 + hstep, voffB);
            PG8_WAIT_V(6); PG8_BAR; PG8_MMA(1, 1, At, B1); PG8_BAR;
            PG8_LDB(B0, 1, 0); PG8_SCHED; PG8_LDA(At, 1, 0); PG8_STAGE(PG8_SA(0, 1), a2 + hstep, voffA);
            PG8_WAIT_L(8); PG8_BAR; PG8_WAIT_L(0); PG8_MMA(0, 0, At, B0); PG8_BAR; PG8_SCHED;
            PG8_LDB(B1, 1, 1); PG8_STAGE(PG8_SB(1, 0), b3, voffB);
            PG8_BAR; PG8_WAIT_L(0); PG8_MMA(0, 1, At, B1); PG8_BAR;
            PG8_LDA(At, 1, 1); PG8_STAGE(PG8_SA(1, 0), a3, voffA);
            PG8_BAR; PG8_WAIT_L(0); PG8_MMA(1, 0, At, B0); PG8_BAR; PG8_SCHED;
            PG8_STAGE(PG8_SB(1, 1), b3 + hstep, voffB);
            PG8_WAIT_V(6); PG8_BAR; PG8_MMA(1, 1, At, B1); PG8_BAR;
            }
        }
        if constexpr (ALIGN_EPI) { if (wr == 0) PG8_BAR; }
        if constexpr (!Epi::AFTER_DRAIN) { E(acc, cur, wr, wc, fr, fq); S.done(cur); }
        if (!has_next) break;
#pragma unroll
        for (int a = 0; a < 2; ++a)
#pragma unroll
            for (int b = 0; b < 2; ++b)
#pragma unroll
                for (int m = 0; m < 4; ++m)
#pragma unroll
                    for (int n = 0; n < 2; ++n) acc[a][b][m][n] = (f32x4){0.f, 0.f, 0.f, 0.f};
        cur = nxt; cA = nA; cB = nB; ++ui;
        if constexpr (ALIGN_EPI) { if (wr == 1) PG8_BAR; }
    }
    PG8_WAIT_V(0);
    if constexpr (!ALIGN_EPI) { if (wr == 0) PG8_BAR; }
    PG8_BAR;
    if constexpr (Epi::AFTER_DRAIN) { E.fused(acc, cur, wr, wc, fr, fq, lds, wid, lane); S.done(cur); }
#undef PG8_SA
#undef PG8_SB
#undef PG8_STAGE
#undef PG8_LDA
#undef PG8_LDB
#undef PG8_MMA
#undef PG8_WAIT_V
#undef PG8_WAIT_L
#undef PG8_BAR
#undef PG8_SCHED
}
}

namespace att {
#define ATT_LAS __attribute__((address_space(3)))
typedef unsigned short bf16_t;
using bf16x8 = __attribute__((ext_vector_type(8))) short;
using s16x4  = __attribute__((ext_vector_type(4))) short;
using f32x16 = __attribute__((ext_vector_type(16))) float;
using u32x4  = __attribute__((ext_vector_type(4))) unsigned;
using f32x4v = __attribute__((ext_vector_type(4))) float;
constexpr int NW = 8, QBLK = 32, KVBLK = 64, DV = 128, LDQ = 1024, SEQ = 4096;
constexpr int SHM_V = KVBLK * DV * 2, SHM_K = 16384;
constexpr int LDS_V = 0, LDS_K = 2 * SHM_V, LDS_WS = 2 * SHM_V + 2 * SHM_K, LDS_BYTES = LDS_WS + NW * 64 * 4;
#define ATT_SBAR() __builtin_amdgcn_sched_barrier(0)
__device__ __forceinline__ int crow(int r, int hi) { return (r & 3) + 8 * (r >> 2) + 4 * hi; }
__device__ __forceinline__ unsigned cvtpk(float lo, float hi) { unsigned r; asm volatile("v_cvt_pk_bf16_f32 %0, %1, %2" : "=v"(r) : "v"(lo), "v"(hi)); return r; }
template <int DQK> __device__ __forceinline__ int kswz(int row, int colB) {
  if constexpr (DQK == 128) return row * 256 + (colB ^ ((row & 7) << 4));
  else return row * 128 + (colB ^ (((row >> 1) & 7) << 4));
}
__device__ __forceinline__ void partialSM(f32x16& p0, f32x16& p1, float& m_reg, float& mn, float& alpha, const float C, const float thr_raw) {
  float pmax = p0[0];
#pragma unroll
  for (int r = 1; r < 16; ++r) pmax = fmaxf(pmax, p0[r]);
#pragma unroll
  for (int r = 0; r < 16; ++r) pmax = fmaxf(pmax, p1[r]);
  { auto rr = __builtin_amdgcn_permlane32_swap(__float_as_uint(pmax), __float_as_uint(pmax), false, false);
    pmax = fmaxf(__uint_as_float(rr[0]), __uint_as_float(rr[1])); }
  if (__builtin_expect(__all(pmax - m_reg <= thr_raw), 1)) { mn = m_reg; alpha = 1.f; }
  else { mn = fmaxf(m_reg, pmax); alpha = __builtin_amdgcn_exp2f((m_reg - mn) * C); m_reg = mn; }
  const float mnC = -mn * C;
#pragma unroll
  for (int r = 0; r < 16; ++r) p0[r] = fmaf(p0[r], C, mnC);
#pragma unroll
  for (int r = 0; r < 16; ++r) p1[r] = fmaf(p1[r], C, mnC);
#pragma unroll
  for (int r = 0; r < 16; ++r) p0[r] = __builtin_amdgcn_exp2f(p0[r]);
}
__device__ __forceinline__ void finishSM(f32x16& p0, f32x16& p1, float alpha, float& l_reg, bf16x8& pa0, bf16x8& pa1, bf16x8& pa2, bf16x8& pa3) {
#pragma unroll
  for (int r = 0; r < 16; ++r) p1[r] = __builtin_amdgcn_exp2f(p1[r]);
  float ps = 0;
#pragma unroll
  for (int r = 0; r < 16; ++r) ps += p0[r];
#pragma unroll
  for (int r = 0; r < 16; ++r) ps += p1[r];
  { auto rr = __builtin_amdgcn_permlane32_swap(__float_as_uint(ps), __float_as_uint(ps), false, false);
    ps = __uint_as_float(rr[0]) + __uint_as_float(rr[1]); }
  l_reg = l_reg * alpha + ps;
#define ATT_PK4(P, BASE, OUT) do { unsigned a0 = cvtpk(P[BASE + 0], P[BASE + 1]), a1 = cvtpk(P[BASE + 2], P[BASE + 3]);   \
    unsigned b0 = cvtpk(P[BASE + 4], P[BASE + 5]), b1 = cvtpk(P[BASE + 6], P[BASE + 7]);                              \
    auto r0 = __builtin_amdgcn_permlane32_swap(a0, b0, false, false); auto r1 = __builtin_amdgcn_permlane32_swap(a1, b1, false, false); \
    u32x4 w = {r0[0], r1[0], r0[1], r1[1]}; OUT = __builtin_bit_cast(bf16x8, w); } while (0)
  ATT_PK4(p0, 0, pa0); ATT_PK4(p0, 8, pa1); ATT_PK4(p1, 0, pa2); ATT_PK4(p1, 8, pa3);
#undef ATT_PK4
}
template <int DQK> __device__ __forceinline__ void qkt(f32x16& p0, f32x16& p1, const ATT_LAS char* Ks, const bf16x8* qr, int r32, int hi) {
  p0 = f32x16{}; p1 = f32x16{};
#pragma unroll
  for (int d0 = 0; d0 < DQK / 16; ++d0) { const int cb = (d0 * 16 + hi * 8) * 2;
    const bf16x8 b0 = *reinterpret_cast<const ATT_LAS bf16x8*>(Ks + kswz<DQK>(r32, cb));
    const bf16x8 b1 = *reinterpret_cast<const ATT_LAS bf16x8*>(Ks + kswz<DQK>(32 + r32, cb));
    p0 = __builtin_amdgcn_mfma_f32_32x32x16_bf16(b0, qr[d0], p0, 0, 0, 0);
    p1 = __builtin_amdgcn_mfma_f32_32x32x16_bf16(b1, qr[d0], p1, 0, 0, 0); }
}
__device__ __forceinline__ int v_st(int k, int c) { const int kk = (k & ~0xC) | ((k & 4) << 1) | ((k & 8) >> 1); return ((kk >> 3) * 4 + (c >> 5)) * 512 + ((kk & 7) * 32 + (c & 31)) * 2; }
__device__ __forceinline__ int v_rd_base(int lane) { return ((lane & 3) << 3) | (((lane >> 2) & 3) << 6) | (((lane >> 4) & 1) << 5) | (((lane >> 5) & 1) << 8); }
constexpr int v_rd_off(int d0, int ks, int half) { return d0 * 512 + ks * 4096 + half * 2048; }
template <int OFF> __device__ __forceinline__ s16x4 tr_read(int vb) {
  s16x4 r; asm volatile("ds_read_b64_tr_b16 %0, %1 offset:%2" : "=&v"(r) : "v"(vb), "i"(OFF) : "memory"); return r;
}
template <int D0> __device__ __forceinline__ void pv_one(f32x16& od, int vb, bf16x8 pa0, bf16x8 pa1, bf16x8 pa2, bf16x8 pa3) {
  const s16x4 l0 = tr_read<v_rd_off(D0, 0, 0)>(vb), h0 = tr_read<v_rd_off(D0, 0, 1)>(vb), l1 = tr_read<v_rd_off(D0, 1, 0)>(vb), h1 = tr_read<v_rd_off(D0, 1, 1)>(vb);
  const s16x4 l2 = tr_read<v_rd_off(D0, 2, 0)>(vb), h2 = tr_read<v_rd_off(D0, 2, 1)>(vb), l3 = tr_read<v_rd_off(D0, 3, 0)>(vb), h3 = tr_read<v_rd_off(D0, 3, 1)>(vb);
  asm volatile("s_waitcnt lgkmcnt(0)" ::: "memory"); ATT_SBAR();
#define ATT_PK(L, H) (bf16x8){L[0], L[1], L[2], L[3], H[0], H[1], H[2], H[3]}
  od = __builtin_amdgcn_mfma_f32_32x32x16_bf16(pa0, ATT_PK(l0, h0), od, 0, 0, 0);
  od = __builtin_amdgcn_mfma_f32_32x32x16_bf16(pa1, ATT_PK(l1, h1), od, 0, 0, 0);
  od = __builtin_amdgcn_mfma_f32_32x32x16_bf16(pa2, ATT_PK(l2, h2), od, 0, 0, 0);
  od = __builtin_amdgcn_mfma_f32_32x32x16_bf16(pa3, ATT_PK(l3, h3), od, 0, 0, 0);
#undef ATT_PK
}
__device__ __forceinline__ void pv_d0(f32x16* o, int vb, bf16x8 pa0, bf16x8 pa1, bf16x8 pa2, bf16x8 pa3) {
  pv_one<0>(o[0], vb, pa0, pa1, pa2, pa3); pv_one<1>(o[1], vb, pa0, pa1, pa2, pa3); pv_one<2>(o[2], vb, pa0, pa1, pa2, pa3); pv_one<3>(o[3], vb, pa0, pa1, pa2, pa3);
}

template <int DQK, int LDKV>
__device__ __forceinline__ void attn_core(const bf16_t* Qb, const bf16_t* Kh, const bf16_t* Vh, ATT_LAS char* lds, const float C, f32x16 (&o)[4]) {
  int tid_ = threadIdx.x; asm volatile("" : "+v"(tid_));
  const int tid = tid_, lane = tid & 63, r32 = lane & 31, hi = lane >> 5; const int wid = __builtin_amdgcn_readfirstlane(tid >> 6);
  ATT_LAS char* V_lds = lds + LDS_V; ATT_LAS char* K_lds = lds + LDS_K;
  ATT_LAS float* ws = (ATT_LAS float*)(lds + LDS_WS) + wid * 64; ATT_LAS float* li_l = ws; ATT_LAS float* al_l = ws + 32;
  const float thr_raw = 8.0f * 1.4426950408889634f / C;
  float m_reg = -1e30f, l_reg = 0;
#pragma unroll
  for (int d = 0; d < 4; ++d) o[d] = f32x16{};
  bf16x8 qr[DQK / 16];
  const bf16_t* Qw = Qb + (long)(wid * QBLK + r32) * LDQ + hi * 8;
#pragma unroll
  for (int d0 = 0; d0 < DQK / 16; ++d0) qr[d0] = *reinterpret_cast<const bf16x8*>(Qw + d0 * 16);
  const int sr = tid >> 4, sc = (tid & 15) * 8, vst0 = v_st(sr, sc), vst1 = v_st(32 + sr, sc);
  const int kr = tid >> 3, kc = (tid & 7) * 8;
  const int vb0 = (int)(size_t)V_lds + v_rd_base(lane);
  struct Slot { bf16x8 vs0, vs1, ks0, ks1; } s0_, s1_;
#define ATT_SLOAD(S, k0) do { S.vs0 = *reinterpret_cast<const bf16x8*>(&Vh[(long)((k0) + sr) * LDKV + sc]); S.vs1 = *reinterpret_cast<const bf16x8*>(&Vh[(long)((k0) + 32 + sr) * LDKV + sc]); \
    if constexpr (DQK == 128) { S.ks0 = *reinterpret_cast<const bf16x8*>(&Kh[(long)((k0) + sr) * LDKV + sc]); S.ks1 = *reinterpret_cast<const bf16x8*>(&Kh[(long)((k0) + 32 + sr) * LDKV + sc]); } \
    else { S.ks0 = *reinterpret_cast<const bf16x8*>(&Kh[(long)((k0) + kr) * LDKV + kc]); } } while (0)
#define ATT_SWRITE(b, S) do { *(ATT_LAS bf16x8*)(V_lds + (b) * SHM_V + vst0) = S.vs0; *(ATT_LAS bf16x8*)(V_lds + (b) * SHM_V + vst1) = S.vs1; \
    if constexpr (DQK == 128) { *(ATT_LAS bf16x8*)(K_lds + (b) * SHM_K + kswz<128>(sr, sc * 2)) = S.ks0; *(ATT_LAS bf16x8*)(K_lds + (b) * SHM_K + kswz<128>(32 + sr, sc * 2)) = S.ks1; } \
    else { *(ATT_LAS bf16x8*)(K_lds + (b) * SHM_K + kswz<64>(kr, kc * 2)) = S.ks0; } } while (0)
#define ATT_SWAIT() do { if constexpr (DQK == 128) asm volatile("s_waitcnt vmcnt(4)" ::: "memory"); else asm volatile("s_waitcnt vmcnt(3)" ::: "memory"); } while (0)
#define ATT_RESC(a) do { if (__any((a) < 1.f)) { if (hi == 0) al_l[r32] = (a); asm volatile("s_waitcnt lgkmcnt(0)" ::: "memory"); \
    _Pragma("unroll") for (int d = 0; d < 4; ++d) _Pragma("unroll") for (int r = 0; r < 16; ++r) o[d][r] *= al_l[crow(r, hi)]; } } while (0)
  f32x16 pA0, pA1, pB0, pB1; float mnA, mnB, alA, alB; bf16x8 pa0, pa1, pa2, pa3; constexpr int NT = SEQ / KVBLK;
  ATT_SLOAD(s0_, 0); asm volatile("s_waitcnt vmcnt(0)" ::: "memory");
  __syncthreads();
  ATT_SWRITE(0, s0_); __syncthreads();
  qkt<DQK>(pA0, pA1, K_lds, qr, r32, hi); partialSM(pA0, pA1, m_reg, mnA, alA, C, thr_raw);
  ATT_SLOAD(s1_, KVBLK); ATT_SLOAD(s0_, 2 * KVBLK);
  ATT_SWAIT(); ATT_SWRITE(1, s1_); __syncthreads();
  for (int j = 1; j + 1 < NT; j += 2) {
    ATT_SBAR(); qkt<DQK>(pB0, pB1, K_lds + SHM_K, qr, r32, hi);
    finishSM(pA0, pA1, alA, l_reg, pa0, pa1, pa2, pa3); ATT_SBAR();
    ATT_SLOAD(s1_, (j + 2) * KVBLK); ATT_SBAR();
    pv_d0(o, vb0, pa0, pa1, pa2, pa3); partialSM(pB0, pB1, m_reg, mnB, alB, C, thr_raw);
    __syncthreads(); ATT_SWAIT(); ATT_SWRITE(0, s0_);
    ATT_RESC(alB); __syncthreads();
    ATT_SBAR(); qkt<DQK>(pA0, pA1, K_lds, qr, r32, hi);
    finishSM(pB0, pB1, alB, l_reg, pa0, pa1, pa2, pa3); ATT_SBAR();
    if (j + 3 < NT) ATT_SLOAD(s0_, (j + 3) * KVBLK); ATT_SBAR();
    pv_d0(o, vb0 + SHM_V, pa0, pa1, pa2, pa3); partialSM(pA0, pA1, m_reg, mnA, alA, C, thr_raw);
    __syncthreads(); ATT_SWAIT(); ATT_SWRITE(1, s1_);
    ATT_RESC(alA); __syncthreads();
  }
  ATT_SBAR(); qkt<DQK>(pB0, pB1, K_lds + SHM_K, qr, r32, hi);
  finishSM(pA0, pA1, alA, l_reg, pa0, pa1, pa2, pa3); ATT_SBAR();
  pv_d0(o, vb0, pa0, pa1, pa2, pa3); partialSM(pB0, pB1, m_reg, mnB, alB, C, thr_raw);
  __syncthreads(); ATT_RESC(alB);
  finishSM(pB0, pB1, alB, l_reg, pa0, pa1, pa2, pa3); ATT_SBAR();
  pv_d0(o, vb0 + SHM_V, pa0, pa1, pa2, pa3);
  if (hi == 0) li_l[r32] = l_reg; asm volatile("s_waitcnt lgkmcnt(0)" ::: "memory");
#pragma unroll
  for (int r = 0; r < 16; ++r) { const float rl = __builtin_amdgcn_rcpf(li_l[crow(r, hi)]);
#pragma unroll
    for (int d = 0; d < 4; ++d) o[d][r] *= rl; }
#undef ATT_SLOAD
#undef ATT_SWRITE
#undef ATT_SWAIT
#undef ATT_RESC
}
__device__ __forceinline__ void store_o(const f32x16 (&v)[4], bf16_t* Ob, ATT_LAS char* lds) {
  int tid_ = threadIdx.x; asm volatile("" : "+v"(tid_));
  const int tid = tid_, lane = tid & 63, r32 = lane & 31, hi = lane >> 5; const int wid = __builtin_amdgcn_readfirstlane(tid >> 6);
  ATT_LAS bf16_t* stg = (ATT_LAS bf16_t*)(lds + wid * 8192);
#pragma unroll
  for (int r = 0; r < 16; ++r) { const int orow = crow(r, hi);
#pragma unroll
    for (int d0 = 0; d0 < 4; ++d0) { const unsigned b = cvtpk(v[d0][r], 0.f); stg[orow * 128 + d0 * 32 + r32] = (bf16_t)(b & 0xffffu); } }
  asm volatile("s_waitcnt lgkmcnt(0)" ::: "memory");
#pragma unroll
  for (int i = 0; i < 8; ++i) { const int row = i * 4 + (lane >> 4), ch = lane & 15;
    const u32x4 w = *(const ATT_LAS u32x4*)(stg + row * 128 + ch * 8);
    *(u32x4*)(Ob + (long)(wid * QBLK + row) * 1024 + ch * 8) = w; }
}
}

constexpr int NWAVES = 8;
constexpr int BATCH = 4, SEQ = 4096, DM = 1024, M = BATCH * SEQ, DFF = 2816, MODW = 6 * DM;
constexpr float EPS = 1e-6f, LAM_INIT0 = 0.2f;
constexpr int NPHASE = 13;
#ifndef MK_N_LAUNCHES
#define MK_N_LAUNCHES 1
#endif
constexpr size_t MiB = 1u << 20;
constexpr size_t WS_CTL = 0, CTL_ZERO_BYTES = 64 * 1024;
constexpr size_t WS_BIAS = 256 * 1024;
constexpr size_t WS_STAT = 1 * MiB + 768 * 1024;
constexpr size_t WS_MOD = 1 * MiB;
constexpr size_t WS_CSA = 1 * MiB + 256 * 1024;
constexpr size_t WS_CSB = 1 * MiB + 512 * 1024;
constexpr size_t WS_GQK = WS_CSB + 16384;
constexpr size_t WS_WAQKV = 2 * MiB, WS_WAO = 8 * MiB, WS_WIN0 = 10 * MiB, WS_WOUT0 = 21 * MiB;
constexpr size_t WS_WBQKV = 26 * MiB + 512 * 1024, WS_WBO = 29 * MiB + 512 * 1024, WS_WIN1 = 31 * MiB + 512 * 1024, WS_WOUT1 = 42 * MiB + 512 * 1024;
constexpr size_t WS_H = 48 * MiB, WS_O = 80 * MiB, WS_Q = 112 * MiB, WS_K = 144 * MiB, WS_V = 176 * MiB, WS_END = 208 * MiB;
constexpr size_t WS_ACT = WS_Q;
static_assert(WS_ACT + (size_t)M * DFF * 2 <= WS_END, "act overlay");
constexpr int RING_BYTES = 131072;
constexpr int EPI_OFF = RING_BYTES;
constexpr int MISC_OFF = RING_BYTES + 8192;
constexpr int LDS_BYTES = 147456;
static_assert(MISC_OFF + 128 <= LDS_BYTES, "LDS map");

#define GAS __attribute__((address_space(1)))
#define LAS __attribute__((address_space(3)))
typedef unsigned short bf16;
typedef unsigned v4u __attribute__((ext_vector_type(4)));
typedef unsigned v2u __attribute__((ext_vector_type(2)));
typedef float f32x4 __attribute__((ext_vector_type(4)));
typedef GAS unsigned gu32;
#define RLX_AGENT __ATOMIC_RELAXED, __HIP_MEMORY_SCOPE_AGENT
#define LDS_WAIT() asm volatile("s_waitcnt lgkmcnt(0)" ::: "memory")
#define VM_WAIT() asm volatile("s_waitcnt vmcnt(0)" ::: "memory")
__device__ __forceinline__ unsigned f2bf(float f) { unsigned u = __builtin_bit_cast(unsigned, f); return (u + 0x7fffu + ((u >> 16) & 1u)) >> 16; }
__device__ __forceinline__ unsigned pk2(float lo, float hi) { return f2bf(lo) | (f2bf(hi) << 16); }

#define XB_TMO      128
#define XB_XCNT(j)  (256  + 64 * (j))
#define XB_XSUB(j)  (1280 + 64 * (j))
#define XB_XGEN(j)  (2304 + 64 * (j))
#define XB_TOP      3328
#define XB_TOPGEN   3392
#define XCD_BAR_WORDS 3456
#define XB_SPIN_CAP (1u << 18)

__device__ __forceinline__ unsigned xb_ld(unsigned* p)              { return __hip_atomic_load(p, __ATOMIC_RELAXED, __HIP_MEMORY_SCOPE_AGENT); }
__device__ __forceinline__ unsigned xb_add(unsigned* p, unsigned v) { return __hip_atomic_fetch_add(p, v, __ATOMIC_RELAXED, __HIP_MEMORY_SCOPE_AGENT); }
__device__ __forceinline__ unsigned xb_xcc_id() { return (unsigned)__builtin_amdgcn_s_getreg((3 << 11) | 20) & 0xFu; }
#define XB_SPIN(cond, bar) do { unsigned _sp = 0; while (cond) { __builtin_amdgcn_s_sleep(1); \
    if ((++_sp & 255u) == 0u) { if (xb_ld(&(bar)[XB_TMO])) break; if (_sp > XB_SPIN_CAP) { atomicAdd(&(bar)[XB_TMO], 1u); break; } } } } while (0)

struct XcdBarrier {
    unsigned* bar; unsigned x;
    volatile LAS unsigned* st;
};

__device__ __forceinline__ XcdBarrier xcd_barrier_post(unsigned* bar, volatile LAS unsigned* st) {
    XcdBarrier b; b.bar = bar; b.x = xb_xcc_id(); b.st = st;
    if (threadIdx.x == 0) (void)xb_add(&bar[XB_XCNT(b.x)], 1u);
    return b;
}
__device__ __forceinline__ void xcd_barrier_complete(unsigned* bar, unsigned x, unsigned& nloc, unsigned& nx) {
    const unsigned G = gridDim.x * gridDim.y * gridDim.z;
    unsigned sum, cnt, mine, sp = 0u;
    for (;;) {
        sum = 0u; cnt = 0u; mine = 0u;
#pragma unroll
        for (unsigned j = 0; j < 16; ++j) { const unsigned c = xb_ld(&bar[XB_XCNT(j)]); sum += c; cnt += (c > 0u) ? 1u : 0u; mine = (j == x) ? c : mine; }
        if (sum == G) break;
        __builtin_amdgcn_s_sleep(1);
        if ((++sp & 255u) == 0u) { if (xb_ld(&bar[XB_TMO])) break; if (sp > XB_SPIN_CAP) { atomicAdd(&bar[XB_TMO], 1u); break; } }
    }
    nloc = mine > 0u ? mine : 1u; nx = cnt > 0u ? cnt : 1u;
}

__device__ __forceinline__ void xcd_barrier(const XcdBarrier& b) {
    asm volatile("s_waitcnt vmcnt(0)" ::: "memory");
    __syncthreads();
    if (threadIdx.x == 0) {
        unsigned* bar = b.bar;
        __builtin_amdgcn_s_waitcnt(0);
        unsigned nloc = b.st[0], nx = b.st[1];
        if (nloc == 0u) { xcd_barrier_complete(bar, b.x, nloc, nx); b.st[0] = nloc; b.st[1] = nx; }
        const unsigned old = xb_add(&bar[XB_XSUB(b.x)], 1u);
        const unsigned gen = old / nloc;
        if (old + 1u == (gen + 1u) * nloc) {
            __builtin_amdgcn_fence(__ATOMIC_RELEASE, "agent");
            asm volatile("s_waitcnt vmcnt(0)" ::: "memory");
            const unsigned og = xb_add(&bar[XB_TOP], 1u);
            const unsigned tg = og / nx;
            if (og + 1u == (tg + 1u) * nx) xb_add(&bar[XB_TOPGEN], 1u);
            else XB_SPIN(xb_ld(&bar[XB_TOPGEN]) == tg, bar);
            __builtin_amdgcn_fence(__ATOMIC_ACQUIRE, "agent");
            xb_add(&bar[XB_XGEN(b.x)], 1u);
            asm volatile("s_waitcnt vmcnt(0)" ::: "memory");
        } else {
            XB_SPIN(xb_ld(&bar[XB_XGEN(b.x)]) == gen, bar);
            __builtin_amdgcn_fence(__ATOMIC_ACQUIRE, "agent");
            asm volatile("s_waitcnt vmcnt(0)" ::: "memory");
        }
    }
    __syncthreads();
}


struct Frame {
    LAS unsigned char* lds;
    volatile LAS unsigned* MISC;
    int tid, lane, wave, vcu, G;
};
__device__ __forceinline__ float wave_sum(float v) {
#pragma unroll
    for (int o = 1; o < 64; o <<= 1) v += __shfl_xor(v, o);
    return v;
}
__device__ const float FREQ_A[8] = {1.000000000e+00f, 1.939227432e-01f, 3.760603070e-02f, 7.292664610e-03f, 1.414213562e-03f, 2.742481884e-04f, 5.318296098e-05f, 1.031338616e-05f};
__device__ const float FREQ_B[32] = {1.000000000e+00f, 7.498942614e-01f, 5.623413324e-01f, 4.216965139e-01f, 3.162277639e-01f, 2.371373773e-01f, 1.778279394e-01f, 1.333521307e-01f, 1.000000015e-01f, 7.498941571e-02f, 5.623413250e-02f, 4.216965288e-02f, 3.162277490e-02f, 2.371373773e-02f, 1.778279431e-02f, 1.333521493e-02f, 9.999999776e-03f, 7.498941850e-03f, 5.623413250e-03f, 4.216964822e-03f, 3.162277630e-03f, 2.371373586e-03f, 1.778279431e-03f, 1.333521446e-03f, 1.000000047e-03f, 7.498942432e-04f, 5.623413017e-04f, 4.216965172e-04f, 3.162277571e-04f, 2.371373703e-04f, 1.778279402e-04f, 1.333521504e-04f};
__device__ __forceinline__ void sincos_acc(float a, float& c, float& s) {
    const double TWO_PI = 6.283185307179586476925286766559, x0 = (double)a;
    const double n = __builtin_rint(x0 * (1.0 / TWO_PI)), x = x0 - n * TWO_PI, x2 = x * x;
    double ts = 1.0, tc = 1.0;
#pragma unroll
    for (int k = 14; k >= 1; --k) { ts = 1.0 - x2 * ts * (1.0 / (double)((2 * k) * (2 * k + 1))); tc = 1.0 - x2 * tc * (1.0 / (double)((2 * k - 1) * (2 * k))); }
    s = (float)(x * ts); c = (float)tc;
}
__device__ __forceinline__ int colmap(int kind, int n) {
    if (kind == 1) { if (n >= 2048) return n; const int p = n & 63, d = p < 16 ? ((p & 1) ? (p >> 1) + 8 : (p >> 1)) : p; return (n & ~63) + d; }
    if (kind == 2) { if (n >= 1280) return n; const int p = n & 127, pr = p >> 1, first = pr < 32 ? pr : pr + 32; return (n & ~127) + ((p & 1) ? first + 32 : first); }
    if (kind == 3) { const int t = n >> 8, r = n & 255; return r < 128 ? t * 128 + r : DFF + t * 128 + (r - 128); }
    return n;
}
__device__ __forceinline__ void transpose_item(const float* W, int K, int N, bf16* WT, int kind, LAS float* scr, int item, int lane) {
    const int nblk = N / 32, kb = item / nblk, nb = item % nblk, k0 = 64 * kb, n0 = 32 * nb;
    const int src = colmap(kind, n0 + (lane & 31));
#pragma unroll 8
    for (int i = 0; i < 32; ++i) { const int kk = 2 * i + (lane >> 5); scr[kk * 33 + (lane & 31)] = W[(size_t)(k0 + kk) * N + src]; }
    LDS_WAIT(); asm volatile("" ::: "memory");
    const int c = lane & 7;
#pragma unroll
    for (int j = 0; j < 4; ++j) { const int n = (lane >> 3) + 8 * j; const LAS float* s = scr + (8 * c) * 33 + n;
        v4u o; o.x = pk2(s[0 * 33], s[1 * 33]); o.y = pk2(s[2 * 33], s[3 * 33]); o.z = pk2(s[4 * 33], s[5 * 33]); o.w = pk2(s[6 * 33], s[7 * 33]);
        *(GAS v4u*)(WT + (size_t)(n0 + n) * K + k0 + 8 * c) = o; }
    LDS_WAIT(); asm volatile("" ::: "memory");
}
struct Args { const float* in[20]; float* out; unsigned char* ws; int ph_lo, ph_hi; };

__device__ __forceinline__ void p0_prologue(Frame& F, const Args& a) {
    unsigned char* ws = a.ws;
    {
        LAS float* scr = (LAS float*)(F.lds + F.wave * 16384);
        const int gw = F.vcu * NWAVES + F.wave, NGW = F.G * NWAVES;
        constexpr int I0 = (DM / 64) * (3072 / 32), I1 = (DM / 64) * (DM / 32), I2 = (DM / 64) * (2 * DFF / 32), I3 = (DFF / 64) * (DM / 32), I4 = (DM / 64) * (1536 / 32);
        constexpr int NITEMS = I0 + I1 + I2 + I3 + I4 + I1 + I2 + I3;
        for (int it = gw; it < NITEMS; it += NGW) {
            int r = it;
            if (r < I0) { transpose_item(a.in[6], DM, 3072, (bf16*)(ws + WS_WAQKV), 1, scr, r, F.lane); continue; } r -= I0;
            if (r < I1) { transpose_item(a.in[7], DM, DM, (bf16*)(ws + WS_WAO), 0, scr, r, F.lane); continue; } r -= I1;
            if (r < I2) { transpose_item(a.in[17], DM, 2 * DFF, (bf16*)(ws + WS_WIN0), 3, scr, r, F.lane); continue; } r -= I2;
            if (r < I3) { transpose_item(a.in[18], DFF, DM, (bf16*)(ws + WS_WOUT0), 0, scr, r, F.lane); continue; } r -= I3;
            if (r < I4) { transpose_item(a.in[13], DM, 1536, (bf16*)(ws + WS_WBQKV), 2, scr, r, F.lane); continue; } r -= I4;
            if (r < I1) { transpose_item(a.in[14], DM, DM, (bf16*)(ws + WS_WBO), 0, scr, r, F.lane); continue; } r -= I1;
            if (r < I2) { transpose_item(a.in[17] + (size_t)DM * 2 * DFF, DM, 2 * DFF, (bf16*)(ws + WS_WIN1), 3, scr, r, F.lane); continue; } r -= I2;
            transpose_item(a.in[18] + (size_t)DFF * DM, DFF, DM, (bf16*)(ws + WS_WOUT1), 0, scr, r, F.lane);
        }
    }
    __syncthreads();
    {
        LAS float* cond = (LAS float*)F.lds;
        LAS float* part = (LAS float*)(F.lds + 16384);
        const float* c = a.in[1]; float* mod = (float*)(ws + WS_MOD);
        for (int i = F.tid; i < BATCH * DM; i += NWAVES * 64) { const float v = c[i]; cond[i] = v / (1.0f + __expf(-v)); }
        __syncthreads();
        for (int task = F.vcu; task < 2 * (MODW / 64); task += F.G) {
            const int L = task / (MODW / 64), n0 = (task % (MODW / 64)) * 64;
            const float* W = a.in[2] + (size_t)L * DM * MODW + n0 + F.lane;
            float acc0 = 0.f, acc1 = 0.f, acc2 = 0.f, acc3 = 0.f;
            const int kb = F.wave * 128;
#pragma unroll 8
            for (int k = 0; k < 128; ++k) { const float w = W[(size_t)(kb + k) * MODW];
                acc0 += cond[kb + k] * w; acc1 += cond[DM + kb + k] * w; acc2 += cond[2 * DM + kb + k] * w; acc3 += cond[3 * DM + kb + k] * w; }
            part[(F.wave * 4 + 0) * 64 + F.lane] = acc0; part[(F.wave * 4 + 1) * 64 + F.lane] = acc1; part[(F.wave * 4 + 2) * 64 + F.lane] = acc2; part[(F.wave * 4 + 3) * 64 + F.lane] = acc3;
            __syncthreads();
            if (F.tid < 256) { const int b = F.tid >> 6, l = F.tid & 63; float s = 0.f;
#pragma unroll
                for (int w = 0; w < 8; ++w) s += part[(w * 4 + b) * 64 + l];
                mod[((size_t)L * BATCH + b) * MODW + n0 + l] = s + a.in[3][(size_t)L * MODW + n0 + l]; }
            __syncthreads();
        }
    }
    {
        float* csa = (float*)(ws + WS_CSA); float* csb = (float*)(ws + WS_CSB);
        if (F.vcu == 0 && F.tid < 256) ((float*)(ws + WS_GQK))[F.tid] = F.tid < 128 ? a.in[15][F.tid] : a.in[16][F.tid - 128];
        for (int e = F.vcu * (NWAVES * 64) + F.tid; e < SEQ * 8 + 64 * 32; e += F.G * NWAVES * 64) {
            float cc, ss;
            if (e < SEQ * 8) { const int t = e >> 3, i = e & 7; sincos_acc((float)t * FREQ_A[i], cc, ss); csa[t * 16 + i] = cc; csa[t * 16 + 8 + i] = ss; }
            else { const int e2 = e - SEQ * 8, p = e2 >> 5, i = e2 & 31; sincos_acc((float)p * FREQ_B[i], cc, ss); csb[p * 64 + i] = cc; csb[p * 64 + 32 + i] = ss; }
        }
    }
}
__device__ __forceinline__ void bias_tasks(Frame& F, const Args& a) {
    unsigned char* ws = a.ws;
    LAS float* shl = (LAS float*)F.lds;
    LAS float* part = (LAS float*)(F.lds + 16384);
    const float* mod = (const float*)(ws + WS_MOD); float* bias = (float*)(ws + WS_BIAS);
    constexpr int T0 = 2 * DFF / 64, T1 = 1536 / 64;
    for (int task = F.vcu; task < 2 * T0 + T1; task += F.G) {
        const float* W; const float* sh; float* out; int N, kind, n0;
        if (task < T0) { W = a.in[17]; N = 2 * DFF; kind = 3; n0 = task * 64; sh = mod + 3 * DM; out = bias; }
        else if (task < T0 + T1) { W = a.in[13]; N = 1536; kind = 2; n0 = (task - T0) * 64; sh = mod + (size_t)BATCH * MODW; out = bias + 4 * 2 * DFF; }
        else { W = a.in[17] + (size_t)DM * 2 * DFF; N = 2 * DFF; kind = 3; n0 = (task - T0 - T1) * 64; sh = mod + (size_t)BATCH * MODW + 3 * DM; out = bias + 4 * 2 * DFF + 4 * 1536; }
        for (int i = F.tid; i < BATCH * DM; i += NWAVES * 64) shl[i] = sh[(size_t)(i >> 10) * MODW + (i & 1023)];
        __syncthreads();
        const float* Wc = W + colmap(kind, n0 + F.lane);
        float acc0 = 0.f, acc1 = 0.f, acc2 = 0.f, acc3 = 0.f;
        const int kb = F.wave * 128;
#pragma unroll 8
        for (int k = 0; k < 128; ++k) { const float w = Wc[(size_t)(kb + k) * N];
            acc0 += shl[kb + k] * w; acc1 += shl[DM + kb + k] * w; acc2 += shl[2 * DM + kb + k] * w; acc3 += shl[3 * DM + kb + k] * w; }
        part[(F.wave * 4 + 0) * 64 + F.lane] = acc0; part[(F.wave * 4 + 1) * 64 + F.lane] = acc1; part[(F.wave * 4 + 2) * 64 + F.lane] = acc2; part[(F.wave * 4 + 3) * 64 + F.lane] = acc3;
        __syncthreads();
        if (F.tid < 256) { const int b = F.tid >> 6, l = F.tid & 63; float s = 0.f;
#pragma unroll
            for (int w = 0; w < 8; ++w) s += part[(w * 4 + b) * 64 + l];
            out[(size_t)b * N + n0 + l] = s; }
        __syncthreads();
    }
}
__device__ __forceinline__ void norm_rows(Frame& F, const float* x, const float* g, const float* shift, const float* scale, bf16* h) {
    const int gw = F.vcu * NWAVES + F.wave, NGW = F.G * NWAVES;
    for (int m = gw; m < M; m += NGW) {
        const GAS f32x4* xr = (const GAS f32x4*)(x + (size_t)m * DM) + F.lane;
        f32x4 v[4]; float s = 0.f;
#pragma unroll
        for (int j = 0; j < 4; ++j) { v[j] = xr[64 * j]; s += (v[j].x * v[j].x + v[j].y * v[j].y) + (v[j].z * v[j].z + v[j].w * v[j].w); }
        const float rstd = 1.0f / sqrtf(wave_sum(s) * (1.f / DM) + EPS);
        const int b = m / SEQ; const float* sh = shift + (size_t)b * MODW; const float* sc = scale + (size_t)b * MODW;
        GAS v2u* o8 = (GAS v2u*)(h + (size_t)m * DM) + F.lane;
#pragma unroll
        for (int j = 0; j < 4; ++j) { const int col = 4 * F.lane + 256 * j;
            const f32x4 gg = *(const f32x4*)(g + col), s1 = *(const f32x4*)(sc + col), s0 = *(const f32x4*)(sh + col);
            const f32x4 y = ((v[j] * rstd) * gg) * (s1 + 1.0f) + s0;
            v2u w; w.x = pk2(y.x, y.y); w.y = pk2(y.z, y.w); o8[64 * j] = w; }
    }
}
__device__ __forceinline__ void final_norm(Frame& F, float* x, const float* g) {
    const int gw = F.vcu * NWAVES + F.wave, NGW = F.G * NWAVES;
    for (int m = gw; m < M; m += NGW) {
        GAS f32x4* xr = (GAS f32x4*)(x + (size_t)m * DM) + F.lane;
        f32x4 v[4]; float s = 0.f;
#pragma unroll
        for (int j = 0; j < 4; ++j) { v[j] = xr[64 * j]; s += (v[j].x * v[j].x + v[j].y * v[j].y) + (v[j].z * v[j].z + v[j].w * v[j].w); }
        const float rstd = 1.0f / sqrtf(wave_sum(s) * (1.f / DM) + EPS);
#pragma unroll
        for (int j = 0; j < 4; ++j) { const f32x4 gg = *(const f32x4*)(g + 4 * F.lane + 256 * j); xr[64 * j] = (v[j] * rstd) * gg; }
    }
}
__device__ __forceinline__ void attn_phase_A(Frame& F, const bf16* Q, const bf16* K, const bf16* V, bf16* O, float* scr, const float* lq1, const float* lk1, const float* lq2, const float* lk2, const float* subg) {
    const float lam = __expf(wave_sum(lq1[F.lane] * lk1[F.lane])) - __expf(wave_sum(lq2[F.lane] * lk2[F.lane])) + LAM_INIT0;
    const int wid = F.wave;
    LAS char* lds = (LAS char*)F.lds;
    constexpr float C = 0.125f * 1.4426950408889634f;
    for (int uid = F.vcu; uid < 512; uid += F.G) {
        const int bh = (uid & 255) >> 3, qb = ((uid & 7) << 1) | (uid >> 8), b = bh >> 3, h = bh & 7;
        const size_t row0 = (size_t)b * SEQ + (size_t)qb * 256, krow0 = (size_t)b * SEQ;
#pragma unroll 1
        for (int c = 0; c < 2; ++c) {
            att::f32x16 o[4];
            att::attn_core<64, 1024>(Q + row0 * DM + h * 128 + c * 64, K + krow0 * DM + h * 128 + c * 64, V + krow0 * DM + h * 128, lds, C, o);
            int ln = threadIdx.x & 63; asm volatile("" : "+v"(ln));
            att::f32x4v* sw = (att::f32x4v*)scr + ((size_t)(uid * 8 + wid) * 16) * 64 + ln;
            if (c == 0) {
#pragma unroll
                for (int r = 0; r < 16; ++r) sw[r * 64] = (att::f32x4v){o[0][r], o[1][r], o[2][r], o[3][r]};
            } else {
                float gs[4];
#pragma unroll
                for (int d0 = 0; d0 < 4; ++d0) gs[d0] = subg[d0 * 32 + (ln & 31)] * (1.0f - LAM_INIT0);
#pragma unroll
                for (int r = 0; r < 16; ++r) { const att::f32x4v o0 = sw[r * 64]; float ss = 0.f;
#pragma unroll
                    for (int d0 = 0; d0 < 4; ++d0) { const float v = o0[d0] - lam * o[d0][r]; o[d0][r] = v; ss += v * v; }
                    ss += __shfl_xor(ss, 1); ss += __shfl_xor(ss, 2); ss += __shfl_xor(ss, 4); ss += __shfl_xor(ss, 8); ss += __shfl_xor(ss, 16);
                    const float rs = 1.0f / sqrtf(ss * (1.0f / 128.0f) + EPS);
#pragma unroll
                    for (int d0 = 0; d0 < 4; ++d0) o[d0][r] *= rs * gs[d0];
                    if ((r & 3) == 3) asm volatile("" ::: "memory"); }
                __syncthreads();
                att::store_o(o, O + row0 * DM + h * 128, lds);
            }
        }
    }
}
__device__ __forceinline__ void attn_phase_B(Frame& F, const bf16* Q, const bf16* K, const bf16* V, bf16* O) {
    LAS char* lds = (LAS char*)F.lds;
    constexpr float C = 0.08838834764831845f * 1.4426950408889634f;
    for (int uid = F.vcu; uid < 512; uid += F.G) {
        const int grp = (uid & 255) >> 5, w = ((uid & 31) << 1) | (uid >> 8), b = grp >> 1, kvh = grp & 1, hq = kvh * 4 + (w >> 4), qb = w & 15;
        const size_t row0 = (size_t)b * SEQ + (size_t)qb * 256, krow0 = (size_t)b * SEQ;
        att::f32x16 o[4];
        att::attn_core<128, 256>(Q + row0 * DM + hq * 128, K + krow0 * 256 + kvh * 128, V + krow0 * 256 + kvh * 128, lds, C, o);
        __syncthreads();
        att::store_o(o, O + row0 * DM + hq * 128, lds);
    }
}

#ifndef PHMASK
#define PHMASK 0xFFFF
#endif
#define KIND(b) (((PHMASK) >> (b)) & 1)
#ifndef REPMASK
#define REPMASK 0
#endif
#define REP(b) for (int rep_ = 0; rep_ < 1 + (((REPMASK) >> (b)) & 1); ++rep_)
constexpr bool USE_BAR = (MK_N_LAUNCHES != NPHASE);
#define IN(k) (lo <= (k) && (k) < hi)
#define SEAM(k) do { if (USE_BAR && IN((k) + 1)) xcd_barrier(bar); } while (0)
__device__ __forceinline__ void refresh(Frame& F) { int t = threadIdx.x; asm volatile("" : "+v"(t)); F.tid = t; F.lane = t & 63; F.wave = __builtin_amdgcn_readfirstlane(t >> 6); }

template <int L>
__device__ __forceinline__ void layer_phases(Frame& F, const Args& args, const int lo, const int hi, const XcdBarrier& bar) {
    constexpr int pb = (L == 0) ? 1 : 6;
    unsigned char* ws = args.ws;
    const float* x = args.in[0]; float* out = args.out;
    const float* modL = (const float*)(ws + WS_MOD) + (size_t)L * BATCH * MODW;
    const float* xin = (L == 0) ? x : (const float*)out;
    bf16 *H = (bf16*)(ws + WS_H), *O = (bf16*)(ws + WS_O), *Qb = (bf16*)(ws + WS_Q), *ACT = (bf16*)(ws + WS_ACT);
    float* stat = (float*)(ws + WS_STAT); const float* biasb = (const float*)(ws + WS_BIAS);
    LAS float* escr = (LAS float*)(F.lds + EPI_OFF);
    if constexpr (L == 0) { if (KIND(1) && IN(pb)) { refresh(F); REP(1) { bias_tasks(F, args); norm_rows(F, xin, args.in[4], modL, modL + DM, H); } SEAM(pb); } }
    if (IN(pb + 1)) {
        if constexpr (L == 0) { if (KIND(2)) REP(2) { pg8::Gemm g{H, (const bf16*)(ws + WS_WAQKV), M, 3072, DM}; pg8::StaticOrder S; S.init(M, 3072, F.G, (int)blockIdx.x);
            pg8::EpiQkvA E{Qb, (size_t)(WS_K - WS_Q) / 2, (const float*)(ws + WS_CSA)};
            pg8::gemm_phase<pg8::EpiQkvA, pg8::StaticOrder, true, true>(F.lds, g, S, E); } }
        else { if (KIND(3)) REP(3) { pg8::Gemm g{H, (const bf16*)(ws + WS_WBQKV), M, 1536, DM}; pg8::StaticOrder S; S.init(M, 1536, F.G, (int)blockIdx.x);
            pg8::EpiQkvB E{stat, biasb + 4 * 2 * DFF, Qb, (size_t)(WS_K - WS_Q) / 2, (const float*)(ws + WS_GQK), (const float*)(ws + WS_CSB), escr};
            pg8::gemm_phase<pg8::EpiQkvB, pg8::StaticOrder, true, true>(F.lds, g, S, E); } }
        SEAM(pb + 1);
    }
    if (IN(pb + 2)) {
        refresh(F);
        bf16 *Kb = (bf16*)(ws + WS_K), *Vb = (bf16*)(ws + WS_V);
        if constexpr (L == 0) { if (KIND(4)) REP(4) attn_phase_A(F, Qb, Kb, Vb, O, out, args.in[8], args.in[9], args.in[10], args.in[11], args.in[12]); }
        else { if (KIND(5)) REP(5) attn_phase_B(F, Qb, Kb, Vb, O); }
        SEAM(pb + 2);
    }
    if (KIND(6) && IN(pb + 3)) { pg8::Gemm g{O, (const bf16*)(ws + (L == 0 ? WS_WAO : WS_WBO)), M, DM, DM}; pg8::StaticOrder S; S.init(M, DM, F.G, (int)blockIdx.x);
        pg8::EpiResid<true> E{xin, out, modL + 2 * DM, args.in[5] + L * DM, modL + 4 * DM, H, stat, escr};
        pg8::gemm_phase<pg8::EpiResid<true>, pg8::StaticOrder, true, true>(F.lds, g, S, E);
        SEAM(pb + 3); }
    if (KIND(8) && IN(pb + 4)) { pg8::Gemm g{H, (const bf16*)(ws + (L == 0 ? WS_WIN0 : WS_WIN1)), M, 2 * DFF, DM}; pg8::StaticOrder S; S.init(M, 2 * DFF, F.G, (int)blockIdx.x);
        pg8::EpiSwiglu E{ACT, DFF, stat, biasb + (L == 0 ? 0 : 4 * 2 * DFF + 4 * 1536)};
        REP(8) pg8::gemm_phase<pg8::EpiSwiglu, pg8::StaticOrder, true, true>(F.lds, g, S, E);
        SEAM(pb + 4); }
    if (KIND(9) && IN(pb + 5)) { pg8::Gemm g{ACT, (const bf16*)(ws + (L == 0 ? WS_WOUT0 : WS_WOUT1)), M, DM, DFF}; pg8::StaticOrder S; S.init(M, DM, F.G, (int)blockIdx.x);
        if constexpr (L == 0) { pg8::EpiResid<true> E{out, out, modL + 5 * DM, args.in[4] + DM, modL + (size_t)BATCH * MODW + DM, H, stat, escr};
            pg8::gemm_phase<pg8::EpiResid<true>, pg8::StaticOrder, true, true>(F.lds, g, S, E); }
        else { pg8::EpiResid<false> E{out, out, modL + 5 * DM, nullptr, nullptr, nullptr, nullptr, escr};
            pg8::gemm_phase<pg8::EpiResid<false>, pg8::StaticOrder, true, true>(F.lds, g, S, E); }
        SEAM(pb + 5); }
}

__global__ void __launch_bounds__(NWAVES * 64, 2) mk_fwd(Args args) {
    extern __shared__ __attribute__((aligned(16))) unsigned char lds[];
    Frame F;
    F.lds = (LAS unsigned char*)lds;
    F.MISC = (volatile LAS unsigned*)(F.lds + MISC_OFF);
    F.tid = threadIdx.x; F.lane = F.tid & 63; F.wave = __builtin_amdgcn_readfirstlane(F.tid >> 6);
    F.G = gridDim.x; { const int bx = blockIdx.x; F.vcu = (F.G % 8 == 0) ? (bx % 8) * (F.G / 8) + bx / 8 : bx; }
    if (F.tid < 32) F.MISC[F.tid] = 0u;
    __syncthreads();
    const int lo = args.ph_lo, hi = args.ph_hi;
    XcdBarrier bar; bar.bar = (unsigned*)(args.ws + WS_CTL); bar.x = 0; bar.st = nullptr;
    if (USE_BAR) bar = xcd_barrier_post((unsigned*)(args.ws + WS_CTL), F.MISC + 8);
    if (KIND(0) && IN(0)) { REP(0) { p0_prologue(F, args); __syncthreads(); } SEAM(0); }
    layer_phases<0>(F, args, lo, hi, bar);
    layer_phases<1>(F, args, lo, hi, bar);
    if (KIND(10) && IN(12)) { refresh(F); final_norm(F, args.out, args.in[19]); }
}
#undef IN
#undef SEAM

extern "C" void kernel_launch(void* const* d_in, const int* in_sizes, int n_in, void* d_out, int out_size, void* d_ws, size_t ws_size, hipStream_t stream) {
    static int grid = 0;
    if (grid == 0) {
        if (n_in != 20 || in_sizes[0] != M * DM || out_size != M * DM || ws_size < WS_END) { fprintf(stderr, "kernel_launch: unexpected shapes (n_in %d, in0 %d, out %d, ws %zu)\n", n_in, n_in > 0 ? in_sizes[0] : -1, out_size, ws_size); grid = -1; return; }
        int dev = 0, cus = 0, per_cu = 0;
        if (hipGetDevice(&dev) != hipSuccess || hipDeviceGetAttribute(&cus, hipDeviceAttributeMultiprocessorCount, dev) != hipSuccess) { grid = -1; return; }
        if (hipFuncSetAttribute((const void*)mk_fwd, hipFuncAttributeMaxDynamicSharedMemorySize, LDS_BYTES) != hipSuccess) { fprintf(stderr, "kernel_launch: hipFuncSetAttribute failed\n"); grid = -1; return; }
        if (hipOccupancyMaxActiveBlocksPerMultiprocessor(&per_cu, (const void*)mk_fwd, NWAVES * 64, LDS_BYTES) != hipSuccess || per_cu < 1) { fprintf(stderr, "kernel_launch: occupancy query says %d blocks per CU\n", per_cu); grid = -1; (void)hipGetLastError(); return; }
        grid = cus;
    }
    if (grid < 0) return;
    if (hipMemsetAsync((char*)d_ws + WS_CTL, 0, CTL_ZERO_BYTES, stream) != hipSuccess) return;
    Args a{};
    for (int i = 0; i < 20; ++i) a.in[i] = (const float*)d_in[i];
    a.out = (float*)d_out; a.ws = (unsigned char*)d_ws;
    constexpr int NL = MK_N_LAUNCHES;
    for (int li = 0; li < NL; ++li) {
        a.ph_lo = li * NPHASE / NL; a.ph_hi = (li + 1) * NPHASE / NL;
        hipLaunchKernelGGL(mk_fwd, dim3(grid), dim3(NWAVES * 64), LDS_BYTES, stream, a);
        const hipError_t le = hipPeekAtLastError();
        if (le != hipSuccess) { fprintf(stderr, "kernel_launch: launch %d failed: %s\n", li, hipGetErrorName(le)); break; }
    }
}
```

```cpp
#include <hip/hip_runtime.h>
#include <hip/hip_bf16.h>
#include <cstdio>
#include <cstdint>
namespace pg8 {
#define PG8_LAS __attribute__((address_space(3)))
typedef unsigned short bf16_t;
typedef short bf16x8 __attribute__((ext_vector_type(8)));
typedef float f32x4 __attribute__((ext_vector_type(4)));
typedef unsigned u32x4 __attribute__((ext_vector_type(4)));
constexpr int BM = 256, BK = 64, HALF = 128, HTB = HALF * BK * 2  , STAGE_BYTES = 8 * HTB, NXCD = 8, WGM = 8;

__host__ __device__ __forceinline__ int lds_byte(int r, int c) { const int st = (r >> 4) * 2 + (c >> 5), rr = r & 15, cc = c & 31, ob = rr * 64 + cc * 2; return st * 1024 + (ob ^ (((ob >> 9) & 1) << 5)); }
__host__ __device__ __forceinline__ void stage_rc(int b, int& R, int& C) { const int st = b / 1024, sb = b % 1024, swz = sb ^ (((sb >> 9) & 1) << 5); R = (st >> 1) * 16 + swz / 64; C = (st & 1) * 32 + (swz % 64) / 2; }
__host__ __device__ __forceinline__ int perm32(int rho) { const int n = rho >> 4, i = rho & 15; return 8 * (i >> 2) + 4 * n + (i & 3); }

struct Unit { int pm, pn; };
struct Gemm { const bf16_t* A; const bf16_t* Bt; int M, N, K; };

struct StaticOrder {
    int nM, nN, nwg, G, c;
    __host__ __device__ void init(int M, int N, int G_, int c_) { nM = M / BM; nN = N / BM; nwg = nM * nN; G = G_; c = c_; }
    __host__ __device__ bool next(int i, Unit& u) const {
        const long L = (long)i * G + c; if (L >= nwg) return false;
        int wgid = (int)L; { const int q = nwg / NXCD, r = nwg % NXCD, xcd = wgid % NXCD, off = wgid / NXCD; wgid = (xcd < r ? xcd * (q + 1) : r * (q + 1) + (xcd - r) * q) + off; }
        const int nig = WGM * nN, gid = wgid / nig, fm = gid * WGM, gsz = (nM - fm) < WGM ? (nM - fm) : WGM;
        u.pm = fm + ((wgid % nig) % gsz); u.pn = (wgid % nig) / gsz; return true;
    }
    __device__ __forceinline__ void a_ready(const Unit&) const {}
    __device__ __forceinline__ void done(const Unit&) const {}
};


__device__ __forceinline__ unsigned cvt_pk_bf16(float lo, float hi) { unsigned r; asm volatile("v_cvt_pk_bf16_f32 %0, %1, %2" : "=v"(r) : "v"(lo), "v"(hi)); return r; }
constexpr int SEQ_ = 4096, DM_ = 1024, MODW_ = 6144;
constexpr float EPS_ = 1e-6f;
typedef unsigned u32x2 __attribute__((ext_vector_type(2)));

__device__ __forceinline__ void rot4(f32x4& v0, f32x4& v1, const f32x4 c, const f32x4 s) {
    f32x4 r0, r1;
    r0[0] = v0[0] * c[0] - v0[1] * s[0]; r0[1] = v0[1] * c[0] + v0[0] * s[0]; r0[2] = v0[2] * c[1] - v0[3] * s[1]; r0[3] = v0[3] * c[1] + v0[2] * s[1];
    r1[0] = v1[0] * c[2] - v1[1] * s[2]; r1[1] = v1[1] * c[2] + v1[0] * s[2]; r1[2] = v1[2] * c[3] - v1[3] * s[3]; r1[3] = v1[3] * c[3] + v1[2] * s[3];
    v0 = r0; v1 = r1;
}

struct EpiQkvA {
    static constexpr bool PERM = true, AFTER_DRAIN = false;
    bf16_t* Q; size_t tstride; const float* cs;
    __device__ __forceinline__ void operator()(const f32x4 (&acc)[2][2][4][2], const Unit& u, int wr, int wc, int fr, int fq) const {
        const int t3 = u.pn >> 2; bf16_t* base = Q + (size_t)t3 * tstride;
        const int col0 = (u.pn & 3) * BM + wc * 32 + 8 * fq, row0 = u.pm * BM + wr * 64 + fr;
        const bool rope = (t3 < 2) && ((wc & 1) == 0) && (fq < 2);
#pragma unroll
        for (int ai = 0; ai < 2; ++ai)
#pragma unroll
            for (int m = 0; m < 4; ++m) { const int row = row0 + ai * HALF + m * 16, t = row & (SEQ_ - 1);
                f32x4 cv = (f32x4){1.f, 1.f, 1.f, 1.f}, sv = (f32x4){0.f, 0.f, 0.f, 0.f};
                if (rope) { cv = *(const f32x4*)(cs + t * 16 + 4 * fq); sv = *(const f32x4*)(cs + t * 16 + 8 + 4 * fq); }
                bf16_t* rowp = base + (size_t)row * DM_ + col0;
#pragma unroll
                for (int bj = 0; bj < 2; ++bj) { f32x4 v0 = acc[ai][bj][m][0], v1 = acc[ai][bj][m][1];
                    rot4(v0, v1, cv, sv);
                    u32x4 w; w.x = cvt_pk_bf16(v0[0], v0[1]); w.y = cvt_pk_bf16(v0[2], v0[3]); w.z = cvt_pk_bf16(v1[0], v1[1]); w.w = cvt_pk_bf16(v1[2], v1[3]);
                    *(u32x4*)(rowp + bj * HALF) = w; } }
    }
};

struct EpiQkvB {
    static constexpr bool PERM = true, AFTER_DRAIN = false;
    const float* stat; const float* bias;
    bf16_t* Q; size_t tstride; const float* gtab; const float* cs2;
    PG8_LAS float* scr;
    __device__ __forceinline__ void operator()(f32x4 (&acc)[2][2][4][2], const Unit& u, int wr, int wc, int fr, int fq) const {
        const int pn = u.pn; const bool nrm = pn < 5;
        bf16_t* base = Q + (size_t)(pn < 4 ? 0 : pn - 3) * tstride; const int ld = pn < 4 ? DM_ : 256; const float* g = gtab + (pn < 4 ? 0 : 128);
        const int col0 = (pn < 4 ? pn * BM : 0) + wc * 32 + 8 * fq, row0 = u.pm * BM + wr * 64 + fr;
        {
            const float* bp = bias + ((u.pm * BM) / SEQ_) * 1536 + pn * BM + wc * 32 + 8 * fq;
            f32x4 bv[2][2];
#pragma unroll
            for (int bj = 0; bj < 2; ++bj) { bv[bj][0] = *(const f32x4*)(bp + bj * HALF); bv[bj][1] = *(const f32x4*)(bp + bj * HALF + 4); }
#pragma unroll
            for (int ai = 0; ai < 2; ++ai)
#pragma unroll
                for (int m = 0; m < 4; ++m) { const f32x4 st = *(const f32x4*)(stat + (size_t)(row0 + ai * HALF + m * 16) * 4);
                    const float rr = __builtin_amdgcn_rsqf(((st[0] + st[1]) + (st[2] + st[3])) * (1.0f / DM_) + EPS_);
#pragma unroll
                    for (int bj = 0; bj < 2; ++bj) { acc[ai][bj][m][0] = acc[ai][bj][m][0] * rr + bv[bj][0]; acc[ai][bj][m][1] = acc[ai][bj][m][1] * rr + bv[bj][1]; } }
        }
        if (nrm) {
#pragma unroll
            for (int ai = 0; ai < 2; ++ai)
#pragma unroll
                for (int m = 0; m < 4; ++m)
#pragma unroll
                    for (int bj = 0; bj < 2; ++bj) { const f32x4 a = acc[ai][bj][m][0], b = acc[ai][bj][m][1];
                        float ss = (a[0] * a[0] + a[1] * a[1]) + (a[2] * a[2] + a[3] * a[3]) + (b[0] * b[0] + b[1] * b[1]) + (b[2] * b[2] + b[3] * b[3]);
                        ss += __shfl_xor(ss, 16); ss += __shfl_xor(ss, 32);
                        if (fq == 0) scr[((ai * HALF + wr * 64 + m * 16 + fr) * 2 + bj) * 4 + wc] = ss; }
            asm volatile("s_waitcnt lgkmcnt(0)" ::: "memory"); __builtin_amdgcn_s_barrier(); asm volatile("" ::: "memory");
        }
        const int f0 = 16 * (wc & 1) + 4 * fq, d1 = (wc < 2 ? 16 * wc : 16 * wc + 32) + 4 * fq;
        f32x4 g1 = (f32x4){1.f, 1.f, 1.f, 1.f}, g2 = g1;
        if (nrm) { g1 = *(const f32x4*)(g + d1); g2 = *(const f32x4*)(g + d1 + 32); }
#pragma unroll
        for (int ai = 0; ai < 2; ++ai)
#pragma unroll
            for (int m = 0; m < 4; ++m) { const int row = row0 + ai * HALF + m * 16, t = row & (SEQ_ - 1), pos = wc < 2 ? (t >> 6) : (t & 63);
                f32x4 cv = (f32x4){1.f, 1.f, 1.f, 1.f}, sv = (f32x4){0.f, 0.f, 0.f, 0.f};
                if (nrm) { cv = *(const f32x4*)(cs2 + pos * 64 + f0); sv = *(const f32x4*)(cs2 + pos * 64 + 32 + f0); }
                bf16_t* rowp = base + (size_t)row * ld + col0;
#pragma unroll
                for (int bj = 0; bj < 2; ++bj) { f32x4 v0 = acc[ai][bj][m][0], v1 = acc[ai][bj][m][1];
                    if (nrm) { const f32x4 p = *(const PG8_LAS f32x4*)(scr + ((ai * HALF + wr * 64 + m * 16 + fr) * 2 + bj) * 4);
                        const float rs = __builtin_amdgcn_rsqf(((p[0] + p[1]) + (p[2] + p[3])) * (1.0f / 128.0f) + EPS_);
                        v0[0] *= rs * g1[0]; v0[1] *= rs * g2[0]; v0[2] *= rs * g1[1]; v0[3] *= rs * g2[1]; v1[0] *= rs * g1[2]; v1[1] *= rs * g2[2]; v1[2] *= rs * g1[3]; v1[3] *= rs * g2[3];
                        rot4(v0, v1, cv, sv); }
                    u32x4 w; w.x = cvt_pk_bf16(v0[0], v0[1]); w.y = cvt_pk_bf16(v0[2], v0[3]); w.z = cvt_pk_bf16(v1[0], v1[1]); w.w = cvt_pk_bf16(v1[2], v1[3]);
                    *(u32x4*)(rowp + bj * HALF) = w; } }
    }
};

template <bool EMIT> struct EpiResid {
    static constexpr bool PERM = false, AFTER_DRAIN = false;
    const float* base; float* out; const float* gate;
    const float* g; const float* scale; bf16_t* xm; float* stat; PG8_LAS float* scr;
    __device__ __forceinline__ void operator()(const f32x4 (&acc)[2][2][4][2], const Unit& u, int wr, int wc, int fr, int fq) const {
        const int col0 = u.pn * BM + wc * 32 + 4 * fq, row0 = u.pm * BM + wr * 64 + fr, b = (u.pm * BM) / SEQ_;
        f32x4 gv[2][2], mv[2][2];
#pragma unroll
        for (int bj = 0; bj < 2; ++bj)
#pragma unroll
            for (int n = 0; n < 2; ++n) { gv[bj][n] = *(const f32x4*)(gate + b * MODW_ + col0 + bj * HALF + n * 16);
                if (EMIT) mv[bj][n] = *(const f32x4*)(g + col0 + bj * HALF + n * 16) * (*(const f32x4*)(scale + b * MODW_ + col0 + bj * HALF + n * 16) + 1.0f); }
#pragma unroll
        for (int ai = 0; ai < 2; ++ai)
#pragma unroll
            for (int m = 0; m < 4; ++m) { const size_t off = (size_t)(row0 + ai * HALF + m * 16) * DM_ + col0; float ss = 0.f;
#pragma unroll
                for (int bj = 0; bj < 2; ++bj)
#pragma unroll
                    for (int n = 0; n < 2; ++n) { const f32x4 bs = *(const f32x4*)(base + off + bj * HALF + n * 16); const f32x4 o = bs + gv[bj][n] * acc[ai][bj][m][n];
                        *(f32x4*)(out + off + bj * HALF + n * 16) = o;
                        if (EMIT) { ss += (o[0] * o[0] + o[1] * o[1]) + (o[2] * o[2] + o[3] * o[3]); const f32x4 a = o * mv[bj][n];
                            u32x2 w; w.x = cvt_pk_bf16(a[0], a[1]); w.y = cvt_pk_bf16(a[2], a[3]); *(u32x2*)(xm + off + bj * HALF + n * 16) = w; } }
                if (EMIT) { ss += __shfl_xor(ss, 16); ss += __shfl_xor(ss, 32); if (fq == 0) scr[(ai * HALF + wr * 64 + m * 16 + fr) * 4 + wc] = ss; }
                if (m & 1) asm volatile("" ::: "memory"); }
        if (EMIT) {
            asm volatile("s_waitcnt lgkmcnt(0)" ::: "memory"); __builtin_amdgcn_s_barrier(); asm volatile("" ::: "memory");
            const int t = (wr * 4 + wc) * 64 + (fq * 16 + fr);
            if (t < BM) { const f32x4 p = *(const PG8_LAS f32x4*)(scr + t * 4); stat[(size_t)(u.pm * BM + t) * 4 + u.pn] = (p[0] + p[1]) + (p[2] + p[3]); }
        }
    }
};

struct EpiSwiglu {
    static constexpr bool PERM = true, AFTER_DRAIN = false;
    bf16_t* O; int ldo; const float* stat; const float* bias;
    __device__ __forceinline__ static float sw(float g, float up) { return g * __builtin_amdgcn_rcpf(1.0f + __builtin_amdgcn_exp2f(g * -1.4426950408889634f)) * up; }
    __device__ __forceinline__ void operator()(const f32x4 (&acc)[2][2][4][2], const Unit& u, int wr, int wc, int fr, int fq) const {
        const int col0 = u.pn * HALF + wc * 32 + 8 * fq, row0 = u.pm * BM + wr * 64 + fr;
        const float* bp = bias + ((u.pm * BM) / SEQ_) * (2 * ldo) + u.pn * BM + wc * 32 + 8 * fq;
        const f32x4 bg0 = *(const f32x4*)(bp), bg1 = *(const f32x4*)(bp + 4), bu0 = *(const f32x4*)(bp + HALF), bu1 = *(const f32x4*)(bp + HALF + 4);
#pragma unroll
        for (int ai = 0; ai < 2; ++ai)
#pragma unroll
            for (int m = 0; m < 4; ++m) { const f32x4 st = *(const f32x4*)(stat + (size_t)(row0 + ai * HALF + m * 16) * 4);
                const float rr = __builtin_amdgcn_rsqf(((st[0] + st[1]) + (st[2] + st[3])) * (1.0f / DM_) + EPS_);
                const f32x4 g0 = acc[ai][0][m][0] * rr + bg0, g1 = acc[ai][0][m][1] * rr + bg1, u0 = acc[ai][1][m][0] * rr + bu0, u1 = acc[ai][1][m][1] * rr + bu1;
                u32x4 w; w.x = cvt_pk_bf16(sw(g0[0], u0[0]), sw(g0[1], u0[1])); w.y = cvt_pk_bf16(sw(g0[2], u0[2]), sw(g0[3], u0[3]));
                w.z = cvt_pk_bf16(sw(g1[0], u1[0]), sw(g1[1], u1[1])); w.w = cvt_pk_bf16(sw(g1[2], u1[2]), sw(g1[3], u1[3]));
                *(u32x4*)(O + (size_t)(row0 + ai * HALF + m * 16) * ldo + col0) = w; }
    }
};

template <class Epi, class Sched, bool ALIGN_EPI = false, bool SP2 = false>
__device__ __forceinline__ void gemm_phase(PG8_LAS unsigned char* lds, const Gemm g, const Sched& S, const Epi& E) {
    int tid_ = threadIdx.x; asm volatile("" : "+v"(tid_));
    const int tid = tid_, wid = __builtin_amdgcn_readfirstlane(tid >> 6), lane = tid & 63, wr = wid >> 2, wc = wid & 3, fr = lane & 15, fq = lane >> 4;
    const int K = g.K, nt = K / BK;
    unsigned voffA[2], voffB[2];
#pragma unroll
    for (int i = 0; i < 2; ++i) { int R, C; stage_rc(tid * 16 + i * 8192, R, C); const int Rb = Epi::PERM ? ((R & ~31) + perm32(R & 31)) : R;
        voffA[i] = (unsigned)(R * K + C) * 2u; voffB[i] = (unsigned)(Rb * K + C) * 2u; }
    const size_t kstep = (size_t)(BK * 2);
    const size_t hstep = (size_t)HALF * K * 2;
    const size_t tstep = 2 * hstep;
    const unsigned ldsw = (unsigned)wid * 1024u;
    const int aoff = lds_byte(wr * 64 + fr, fq * 8), boff = lds_byte(wc * 32 + fr, fq * 8);
#define PG8_SA(b, h) (((b) * 2 + (h)) * HTB)
#define PG8_SB(b, h) ((4 + (b) * 2 + (h)) * HTB)
#define PG8_STAGE(bufoff, gbase, voff) do { _Pragma("unroll") for (int _i = 0; _i < 2; ++_i) \
        __builtin_amdgcn_global_load_lds((const unsigned*)((const char*)(gbase) + (voff)[_i]), (PG8_LAS unsigned*)(lds + (bufoff) + ldsw + _i * 8192), 16, 0, 0); } while (0)
#define PG8_LDA(dst, b, h) do { _Pragma("unroll") for (int m = 0; m < 4; ++m) _Pragma("unroll") for (int k = 0; k < 2; ++k) dst[m][k] = *(const PG8_LAS bf16x8*)(lds + PG8_SA(b, h) + aoff + m * 2048 + k * 1024); } while (0)
#define PG8_LDB(dst, b, h) do { _Pragma("unroll") for (int n = 0; n < 2; ++n) _Pragma("unroll") for (int k = 0; k < 2; ++k) dst[n][k] = *(const PG8_LAS bf16x8*)(lds + PG8_SB(b, h) + boff + n * 2048 + k * 1024); } while (0)
#define PG8_MMA(ai, bj, At, Bt) do { __builtin_amdgcn_s_setprio(1); _Pragma("unroll") for (int m = 0; m < 4; ++m) _Pragma("unroll") for (int n = 0; n < 2; ++n) _Pragma("unroll") for (int k = 0; k < 2; ++k) \
        acc[ai][bj][m][n] = __builtin_amdgcn_mfma_f32_16x16x32_bf16(Bt[n][k], At[m][k], acc[ai][bj][m][n], 0, 0, 0); __builtin_amdgcn_s_setprio(0); } while (0)
#define PG8_WAIT_V(n) asm volatile("s_waitcnt vmcnt(" #n ")" ::: "memory")
#define PG8_WAIT_L(n) asm volatile("s_waitcnt lgkmcnt(" #n ")" ::: "memory")
#define PG8_BAR __builtin_amdgcn_s_barrier()
#define PG8_SCHED __builtin_amdgcn_sched_barrier(0)
    Unit cur, nxt; int ui = 0;
    if (!S.next(0, cur)) return;
    f32x4 acc[2][2][4][2];
#pragma unroll
    for (int a = 0; a < 2; ++a)
#pragma unroll
        for (int b = 0; b < 2; ++b)
#pragma unroll
            for (int m = 0; m < 4; ++m)
#pragma unroll
                for (int n = 0; n < 2; ++n) acc[a][b][m][n] = (f32x4){0.f, 0.f, 0.f, 0.f};
    bf16x8 At[4][2], B0[2][2], B1[2][2];
    const char* cA = (const char*)g.A + (size_t)cur.pm * tstep; const char* cB = (const char*)g.Bt + (size_t)cur.pn * tstep;
    S.a_ready(cur);
    if constexpr (SP2) {
        PG8_STAGE(PG8_SB(0, 0), cB, voffB); PG8_STAGE(PG8_SB(0, 1), cB + hstep, voffB); PG8_STAGE(PG8_SA(0, 0), cA, voffA); PG8_STAGE(PG8_SA(0, 1), cA + hstep, voffA);
        if (wr == 1) PG8_BAR;
        PG8_WAIT_V(2); PG8_BAR;
        PG8_STAGE(PG8_SB(1, 0), cB + kstep, voffB); PG8_STAGE(PG8_SA(1, 0), cA + kstep, voffA); PG8_STAGE(PG8_SB(1, 1), cB + hstep + kstep, voffB);
        PG8_WAIT_V(6); PG8_BAR;
    } else {
        PG8_STAGE(PG8_SB(0, 0), cB, voffB); PG8_STAGE(PG8_SA(0, 0), cA, voffA); PG8_STAGE(PG8_SB(0, 1), cB + hstep, voffB); PG8_STAGE(PG8_SA(0, 1), cA + hstep, voffA);
        if (wr == 1) PG8_BAR;
        PG8_WAIT_V(4); PG8_BAR;
        PG8_STAGE(PG8_SB(1, 0), cB + kstep, voffB); PG8_STAGE(PG8_SA(1, 0), cA + kstep, voffA); PG8_STAGE(PG8_SB(1, 1), cB + hstep + kstep, voffB);
        PG8_WAIT_V(6); PG8_BAR;
    }
    for (;;) {
        const bool has_next = S.next(ui + 1, nxt);
        const char* nA = has_next ? (const char*)g.A + (size_t)nxt.pm * tstep : cA; const char* nB = has_next ? (const char*)g.Bt + (size_t)nxt.pn * tstep : cB;
        for (int t = 0; t < nt; t += 2) {
            const bool last = (t == nt - 2);
            const char* a1 = cA + (size_t)(t + 1) * kstep;
            const char* a2 = last ? nA : cA + (size_t)(t + 2) * kstep; const char* b2 = last ? nB : cB + (size_t)(t + 2) * kstep;
            const char* a3 = a2 + kstep; const char* b3 = b2 + kstep;
            if (last && has_next) S.a_ready(nxt);
            if constexpr (SP2) {
            PG8_LDB(B0, 0, 0); PG8_LDB(B1, 0, 1); PG8_SCHED; PG8_LDA(At, 0, 0); PG8_STAGE(PG8_SA(1, 1), a1 + hstep, voffA);
            PG8_WAIT_V(8); PG8_WAIT_L(0); PG8_BAR; PG8_MMA(0, 0, At, B0); PG8_MMA(0, 1, At, B1); PG8_BAR; PG8_SCHED;
            PG8_LDA(At, 0, 1); PG8_STAGE(PG8_SB(0, 0), b2, voffB); PG8_STAGE(PG8_SB(0, 1), b2 + hstep, voffB); PG8_STAGE(PG8_SA(0, 0), a2, voffA);
            PG8_WAIT_V(8); PG8_WAIT_L(0); PG8_BAR; PG8_MMA(1, 0, At, B0); PG8_MMA(1, 1, At, B1); PG8_BAR; PG8_SCHED;
            PG8_LDB(B0, 1, 0); PG8_LDB(B1, 1, 1); PG8_SCHED; PG8_LDA(At, 1, 0); PG8_STAGE(PG8_SA(0, 1), a2 + hstep, voffA);
            PG8_WAIT_V(8); PG8_WAIT_L(0); PG8_BAR; PG8_MMA(0, 0, At, B0); PG8_MMA(0, 1, At, B1); PG8_BAR; PG8_SCHED;
            PG8_LDA(At, 1, 1); PG8_STAGE(PG8_SB(1, 0), b3, voffB); PG8_STAGE(PG8_SB(1, 1), b3 + hstep, voffB); PG8_STAGE(PG8_SA(1, 0), a3, voffA);
            PG8_WAIT_V(8); PG8_WAIT_L(0); PG8_BAR; PG8_MMA(1, 0, At, B0); PG8_MMA(1, 1, At, B1); PG8_BAR; PG8_SCHED;
            } else {
            PG8_LDB(B0, 0, 0); PG8_SCHED; PG8_LDA(At, 0, 0); PG8_STAGE(PG8_SA(1, 1), a1 + hstep, voffA);
            PG8_WAIT_L(8); PG8_BAR; PG8_WAIT_L(0); PG8_MMA(0, 0, At, B0); PG8_BAR; PG8_SCHED;
            PG8_LDB(B1, 0, 1); PG8_STAGE(PG8_SB(0, 0), b2, voffB);
            PG8_BAR; PG8_WAIT_L(0); PG8_MMA(0, 1, At, B1); PG8_BAR;
            PG8_LDA(At, 0, 1); PG8_STAGE(PG8_SA(0, 0), a2, voffA);
            PG8_BAR; PG8_WAIT_L(0); PG8_MMA(1, 0, At, B0); PG8_BAR; PG8_SCHED;
            PG8_STAGE(PG8_SB(0, 1), b2 + hstep, voffB);
            PG8_WAIT_V(6); PG8_BAR; PG8_MMA(1, 1, At, B1); PG8_BAR;
            PG8_LDB(B0, 1, 0); PG8_SCHED; PG8_LDA(At, 1, 0); PG8_STAGE(PG8_SA(0, 1), a2 + hstep, voffA);
            PG8_WAIT_L(8); PG8_BAR; PG8_WAIT_L(0); PG8_MMA(0, 0, At, B0); PG8_BAR; PG8_SCHED;
            PG8_LDB(B1, 1, 1); PG8_STAGE(PG8_SB(1, 0), b3, voffB);
            PG8_BAR; PG8_WAIT_L(0); PG8_MMA(0, 1, At, B1); PG8_BAR;
            PG8_LDA(At, 1, 1); PG8_STAGE(PG8_SA(1, 0), a3, voffA);
            PG8_BAR; PG8_WAIT_L(0); PG8_MMA(1, 0, At, B0); PG8_BAR; PG8_SCHED;
            PG8_STAGE(PG8_SB(1, 1), b3 + hstep, voffB);
            PG8_WAIT_V(6); PG8_BAR; PG8_MMA(1, 1, At, B1); PG8_BAR;
            }
        }
        if constexpr (ALIGN_EPI) { if (wr == 0) PG8_BAR; }
        if constexpr (!Epi::AFTER_DRAIN) { E(acc, cur, wr, wc, fr, fq); S.done(cur); }
        if (!has_next) break;
#pragma unroll
        for (int a = 0; a < 2; ++a)
#pragma unroll
            for (int b = 0; b < 2; ++b)
#pragma unroll
                for (int m = 0; m < 4; ++m)
#pragma unroll
                    for (int n = 0; n < 2; ++n) acc[a][b][m][n] = (f32x4){0.f, 0.f, 0.f, 0.f};
        cur = nxt; cA = nA; cB = nB; ++ui;
        if constexpr (ALIGN_EPI) { if (wr == 1) PG8_BAR; }
    }
    PG8_WAIT_V(0);
    if constexpr (!ALIGN_EPI) { if (wr == 0) PG8_BAR; }
    PG8_BAR;
    if constexpr (Epi::AFTER_DRAIN) { E.fused(acc, cur, wr, wc, fr, fq, lds, wid, lane); S.done(cur); }
#undef PG8_SA
#undef PG8_SB
#undef PG8_STAGE
#undef PG8_LDA
#undef PG8_LDB
#undef PG8_MMA
#undef PG8_WAIT_V
#undef PG8_WAIT_L
#undef PG8_BAR
#undef PG8_SCHED
}
}

namespace att {
#define ATT_LAS __attribute__((address_space(3)))
typedef unsigned short bf16_t;
using bf16x8 = __attribute__((ext_vector_type(8))) short;
using s16x4  = __attribute__((ext_vector_type(4))) short;
using f32x16 = __attribute__((ext_vector_type(16))) float;
using u32x4  = __attribute__((ext_vector_type(4))) unsigned;
using f32x4v = __attribute__((ext_vector_type(4))) float;
constexpr int NW = 8, QBLK = 32, KVBLK = 64, DV = 128, LDQ = 1024, SEQ = 4096;
constexpr int SHM_V = KVBLK * DV * 2, SHM_K = 16384;
constexpr int LDS_V = 0, LDS_K = 2 * SHM_V, LDS_WS = 2 * SHM_V + 2 * SHM_K, LDS_BYTES = LDS_WS + NW * 64 * 4;
#define ATT_SBAR() __builtin_amdgcn_sched_barrier(0)
__device__ __forceinline__ int crow(int r, int hi) { return (r & 3) + 8 * (r >> 2) + 4 * hi; }
__device__ __forceinline__ unsigned cvtpk(float lo, float hi) { unsigned r; asm volatile("v_cvt_pk_bf16_f32 %0, %1, %2" : "=v"(r) : "v"(lo), "v"(hi)); return r; }
template <int DQK> __device__ __forceinline__ int kswz(int row, int colB) {
  if constexpr (DQK == 128) return row * 256 + (colB ^ ((row & 7) << 4));
  else return row * 128 + (colB ^ (((row >> 1) & 7) << 4));
}
__device__ __forceinline__ void partialSM(f32x16& p0, f32x16& p1, float& m_reg, float& mn, float& alpha, const float C, const float thr_raw) {
  float pmax = p0[0];
#pragma unroll
  for (int r = 1; r < 16; ++r) pmax = fmaxf(pmax, p0[r]);
#pragma unroll
  for (int r = 0; r < 16; ++r) pmax = fmaxf(pmax, p1[r]);
  { auto rr = __builtin_amdgcn_permlane32_swap(__float_as_uint(pmax), __float_as_uint(pmax), false, false);
    pmax = fmaxf(__uint_as_float(rr[0]), __uint_as_float(rr[1])); }
  if (__builtin_expect(__all(pmax - m_reg <= thr_raw), 1)) { mn = m_reg; alpha = 1.f; }
  else { mn = fmaxf(m_reg, pmax); alpha = __builtin_amdgcn_exp2f((m_reg - mn) * C); m_reg = mn; }
  const float mnC = -mn * C;
#pragma unroll
  for (int r = 0; r < 16; ++r) p0[r] = fmaf(p0[r], C, mnC);
#pragma unroll
  for (int r = 0; r < 16; ++r) p1[r] = fmaf(p1[r], C, mnC);
#pragma unroll
  for (int r = 0; r < 16; ++r) p0[r] = __builtin_amdgcn_exp2f(p0[r]);
}
__device__ __forceinline__ void finishSM(f32x16& p0, f32x16& p1, float alpha, float& l_reg, bf16x8& pa0, bf16x8& pa1, bf16x8& pa2, bf16x8& pa3) {
#pragma unroll
  for (int r = 0; r < 16; ++r) p1[r] = __builtin_amdgcn_exp2f(p1[r]);
  float ps = 0;
#pragma unroll
  for (int r = 0; r < 16; ++r) ps += p0[r];
#pragma unroll
  for (int r = 0; r < 16; ++r) ps += p1[r];
  { auto rr = __builtin_amdgcn_permlane32_swap(__float_as_uint(ps), __float_as_uint(ps), false, false);
    ps = __uint_as_float(rr[0]) + __uint_as_float(rr[1]); }
  l_reg = l_reg * alpha + ps;
#define ATT_PK4(P, BASE, OUT) do { unsigned a0 = cvtpk(P[BASE + 0], P[BASE + 1]), a1 = cvtpk(P[BASE + 2], P[BASE + 3]);   \
    unsigned b0 = cvtpk(P[BASE + 4], P[BASE + 5]), b1 = cvtpk(P[BASE + 6], P[BASE + 7]);                              \
    auto r0 = __builtin_amdgcn_permlane32_swap(a0, b0, false, false); auto r1 = __builtin_amdgcn_permlane32_swap(a1, b1, false, false); \
    u32x4 w = {r0[0], r1[0], r0[1], r1[1]}; OUT = __builtin_bit_cast(bf16x8, w); } while (0)
  ATT_PK4(p0, 0, pa0); ATT_PK4(p0, 8, pa1); ATT_PK4(p1, 0, pa2); ATT_PK4(p1, 8, pa3);
#undef ATT_PK4
}
template <int DQK> __device__ __forceinline__ void qkt(f32x16& p0, f32x16& p1, const ATT_LAS char* Ks, const bf16x8* qr, int r32, int hi) {
  p0 = f32x16{}; p1 = f32x16{};
#pragma unroll
  for (int d0 = 0; d0 < DQK / 16; ++d0) { const int cb = (d0 * 16 + hi * 8) * 2;
    const bf16x8 b0 = *reinterpret_cast<const ATT_LAS bf16x8*>(Ks + kswz<DQK>(r32, cb));
    const bf16x8 b1 = *reinterpret_cast<const ATT_LAS bf16x8*>(Ks + kswz<DQK>(32 + r32, cb));
    p0 = __builtin_amdgcn_mfma_f32_32x32x16_bf16(b0, qr[d0], p0, 0, 0, 0);
    p1 = __builtin_amdgcn_mfma_f32_32x32x16_bf16(b1, qr[d0], p1, 0, 0, 0);
    if ((d0 & 3) == 3) ATT_SBAR(); }
}
__device__ __forceinline__ int v_st(int k, int c) { const int kk = (k & ~0xC) | ((k & 4) << 1) | ((k & 8) >> 1); return ((kk >> 3) * 4 + (c >> 5)) * 512 + ((kk & 7) * 32 + (c & 31)) * 2; }
__device__ __forceinline__ int v_rd_base(int lane) { return ((lane & 3) << 3) | (((lane >> 2) & 3) << 6) | (((lane >> 4) & 1) << 5) | (((lane >> 5) & 1) << 8); }
constexpr int v_rd_off(int d0, int ks, int half) { return d0 * 512 + ks * 4096 + half * 2048; }
template <int OFF> __device__ __forceinline__ s16x4 tr_read(int vb) {
  s16x4 r; asm volatile("ds_read_b64_tr_b16 %0, %1 offset:%2" : "=&v"(r) : "v"(vb), "i"(OFF) : "memory"); return r;
}
template <int D0> __device__ __forceinline__ void pv_one(f32x16& od, int vb, bf16x8 pa0, bf16x8 pa1, bf16x8 pa2, bf16x8 pa3) {
  const s16x4 l0 = tr_read<v_rd_off(D0, 0, 0)>(vb), h0 = tr_read<v_rd_off(D0, 0, 1)>(vb), l1 = tr_read<v_rd_off(D0, 1, 0)>(vb), h1 = tr_read<v_rd_off(D0, 1, 1)>(vb);
  const s16x4 l2 = tr_read<v_rd_off(D0, 2, 0)>(vb), h2 = tr_read<v_rd_off(D0, 2, 1)>(vb), l3 = tr_read<v_rd_off(D0, 3, 0)>(vb), h3 = tr_read<v_rd_off(D0, 3, 1)>(vb);
  asm volatile("s_waitcnt lgkmcnt(0)" ::: "memory"); ATT_SBAR();
#define ATT_PK(L, H) (bf16x8){L[0], L[1], L[2], L[3], H[0], H[1], H[2], H[3]}
  od = __builtin_amdgcn_mfma_f32_32x32x16_bf16(pa0, ATT_PK(l0, h0), od, 0, 0, 0);
  od = __builtin_amdgcn_mfma_f32_32x32x16_bf16(pa1, ATT_PK(l1, h1), od, 0, 0, 0);
  od = __builtin_amdgcn_mfma_f32_32x32x16_bf16(pa2, ATT_PK(l2, h2), od, 0, 0, 0);
  od = __builtin_amdgcn_mfma_f32_32x32x16_bf16(pa3, ATT_PK(l3, h3), od, 0, 0, 0);
#undef ATT_PK
}
__device__ __forceinline__ void pv_d0(f32x16* o, int vb, bf16x8 pa0, bf16x8 pa1, bf16x8 pa2, bf16x8 pa3) {
  pv_one<0>(o[0], vb, pa0, pa1, pa2, pa3); pv_one<1>(o[1], vb, pa0, pa1, pa2, pa3); pv_one<2>(o[2], vb, pa0, pa1, pa2, pa3); pv_one<3>(o[3], vb, pa0, pa1, pa2, pa3);
}

template <int DQK, int LDKV>
__device__ __forceinline__ void attn_core(const bf16_t* Qb, const bf16_t* Kh, const bf16_t* Vh, ATT_LAS char* lds, const float C, f32x16 (&o)[4]) {
  int tid_ = threadIdx.x; asm volatile("" : "+v"(tid_));
  const int tid = tid_, lane = tid & 63, r32 = lane & 31, hi = lane >> 5; const int wid = __builtin_amdgcn_readfirstlane(tid >> 6); const int grp = wid >> 2;
  ATT_LAS char* V_lds = lds + LDS_V; ATT_LAS char* K_lds = lds + LDS_K;
  ATT_LAS float* ws = (ATT_LAS float*)(lds + LDS_WS) + wid * 64; ATT_LAS float* li_l = ws; ATT_LAS float* al_l = ws + 32;
  const float thr_raw = 8.0f * 1.4426950408889634f / C;
  float m_reg = -1e30f, l_reg = 0;
#pragma unroll
  for (int d = 0; d < 4; ++d) o[d] = f32x16{};
  bf16x8 qr[DQK / 16];
  const bf16_t* Qw = Qb + (long)(wid * QBLK + r32) * LDQ + hi * 8;
#pragma unroll
  for (int d0 = 0; d0 < DQK / 16; ++d0) qr[d0] = *reinterpret_cast<const bf16x8*>(Qw + d0 * 16);
  const int sr = tid >> 4, sc = (tid & 15) * 8, vst0 = v_st(sr, sc), vst1 = v_st(32 + sr, sc);
  const int kr = tid >> 3, kc = (tid & 7) * 8;
  const int vb0 = (int)(size_t)V_lds + v_rd_base(lane);
  struct Slot { bf16x8 vs0, vs1, ks0, ks1; } st_;
#define ATT_LOADV(S, t) do { S.vs0 = *reinterpret_cast<const bf16x8*>(&Vh[(long)((t) * KVBLK + sr) * LDKV + sc]); S.vs1 = *reinterpret_cast<const bf16x8*>(&Vh[(long)((t) * KVBLK + 32 + sr) * LDKV + sc]); } while (0)
#define ATT_LOADK(S, t) do { if constexpr (DQK == 128) { S.ks0 = *reinterpret_cast<const bf16x8*>(&Kh[(long)((t) * KVBLK + sr) * LDKV + sc]); S.ks1 = *reinterpret_cast<const bf16x8*>(&Kh[(long)((t) * KVBLK + 32 + sr) * LDKV + sc]); } \
    else { S.ks0 = *reinterpret_cast<const bf16x8*>(&Kh[(long)((t) * KVBLK + kr) * LDKV + kc]); } } while (0)
#define ATT_WRITEV(b, S) do { *(ATT_LAS bf16x8*)(V_lds + (b) * SHM_V + vst0) = S.vs0; *(ATT_LAS bf16x8*)(V_lds + (b) * SHM_V + vst1) = S.vs1; } while (0)
#define ATT_WRITEK(b, S) do { if constexpr (DQK == 128) { *(ATT_LAS bf16x8*)(K_lds + (b) * SHM_K + kswz<128>(sr, sc * 2)) = S.ks0; *(ATT_LAS bf16x8*)(K_lds + (b) * SHM_K + kswz<128>(32 + sr, sc * 2)) = S.ks1; } \
    else { *(ATT_LAS bf16x8*)(K_lds + (b) * SHM_K + kswz<64>(kr, kc * 2)) = S.ks0; } } while (0)
#define ATT_RESC(a) do { if (__any((a) < 1.f)) { if (hi == 0) al_l[r32] = (a); asm volatile("s_waitcnt lgkmcnt(0)" ::: "memory"); \
    _Pragma("unroll") for (int d = 0; d < 4; ++d) _Pragma("unroll") for (int r = 0; r < 16; ++r) o[d][r] *= al_l[crow(r, hi)]; } } while (0)
#define ATT_EVENT(j) do { if ((j) < NT) { ATT_WRITEV((j) & 1, st_); if ((j) + 1 < NT) ATT_WRITEK(((j) + 1) & 1, st_); \
    if ((j) + 1 < NT) ATT_LOADV(st_, (j) + 1); if ((j) + 2 < NT) ATT_LOADK(st_, (j) + 2); } } while (0)
#define ATT_MBLK(j) do { ATT_SBAR(); if ((j) < NT) qkt<DQK>(p0, p1, K_lds + ((j) & 1) * SHM_K, qr, r32, hi); \
    if ((j) >= 1) pv_d0(o, vb0 + (((j) - 1) & 1) * SHM_V, pa0, pa1, pa2, pa3); ATT_SBAR(); } while (0)
#define ATT_SBLK() do { ATT_SBAR(); float mn_, al_; partialSM(p0, p1, m_reg, mn_, al_, C, thr_raw); finishSM(p0, p1, al_, l_reg, pa0, pa1, pa2, pa3); ATT_RESC(al_); ATT_SBAR(); } while (0)
  f32x16 p0, p1; bf16x8 pa0, pa1, pa2, pa3; constexpr int NT = SEQ / KVBLK;
  ATT_LOADK(st_, 0);
  __syncthreads();
  ATT_WRITEK(0, st_);
  ATT_LOADV(st_, 0); ATT_LOADK(st_, 1);
  __syncthreads();
  if (grp == 0) {
#pragma unroll 2
    for (int j = 0; j < NT; ++j) { ATT_MBLK(j); __syncthreads(); ATT_EVENT(j); ATT_SBLK(); __syncthreads(); }
    ATT_SBAR(); pv_d0(o, vb0 + ((NT - 1) & 1) * SHM_V, pa0, pa1, pa2, pa3); ATT_SBAR();
    __syncthreads(); __syncthreads();
  } else {
    ATT_SBAR(); __syncthreads(); ATT_EVENT(0); ATT_MBLK(0); __syncthreads();
#pragma unroll 2
    for (int j = 1; j < NT; ++j) { ATT_SBLK(); __syncthreads(); ATT_EVENT(j); ATT_MBLK(j); __syncthreads(); }
    ATT_SBLK(); __syncthreads();
    ATT_SBAR(); pv_d0(o, vb0 + ((NT - 1) & 1) * SHM_V, pa0, pa1, pa2, pa3); ATT_SBAR();
    __syncthreads();
  }
  if (hi == 0) li_l[r32] = l_reg; asm volatile("s_waitcnt lgkmcnt(0)" ::: "memory");
#pragma unroll
  for (int r = 0; r < 16; ++r) { const float rl = __builtin_amdgcn_rcpf(li_l[crow(r, hi)]);
#pragma unroll
    for (int d = 0; d < 4; ++d) o[d][r] *= rl; }
#undef ATT_LOADV
#undef ATT_LOADK
#undef ATT_WRITEV
#undef ATT_WRITEK
#undef ATT_RESC
#undef ATT_EVENT
#undef ATT_MBLK
#undef ATT_SBLK
}
__device__ __forceinline__ void store_o(const f32x16 (&v)[4], bf16_t* Ob, ATT_LAS char* lds) {
  int tid_ = threadIdx.x; asm volatile("" : "+v"(tid_));
  const int tid = tid_, lane = tid & 63, r32 = lane & 31, hi = lane >> 5; const int wid = __builtin_amdgcn_readfirstlane(tid >> 6);
  ATT_LAS bf16_t* stg = (ATT_LAS bf16_t*)(lds + wid * 8192);
#pragma unroll
  for (int r = 0; r < 16; ++r) { const int orow = crow(r, hi);
#pragma unroll
    for (int d0 = 0; d0 < 4; ++d0) { const unsigned b = cvtpk(v[d0][r], 0.f); stg[orow * 128 + d0 * 32 + r32] = (bf16_t)(b & 0xffffu); } }
  asm volatile("s_waitcnt lgkmcnt(0)" ::: "memory");
#pragma unroll
  for (int i = 0; i < 8; ++i) { const int row = i * 4 + (lane >> 4), ch = lane & 15;
    const u32x4 w = *(const ATT_LAS u32x4*)(stg + row * 128 + ch * 8);
    *(u32x4*)(Ob + (long)(wid * QBLK + row) * 1024 + ch * 8) = w; }
}
}

constexpr int NWAVES = 8;
constexpr int BATCH = 4, SEQ = 4096, DM = 1024, M = BATCH * SEQ, DFF = 2816, MODW = 6 * DM;
constexpr float EPS = 1e-6f, LAM_INIT0 = 0.2f;
constexpr int NPHASE = 13;
#ifndef MK_N_LAUNCHES
#define MK_N_LAUNCHES 1
#endif
constexpr size_t MiB = 1u << 20;
constexpr size_t WS_CTL = 0, CTL_ZERO_BYTES = 64 * 1024;
constexpr size_t WS_BIAS = 256 * 1024;
constexpr size_t WS_STAT = 1 * MiB + 768 * 1024;
constexpr size_t WS_MOD = 1 * MiB;
constexpr size_t WS_CSA = 1 * MiB + 256 * 1024;
constexpr size_t WS_CSB = 1 * MiB + 512 * 1024;
constexpr size_t WS_GQK = WS_CSB + 16384;
constexpr size_t WS_WAQKV = 2 * MiB, WS_WAO = 8 * MiB, WS_WIN0 = 10 * MiB, WS_WOUT0 = 21 * MiB;
constexpr size_t WS_WBQKV = 26 * MiB + 512 * 1024, WS_WBO = 29 * MiB + 512 * 1024, WS_WIN1 = 31 * MiB + 512 * 1024, WS_WOUT1 = 42 * MiB + 512 * 1024;
constexpr size_t WS_H = 48 * MiB, WS_O = 80 * MiB, WS_Q = 112 * MiB, WS_K = 144 * MiB, WS_V = 176 * MiB, WS_END = 208 * MiB;
constexpr size_t WS_ACT = WS_Q;
static_assert(WS_ACT + (size_t)M * DFF * 2 <= WS_END, "act overlay");
constexpr int RING_BYTES = 131072;
constexpr int EPI_OFF = RING_BYTES;
constexpr int MISC_OFF = RING_BYTES + 8192;
constexpr int LDS_BYTES = 147456;
static_assert(MISC_OFF + 128 <= LDS_BYTES, "LDS map");

#define GAS __attribute__((address_space(1)))
#define LAS __attribute__((address_space(3)))
typedef unsigned short bf16;
typedef unsigned v4u __attribute__((ext_vector_type(4)));
typedef unsigned v2u __attribute__((ext_vector_type(2)));
typedef float f32x4 __attribute__((ext_vector_type(4)));
typedef GAS unsigned gu32;
#define RLX_AGENT __ATOMIC_RELAXED, __HIP_MEMORY_SCOPE_AGENT
#define LDS_WAIT() asm volatile("s_waitcnt lgkmcnt(0)" ::: "memory")
#define VM_WAIT() asm volatile("s_waitcnt vmcnt(0)" ::: "memory")
__device__ __forceinline__ unsigned f2bf(float f) { unsigned u = __builtin_bit_cast(unsigned, f); return (u + 0x7fffu + ((u >> 16) & 1u)) >> 16; }
__device__ __forceinline__ unsigned pk2(float lo, float hi) { return f2bf(lo) | (f2bf(hi) << 16); }

#define XB_TMO      128
#define XB_XCNT(j)  (256  + 64 * (j))
#define XB_XSUB(j)  (1280 + 64 * (j))
#define XB_XGEN(j)  (2304 + 64 * (j))
#define XB_TOP      3328
#define XB_TOPGEN   3392
#define XCD_BAR_WORDS 3456
#define XB_SPIN_CAP (1u << 18)

__device__ __forceinline__ unsigned xb_ld(unsigned* p)              { return __hip_atomic_load(p, __ATOMIC_RELAXED, __HIP_MEMORY_SCOPE_AGENT); }
__device__ __forceinline__ unsigned xb_add(unsigned* p, unsigned v) { return __hip_atomic_fetch_add(p, v, __ATOMIC_RELAXED, __HIP_MEMORY_SCOPE_AGENT); }
__device__ __forceinline__ unsigned xb_xcc_id() { return (unsigned)__builtin_amdgcn_s_getreg((3 << 11) | 20) & 0xFu; }
#define XB_SPIN(cond, bar) do { unsigned _sp = 0; while (cond) { __builtin_amdgcn_s_sleep(1); \
    if ((++_sp & 255u) == 0u) { if (xb_ld(&(bar)[XB_TMO])) break; if (_sp > XB_SPIN_CAP) { atomicAdd(&(bar)[XB_TMO], 1u); break; } } } } while (0)

struct XcdBarrier {
    unsigned* bar; unsigned x;
    volatile LAS unsigned* st;
};

__device__ __forceinline__ XcdBarrier xcd_barrier_post(unsigned* bar, volatile LAS unsigned* st) {
    XcdBarrier b; b.bar = bar; b.x = xb_xcc_id(); b.st = st;
    if (threadIdx.x == 0) (void)xb_add(&bar[XB_XCNT(b.x)], 1u);
    return b;
}
__device__ __forceinline__ void xcd_barrier_complete(unsigned* bar, unsigned x, unsigned& nloc, unsigned& nx) {
    const unsigned G = gridDim.x * gridDim.y * gridDim.z;
    unsigned sum, cnt, mine, sp = 0u;
    for (;;) {
        sum = 0u; cnt = 0u; mine = 0u;
#pragma unroll
        for (unsigned j = 0; j < 16; ++j) { const unsigned c = xb_ld(&bar[XB_XCNT(j)]); sum += c; cnt += (c > 0u) ? 1u : 0u; mine = (j == x) ? c : mine; }
        if (sum == G) break;
        __builtin_amdgcn_s_sleep(1);
        if ((++sp & 255u) == 0u) { if (xb_ld(&bar[XB_TMO])) break; if (sp > XB_SPIN_CAP) { atomicAdd(&bar[XB_TMO], 1u); break; } }
    }
    nloc = mine > 0u ? mine : 1u; nx = cnt > 0u ? cnt : 1u;
}

__device__ __forceinline__ void xcd_barrier(const XcdBarrier& b) {
    asm volatile("s_waitcnt vmcnt(0)" ::: "memory");
    __syncthreads();
    if (threadIdx.x == 0) {
        unsigned* bar = b.bar;
        __builtin_amdgcn_s_waitcnt(0);
        unsigned nloc = b.st[0], nx = b.st[1];
        if (nloc == 0u) { xcd_barrier_complete(bar, b.x, nloc, nx); b.st[0] = nloc; b.st[1] = nx; }
        const unsigned old = xb_add(&bar[XB_XSUB(b.x)], 1u);
        const unsigned gen = old / nloc;
        if (old + 1u == (gen + 1u) * nloc) {
            __builtin_amdgcn_fence(__ATOMIC_RELEASE, "agent");
            asm volatile("s_waitcnt vmcnt(0)" ::: "memory");
            const unsigned og = xb_add(&bar[XB_TOP], 1u);
            const unsigned tg = og / nx;
            if (og + 1u == (tg + 1u) * nx) xb_add(&bar[XB_TOPGEN], 1u);
            else XB_SPIN(xb_ld(&bar[XB_TOPGEN]) == tg, bar);
            __builtin_amdgcn_fence(__ATOMIC_ACQUIRE, "agent");
            xb_add(&bar[XB_XGEN(b.x)], 1u);
            asm volatile("s_waitcnt vmcnt(0)" ::: "memory");
        } else {
            XB_SPIN(xb_ld(&bar[XB_XGEN(b.x)]) == gen, bar);
            __builtin_amdgcn_fence(__ATOMIC_ACQUIRE, "agent");
            asm volatile("s_waitcnt vmcnt(0)" ::: "memory");
        }
    }
    __syncthreads();
}


struct Frame {
    LAS unsigned char* lds;
    volatile LAS unsigned* MISC;
    int tid, lane, wave, vcu, G;
};
__device__ __forceinline__ float wave_sum(float v) {
#pragma unroll
    for (int o = 1; o < 64; o <<= 1) v += __shfl_xor(v, o);
    return v;
}
__device__ const float FREQ_A[8] = {1.000000000e+00f, 1.939227432e-01f, 3.760603070e-02f, 7.292664610e-03f, 1.414213562e-03f, 2.742481884e-04f, 5.318296098e-05f, 1.031338616e-05f};
__device__ const float FREQ_B[32] = {1.000000000e+00f, 7.498942614e-01f, 5.623413324e-01f, 4.216965139e-01f, 3.162277639e-01f, 2.371373773e-01f, 1.778279394e-01f, 1.333521307e-01f, 1.000000015e-01f, 7.498941571e-02f, 5.623413250e-02f, 4.216965288e-02f, 3.162277490e-02f, 2.371373773e-02f, 1.778279431e-02f, 1.333521493e-02f, 9.999999776e-03f, 7.498941850e-03f, 5.623413250e-03f, 4.216964822e-03f, 3.162277630e-03f, 2.371373586e-03f, 1.778279431e-03f, 1.333521446e-03f, 1.000000047e-03f, 7.498942432e-04f, 5.623413017e-04f, 4.216965172e-04f, 3.162277571e-04f, 2.371373703e-04f, 1.778279402e-04f, 1.333521504e-04f};
__device__ __forceinline__ void sincos_acc(float a, float& c, float& s) {
    const double TWO_PI = 6.283185307179586476925286766559, x0 = (double)a;
    const double n = __builtin_rint(x0 * (1.0 / TWO_PI)), x = x0 - n * TWO_PI, x2 = x * x;
    double ts = 1.0, tc = 1.0;
#pragma unroll
    for (int k = 14; k >= 1; --k) { ts = 1.0 - x2 * ts * (1.0 / (double)((2 * k) * (2 * k + 1))); tc = 1.0 - x2 * tc * (1.0 / (double)((2 * k - 1) * (2 * k))); }
    s = (float)(x * ts); c = (float)tc;
}
__device__ __forceinline__ int colmap(int kind, int n) {
    if (kind == 1) { if (n >= 2048) return n; const int p = n & 63, d = p < 16 ? ((p & 1) ? (p >> 1) + 8 : (p >> 1)) : p; return (n & ~63) + d; }
    if (kind == 2) { if (n >= 1280) return n; const int p = n & 127, pr = p >> 1, first = pr < 32 ? pr : pr + 32; return (n & ~127) + ((p & 1) ? first + 32 : first); }
    if (kind == 3) { const int t = n >> 8, r = n & 255; return r < 128 ? t * 128 + r : DFF + t * 128 + (r - 128); }
    return n;
}
__device__ __forceinline__ void transpose_item(const float* W, int K, int N, bf16* WT, int kind, LAS float* scr, int item, int lane) {
    const int nblk = N / 32, kb = item / nblk, nb = item % nblk, k0 = 64 * kb, n0 = 32 * nb;
    const int src = colmap(kind, n0 + (lane & 31));
#pragma unroll 8
    for (int i = 0; i < 32; ++i) { const int kk = 2 * i + (lane >> 5); scr[kk * 33 + (lane & 31)] = W[(size_t)(k0 + kk) * N + src]; }
    LDS_WAIT(); asm volatile("" ::: "memory");
    const int c = lane & 7;
#pragma unroll
    for (int j = 0; j < 4; ++j) { const int n = (lane >> 3) + 8 * j; const LAS float* s = scr + (8 * c) * 33 + n;
        v4u o; o.x = pk2(s[0 * 33], s[1 * 33]); o.y = pk2(s[2 * 33], s[3 * 33]); o.z = pk2(s[4 * 33], s[5 * 33]); o.w = pk2(s[6 * 33], s[7 * 33]);
        *(GAS v4u*)(WT + (size_t)(n0 + n) * K + k0 + 8 * c) = o; }
    LDS_WAIT(); asm volatile("" ::: "memory");
}
struct Args { const float* in[20]; float* out; unsigned char* ws; int ph_lo, ph_hi; };

__device__ __forceinline__ void p0_prologue(Frame& F, const Args& a) {
    unsigned char* ws = a.ws;
    {
        LAS float* scr = (LAS float*)(F.lds + F.wave * 16384);
        const int gw = F.vcu * NWAVES + F.wave, NGW = F.G * NWAVES;
        constexpr int I0 = (DM / 64) * (3072 / 32), I1 = (DM / 64) * (DM / 32), I2 = (DM / 64) * (2 * DFF / 32), I3 = (DFF / 64) * (DM / 32), I4 = (DM / 64) * (1536 / 32);
        constexpr int NITEMS = I0 + I1 + I2 + I3 + I4 + I1 + I2 + I3;
        for (int it = gw; it < NITEMS; it += NGW) {
            int r = it;
            if (r < I0) { transpose_item(a.in[6], DM, 3072, (bf16*)(ws + WS_WAQKV), 1, scr, r, F.lane); continue; } r -= I0;
            if (r < I1) { transpose_item(a.in[7], DM, DM, (bf16*)(ws + WS_WAO), 0, scr, r, F.lane); continue; } r -= I1;
            if (r < I2) { transpose_item(a.in[17], DM, 2 * DFF, (bf16*)(ws + WS_WIN0), 3, scr, r, F.lane); continue; } r -= I2;
            if (r < I3) { transpose_item(a.in[18], DFF, DM, (bf16*)(ws + WS_WOUT0), 0, scr, r, F.lane); continue; } r -= I3;
            if (r < I4) { transpose_item(a.in[13], DM, 1536, (bf16*)(ws + WS_WBQKV), 2, scr, r, F.lane); continue; } r -= I4;
            if (r < I1) { transpose_item(a.in[14], DM, DM, (bf16*)(ws + WS_WBO), 0, scr, r, F.lane); continue; } r -= I1;
            if (r < I2) { transpose_item(a.in[17] + (size_t)DM * 2 * DFF, DM, 2 * DFF, (bf16*)(ws + WS_WIN1), 3, scr, r, F.lane); continue; } r -= I2;
            transpose_item(a.in[18] + (size_t)DFF * DM, DFF, DM, (bf16*)(ws + WS_WOUT1), 0, scr, r, F.lane);
        }
    }
    __syncthreads();
    {
        LAS float* cond = (LAS float*)F.lds;
        LAS float* part = (LAS float*)(F.lds + 16384);
        const float* c = a.in[1]; float* mod = (float*)(ws + WS_MOD);
        for (int i = F.tid; i < BATCH * DM; i += NWAVES * 64) { const float v = c[i]; cond[i] = v / (1.0f + __expf(-v)); }
        __syncthreads();
        for (int task = F.vcu; task < 2 * (MODW / 64); task += F.G) {
            const int L = task / (MODW / 64), n0 = (task % (MODW / 64)) * 64;
            const float* W = a.in[2] + (size_t)L * DM * MODW + n0 + F.lane;
            float acc0 = 0.f, acc1 = 0.f, acc2 = 0.f, acc3 = 0.f;
            const int kb = F.wave * 128;
#pragma unroll 8
            for (int k = 0; k < 128; ++k) { const float w = W[(size_t)(kb + k) * MODW];
                acc0 += cond[kb + k] * w; acc1 += cond[DM + kb + k] * w; acc2 += cond[2 * DM + kb + k] * w; acc3 += cond[3 * DM + kb + k] * w; }
            part[(F.wave * 4 + 0) * 64 + F.lane] = acc0; part[(F.wave * 4 + 1) * 64 + F.lane] = acc1; part[(F.wave * 4 + 2) * 64 + F.lane] = acc2; part[(F.wave * 4 + 3) * 64 + F.lane] = acc3;
            __syncthreads();
            if (F.tid < 256) { const int b = F.tid >> 6, l = F.tid & 63; float s = 0.f;
#pragma unroll
                for (int w = 0; w < 8; ++w) s += part[(w * 4 + b) * 64 + l];
                mod[((size_t)L * BATCH + b) * MODW + n0 + l] = s + a.in[3][(size_t)L * MODW + n0 + l]; }
            __syncthreads();
        }
    }
    {
        float* csa = (float*)(ws + WS_CSA); float* csb = (float*)(ws + WS_CSB);
        if (F.vcu == 0 && F.tid < 256) ((float*)(ws + WS_GQK))[F.tid] = F.tid < 128 ? a.in[15][F.tid] : a.in[16][F.tid - 128];
        for (int e = F.vcu * (NWAVES * 64) + F.tid; e < SEQ * 8 + 64 * 32; e += F.G * NWAVES * 64) {
            float cc, ss;
            if (e < SEQ * 8) { const int t = e >> 3, i = e & 7; sincos_acc((float)t * FREQ_A[i], cc, ss); csa[t * 16 + i] = cc; csa[t * 16 + 8 + i] = ss; }
            else { const int e2 = e - SEQ * 8, p = e2 >> 5, i = e2 & 31; sincos_acc((float)p * FREQ_B[i], cc, ss); csb[p * 64 + i] = cc; csb[p * 64 + 32 + i] = ss; }
        }
    }
}
__device__ __forceinline__ void bias_tasks(Frame& F, const Args& a) {
    unsigned char* ws = a.ws;
    LAS float* shl = (LAS float*)F.lds;
    LAS float* part = (LAS float*)(F.lds + 16384);
    const float* mod = (const float*)(ws + WS_MOD); float* bias = (float*)(ws + WS_BIAS);
    constexpr int T0 = 2 * DFF / 64, T1 = 1536 / 64;
    for (int task = F.vcu; task < 2 * T0 + T1; task += F.G) {
        const float* W; const float* sh; float* out; int N, kind, n0;
        if (task < T0) { W = a.in[17]; N = 2 * DFF; kind = 3; n0 = task * 64; sh = mod + 3 * DM; out = bias; }
        else if (task < T0 + T1) { W = a.in[13]; N = 1536; kind = 2; n0 = (task - T0) * 64; sh = mod + (size_t)BATCH * MODW; out = bias + 4 * 2 * DFF; }
        else { W = a.in[17] + (size_t)DM * 2 * DFF; N = 2 * DFF; kind = 3; n0 = (task - T0 - T1) * 64; sh = mod + (size_t)BATCH * MODW + 3 * DM; out = bias + 4 * 2 * DFF + 4 * 1536; }
        for (int i = F.tid; i < BATCH * DM; i += NWAVES * 64) shl[i] = sh[(size_t)(i >> 10) * MODW + (i & 1023)];
        __syncthreads();
        const float* Wc = W + colmap(kind, n0 + F.lane);
        float acc0 = 0.f, acc1 = 0.f, acc2 = 0.f, acc3 = 0.f;
        const int kb = F.wave * 128;
#pragma unroll 8
        for (int k = 0; k < 128; ++k) { const float w = Wc[(size_t)(kb + k) * N];
            acc0 += shl[kb + k] * w; acc1 += shl[DM + kb + k] * w; acc2 += shl[2 * DM + kb + k] * w; acc3 += shl[3 * DM + kb + k] * w; }
        part[(F.wave * 4 + 0) * 64 + F.lane] = acc0; part[(F.wave * 4 + 1) * 64 + F.lane] = acc1; part[(F.wave * 4 + 2) * 64 + F.lane] = acc2; part[(F.wave * 4 + 3) * 64 + F.lane] = acc3;
        __syncthreads();
        if (F.tid < 256) { const int b = F.tid >> 6, l = F.tid & 63; float s = 0.f;
#pragma unroll
            for (int w = 0; w < 8; ++w) s += part[(w * 4 + b) * 64 + l];
            out[(size_t)b * N + n0 + l] = s; }
        __syncthreads();
    }
}
__device__ __forceinline__ void norm_rows(Frame& F, const float* x, const float* g, const float* shift, const float* scale, bf16* h) {
    const int gw = F.vcu * NWAVES + F.wave, NGW = F.G * NWAVES;
    for (int m = gw; m < M; m += NGW) {
        const GAS f32x4* xr = (const GAS f32x4*)(x + (size_t)m * DM) + F.lane;
        f32x4 v[4]; float s = 0.f;
#pragma unroll
        for (int j = 0; j < 4; ++j) { v[j] = xr[64 * j]; s += (v[j].x * v[j].x + v[j].y * v[j].y) + (v[j].z * v[j].z + v[j].w * v[j].w); }
        const float rstd = 1.0f / sqrtf(wave_sum(s) * (1.f / DM) + EPS);
        const int b = m / SEQ; const float* sh = shift + (size_t)b * MODW; const float* sc = scale + (size_t)b * MODW;
        GAS v2u* o8 = (GAS v2u*)(h + (size_t)m * DM) + F.lane;
#pragma unroll
        for (int j = 0; j < 4; ++j) { const int col = 4 * F.lane + 256 * j;
            const f32x4 gg = *(const f32x4*)(g + col), s1 = *(const f32x4*)(sc + col), s0 = *(const f32x4*)(sh + col);
            const f32x4 y = ((v[j] * rstd) * gg) * (s1 + 1.0f) + s0;
            v2u w; w.x = pk2(y.x, y.y); w.y = pk2(y.z, y.w); o8[64 * j] = w; }
    }
}
__device__ __forceinline__ void final_norm(Frame& F, float* x, const float* g) {
    const int gw = F.vcu * NWAVES + F.wave, NGW = F.G * NWAVES;
    for (int m = gw; m < M; m += NGW) {
        GAS f32x4* xr = (GAS f32x4*)(x + (size_t)m * DM) + F.lane;
        f32x4 v[4]; float s = 0.f;
#pragma unroll
        for (int j = 0; j < 4; ++j) { v[j] = xr[64 * j]; s += (v[j].x * v[j].x + v[j].y * v[j].y) + (v[j].z * v[j].z + v[j].w * v[j].w); }
        const float rstd = 1.0f / sqrtf(wave_sum(s) * (1.f / DM) + EPS);
#pragma unroll
        for (int j = 0; j < 4; ++j) { const f32x4 gg = *(const f32x4*)(g + 4 * F.lane + 256 * j); xr[64 * j] = (v[j] * rstd) * gg; }
    }
}
__device__ __forceinline__ void attn_phase_A(Frame& F, const bf16* Q, const bf16* K, const bf16* V, bf16* O, float* scr, const float* lq1, const float* lk1, const float* lq2, const float* lk2, const float* subg) {
    const float lam = __expf(wave_sum(lq1[F.lane] * lk1[F.lane])) - __expf(wave_sum(lq2[F.lane] * lk2[F.lane])) + LAM_INIT0;
    const int wid = F.wave;
    LAS char* lds = (LAS char*)F.lds;
    constexpr float C = 0.125f * 1.4426950408889634f;
    for (int uid = F.vcu; uid < 512; uid += F.G) {
        const int bh = (uid & 255) >> 3, qb = ((uid & 7) << 1) | (uid >> 8), b = bh >> 3, h = bh & 7;
        const size_t row0 = (size_t)b * SEQ + (size_t)qb * 256, krow0 = (size_t)b * SEQ;
#pragma unroll 1
        for (int c = 0; c < 2; ++c) {
            att::f32x16 o[4];
            att::attn_core<64, 1024>(Q + row0 * DM + h * 128 + c * 64, K + krow0 * DM + h * 128 + c * 64, V + krow0 * DM + h * 128, lds, C, o);
            int ln = threadIdx.x & 63; asm volatile("" : "+v"(ln));
            att::f32x4v* sw = (att::f32x4v*)scr + ((size_t)(uid * 8 + wid) * 16) * 64 + ln;
            if (c == 0) {
#pragma unroll
                for (int r = 0; r < 16; ++r) sw[r * 64] = (att::f32x4v){o[0][r], o[1][r], o[2][r], o[3][r]};
            } else {
                float gs[4];
#pragma unroll
                for (int d0 = 0; d0 < 4; ++d0) gs[d0] = subg[d0 * 32 + (ln & 31)] * (1.0f - LAM_INIT0);
#pragma unroll
                for (int r = 0; r < 16; ++r) { const att::f32x4v o0 = sw[r * 64]; float ss = 0.f;
#pragma unroll
                    for (int d0 = 0; d0 < 4; ++d0) { const float v = o0[d0] - lam * o[d0][r]; o[d0][r] = v; ss += v * v; }
                    ss += __shfl_xor(ss, 1); ss += __shfl_xor(ss, 2); ss += __shfl_xor(ss, 4); ss += __shfl_xor(ss, 8); ss += __shfl_xor(ss, 16);
                    const float rs = 1.0f / sqrtf(ss * (1.0f / 128.0f) + EPS);
#pragma unroll
                    for (int d0 = 0; d0 < 4; ++d0) o[d0][r] *= rs * gs[d0];
                    if ((r & 3) == 3) asm volatile("" ::: "memory"); }
                __syncthreads();
                att::store_o(o, O + row0 * DM + h * 128, lds);
            }
        }
    }
}
__device__ __forceinline__ void attn_phase_B(Frame& F, const bf16* Q, const bf16* K, const bf16* V, bf16* O) {
    LAS char* lds = (LAS char*)F.lds;
    constexpr float C = 0.08838834764831845f * 1.4426950408889634f;
    for (int uid = F.vcu; uid < 512; uid += F.G) {
        const int grp = (uid & 255) >> 5, w = ((uid & 31) << 1) | (uid >> 8), b = grp >> 1, kvh = grp & 1, hq = kvh * 4 + (w >> 4), qb = w & 15;
        const size_t row0 = (size_t)b * SEQ + (size_t)qb * 256, krow0 = (size_t)b * SEQ;
        att::f32x16 o[4];
        att::attn_core<128, 256>(Q + row0 * DM + hq * 128, K + krow0 * 256 + kvh * 128, V + krow0 * 256 + kvh * 128, lds, C, o);
        __syncthreads();
        att::store_o(o, O + row0 * DM + hq * 128, lds);
    }
}

#ifndef PHMASK
#define PHMASK 0xFFFF
#endif
#define KIND(b) (((PHMASK) >> (b)) & 1)
#ifndef REPMASK
#define REPMASK 0
#endif
#define REP(b) for (int rep_ = 0; rep_ < 1 + (((REPMASK) >> (b)) & 1); ++rep_)
constexpr bool USE_BAR = (MK_N_LAUNCHES != NPHASE);
#define IN(k) (lo <= (k) && (k) < hi)
#define SEAM(k) do { if (USE_BAR && IN((k) + 1)) xcd_barrier(bar); } while (0)
__device__ __forceinline__ void refresh(Frame& F) { int t = threadIdx.x; asm volatile("" : "+v"(t)); F.tid = t; F.lane = t & 63; F.wave = __builtin_amdgcn_readfirstlane(t >> 6); }

template <int L>
__device__ __forceinline__ void layer_phases(Frame& F, const Args& args, const int lo, const int hi, const XcdBarrier& bar) {
    constexpr int pb = (L == 0) ? 1 : 6;
    unsigned char* ws = args.ws;
    const float* x = args.in[0]; float* out = args.out;
    const float* modL = (const float*)(ws + WS_MOD) + (size_t)L * BATCH * MODW;
    const float* xin = (L == 0) ? x : (const float*)out;
    bf16 *H = (bf16*)(ws + WS_H), *O = (bf16*)(ws + WS_O), *Qb = (bf16*)(ws + WS_Q), *ACT = (bf16*)(ws + WS_ACT);
    float* stat = (float*)(ws + WS_STAT); const float* biasb = (const float*)(ws + WS_BIAS);
    LAS float* escr = (LAS float*)(F.lds + EPI_OFF);
    if constexpr (L == 0) { if (KIND(1) && IN(pb)) { refresh(F); REP(1) { bias_tasks(F, args); norm_rows(F, xin, args.in[4], modL, modL + DM, H); } SEAM(pb); } }
    if (IN(pb + 1)) {
        if constexpr (L == 0) { if (KIND(2)) REP(2) { pg8::Gemm g{H, (const bf16*)(ws + WS_WAQKV), M, 3072, DM}; pg8::StaticOrder S; S.init(M, 3072, F.G, (int)blockIdx.x);
            pg8::EpiQkvA E{Qb, (size_t)(WS_K - WS_Q) / 2, (const float*)(ws + WS_CSA)};
            pg8::gemm_phase<pg8::EpiQkvA, pg8::StaticOrder, true, true>(F.lds, g, S, E); } }
        else { if (KIND(3)) REP(3) { pg8::Gemm g{H, (const bf16*)(ws + WS_WBQKV), M, 1536, DM}; pg8::StaticOrder S; S.init(M, 1536, F.G, (int)blockIdx.x);
            pg8::EpiQkvB E{stat, biasb + 4 * 2 * DFF, Qb, (size_t)(WS_K - WS_Q) / 2, (const float*)(ws + WS_GQK), (const float*)(ws + WS_CSB), escr};
            pg8::gemm_phase<pg8::EpiQkvB, pg8::StaticOrder, true, true>(F.lds, g, S, E); } }
        SEAM(pb + 1);
    }
    if (IN(pb + 2)) {
        refresh(F);
        bf16 *Kb = (bf16*)(ws + WS_K), *Vb = (bf16*)(ws + WS_V);
        if constexpr (L == 0) { if (KIND(4)) REP(4) attn_phase_A(F, Qb, Kb, Vb, O, out, args.in[8], args.in[9], args.in[10], args.in[11], args.in[12]); }
        else { if (KIND(5)) REP(5) attn_phase_B(F, Qb, Kb, Vb, O); }
        SEAM(pb + 2);
    }
    if (KIND(6) && IN(pb + 3)) { pg8::Gemm g{O, (const bf16*)(ws + (L == 0 ? WS_WAO : WS_WBO)), M, DM, DM}; pg8::StaticOrder S; S.init(M, DM, F.G, (int)blockIdx.x);
        pg8::EpiResid<true> E{xin, out, modL + 2 * DM, args.in[5] + L * DM, modL + 4 * DM, H, stat, escr};
        pg8::gemm_phase<pg8::EpiResid<true>, pg8::StaticOrder, true, true>(F.lds, g, S, E);
        SEAM(pb + 3); }
    if (KIND(8) && IN(pb + 4)) { pg8::Gemm g{H, (const bf16*)(ws + (L == 0 ? WS_WIN0 : WS_WIN1)), M, 2 * DFF, DM}; pg8::StaticOrder S; S.init(M, 2 * DFF, F.G, (int)blockIdx.x);
        pg8::EpiSwiglu E{ACT, DFF, stat, biasb + (L == 0 ? 0 : 4 * 2 * DFF + 4 * 1536)};
        REP(8) pg8::gemm_phase<pg8::EpiSwiglu, pg8::StaticOrder, true, true>(F.lds, g, S, E);
        SEAM(pb + 4); }
    if (KIND(9) && IN(pb + 5)) { pg8::Gemm g{ACT, (const bf16*)(ws + (L == 0 ? WS_WOUT0 : WS_WOUT1)), M, DM, DFF}; pg8::StaticOrder S; S.init(M, DM, F.G, (int)blockIdx.x);
        if constexpr (L == 0) { pg8::EpiResid<true> E{out, out, modL + 5 * DM, args.in[4] + DM, modL + (size_t)BATCH * MODW + DM, H, stat, escr};
            pg8::gemm_phase<pg8::EpiResid<true>, pg8::StaticOrder, true, true>(F.lds, g, S, E); }
        else { pg8::EpiResid<false> E{out, out, modL + 5 * DM, nullptr, nullptr, nullptr, nullptr, escr};
            pg8::gemm_phase<pg8::EpiResid<false>, pg8::StaticOrder, true, true>(F.lds, g, S, E); }
        SEAM(pb + 5); }
}

__global__ void __launch_bounds__(NWAVES * 64, 2) mk_fwd(Args args) {
    extern __shared__ __attribute__((aligned(16))) unsigned char lds[];
    Frame F;
    F.lds = (LAS unsigned char*)lds;
    F.MISC = (volatile LAS unsigned*)(F.lds + MISC_OFF);
    F.tid = threadIdx.x; F.lane = F.tid & 63; F.wave = __builtin_amdgcn_readfirstlane(F.tid >> 6);
    F.G = gridDim.x; { const int bx = blockIdx.x; F.vcu = (F.G % 8 == 0) ? (bx % 8) * (F.G / 8) + bx / 8 : bx; }
    if (F.tid < 32) F.MISC[F.tid] = 0u;
    __syncthreads();
    const int lo = args.ph_lo, hi = args.ph_hi;
    XcdBarrier bar; bar.bar = (unsigned*)(args.ws + WS_CTL); bar.x = 0; bar.st = nullptr;
    if (USE_BAR) bar = xcd_barrier_post((unsigned*)(args.ws + WS_CTL), F.MISC + 8);
    if (KIND(0) && IN(0)) { REP(0) { p0_prologue(F, args); __syncthreads(); } SEAM(0); }
    layer_phases<0>(F, args, lo, hi, bar);
    layer_phases<1>(F, args, lo, hi, bar);
    if (KIND(10) && IN(12)) { refresh(F); final_norm(F, args.out, args.in[19]); }
}
#undef IN
#undef SEAM

extern "C" void kernel_launch(void* const* d_in, const int* in_sizes, int n_in, void* d_out, int out_size, void* d_ws, size_t ws_size, hipStream_t stream) {
    static int grid = 0;
    if (grid == 0) {
        if (n_in != 20 || in_sizes[0] != M * DM || out_size != M * DM || ws_size < WS_END) { fprintf(stderr, "kernel_launch: unexpected shapes (n_in %d, in0 %d, out %d, ws %zu)\n", n_in, n_in > 0 ? in_sizes[0] : -1, out_size, ws_size); grid = -1; return; }
        int dev = 0, cus = 0, per_cu = 0;
        if (hipGetDevice(&dev) != hipSuccess || hipDeviceGetAttribute(&cus, hipDeviceAttributeMultiprocessorCount, dev) != hipSuccess) { grid = -1; return; }
        if (hipFuncSetAttribute((const void*)mk_fwd, hipFuncAttributeMaxDynamicSharedMemorySize, LDS_BYTES) != hipSuccess) { fprintf(stderr, "kernel_launch: hipFuncSetAttribute failed\n"); grid = -1; return; }
        if (hipOccupancyMaxActiveBlocksPerMultiprocessor(&per_cu, (const void*)mk_fwd, NWAVES * 64, LDS_BYTES) != hipSuccess || per_cu < 1) { fprintf(stderr, "kernel_launch: occupancy query says %d blocks per CU\n", per_cu); grid = -1; (void)hipGetLastError(); return; }
        grid = cus;
    }
    if (grid < 0) return;
    if (hipMemsetAsync((char*)d_ws + WS_CTL, 0, CTL_ZERO_BYTES, stream) != hipSuccess) return;
    Args a{};
    for (int i = 0; i < 20; ++i) a.in[i] = (const float*)d_in[i];
    a.out = (float*)d_out; a.ws = (unsigned char*)d_ws;
    constexpr int NL = MK_N_LAUNCHES;
    for (int li = 0; li < NL; ++li) {
        a.ph_lo = li * NPHASE / NL; a.ph_hi = (li + 1) * NPHASE / NL;
        hipLaunchKernelGGL(mk_fwd, dim3(grid), dim3(NWAVES * 64), LDS_BYTES, stream, a);
        const hipError_t le = hipPeekAtLastError();
        if (le != hipSuccess) { fprintf(stderr, "kernel_launch: launch %d failed: %s\n", li, hipGetErrorName(le)); break; }
    }
}
```

```cpp
#include <hip/hip_runtime.h>
#include <hip/hip_bf16.h>
#include <cstdio>
#include <cstdint>
namespace pg8 {
#define PG8_LAS __attribute__((address_space(3)))
typedef unsigned short bf16_t;
typedef short bf16x8 __attribute__((ext_vector_type(8)));
typedef float f32x4 __attribute__((ext_vector_type(4)));
typedef unsigned u32x4 __attribute__((ext_vector_type(4)));
constexpr int BM = 256, BK = 64, HALF = 128, HTB = HALF * BK * 2  , STAGE_BYTES = 8 * HTB, NXCD = 8, WGM = 8;

__host__ __device__ __forceinline__ int lds_byte(int r, int c) { const int st = (r >> 4) * 2 + (c >> 5), rr = r & 15, cc = c & 31, ob = rr * 64 + cc * 2; return st * 1024 + (ob ^ (((ob >> 9) & 1) << 5)); }
__host__ __device__ __forceinline__ void stage_rc(int b, int& R, int& C) { const int st = b / 1024, sb = b % 1024, swz = sb ^ (((sb >> 9) & 1) << 5); R = (st >> 1) * 16 + swz / 64; C = (st & 1) * 32 + (swz % 64) / 2; }
__host__ __device__ __forceinline__ int perm32(int rho) { const int n = rho >> 4, i = rho & 15; return 8 * (i >> 2) + 4 * n + (i & 3); }

struct Unit { int pm, pn; };
struct Gemm { const bf16_t* A; const bf16_t* Bt; int M, N, K; };

struct StaticOrder {
    int nM, nN, nwg, G, c;
    __host__ __device__ void init(int M, int N, int G_, int c_) { nM = M / BM; nN = N / BM; nwg = nM * nN; G = G_; c = c_; }
    __host__ __device__ bool next(int i, Unit& u) const {
        const long L = (long)i * G + c; if (L >= nwg) return false;
        int wgid = (int)L; { const int q = nwg / NXCD, r = nwg % NXCD, xcd = wgid % NXCD, off = wgid / NXCD; wgid = (xcd < r ? xcd * (q + 1) : r * (q + 1) + (xcd - r) * q) + off; }
        const int nig = WGM * nN, gid = wgid / nig, fm = gid * WGM, gsz = (nM - fm) < WGM ? (nM - fm) : WGM;
        u.pm = fm + ((wgid % nig) % gsz); u.pn = (wgid % nig) / gsz; return true;
    }
    __device__ __forceinline__ void a_ready(const Unit&) const {}
    __device__ __forceinline__ void done(const Unit&) const {}
};


__device__ __forceinline__ unsigned cvt_pk_bf16(float lo, float hi) { unsigned r; asm volatile("v_cvt_pk_bf16_f32 %0, %1, %2" : "=v"(r) : "v"(lo), "v"(hi)); return r; }
constexpr int SEQ_ = 4096, DM_ = 1024, MODW_ = 6144;
constexpr float EPS_ = 1e-6f, QSCALE_A = 0.125f * 1.4426950408889634f, QSCALE_B = 0.08838834764831845f * 1.4426950408889634f;
typedef unsigned u32x2 __attribute__((ext_vector_type(2)));

__device__ __forceinline__ void rot4(f32x4& v0, f32x4& v1, const f32x4 c, const f32x4 s) {
    f32x4 r0, r1;
    r0[0] = v0[0] * c[0] - v0[1] * s[0]; r0[1] = v0[1] * c[0] + v0[0] * s[0]; r0[2] = v0[2] * c[1] - v0[3] * s[1]; r0[3] = v0[3] * c[1] + v0[2] * s[1];
    r1[0] = v1[0] * c[2] - v1[1] * s[2]; r1[1] = v1[1] * c[2] + v1[0] * s[2]; r1[2] = v1[2] * c[3] - v1[3] * s[3]; r1[3] = v1[3] * c[3] + v1[2] * s[3];
    v0 = r0; v1 = r1;
}

struct EpiQkvA {
    static constexpr bool PERM = true, AFTER_DRAIN = false;
    bf16_t* Q; size_t tstride; const float* cs;
    __device__ __forceinline__ void operator()(const f32x4 (&acc)[2][2][4][2], const Unit& u, int wr, int wc, int fr, int fq) const {
        const int t3 = u.pn >> 2; bf16_t* base = Q + (size_t)t3 * tstride;
        const int col0 = (u.pn & 3) * BM + wc * 32 + 8 * fq, row0 = u.pm * BM + wr * 64 + fr;
        const bool rope = (t3 < 2) && ((wc & 1) == 0) && (fq < 2);
#pragma unroll
        for (int ai = 0; ai < 2; ++ai)
#pragma unroll
            for (int m = 0; m < 4; ++m) { const int row = row0 + ai * HALF + m * 16, t = row & (SEQ_ - 1);
                f32x4 cv = (f32x4){1.f, 1.f, 1.f, 1.f}, sv = (f32x4){0.f, 0.f, 0.f, 0.f};
                if (rope) { cv = *(const f32x4*)(cs + t * 16 + 4 * fq); sv = *(const f32x4*)(cs + t * 16 + 8 + 4 * fq); }
                bf16_t* rowp = base + (size_t)row * DM_ + col0;
#pragma unroll
                for (int bj = 0; bj < 2; ++bj) { f32x4 v0 = acc[ai][bj][m][0], v1 = acc[ai][bj][m][1];
                    rot4(v0, v1, cv, sv);
                    if (t3 == 0) { v0 = v0 * QSCALE_A; v1 = v1 * QSCALE_A; }
                    u32x4 w; w.x = cvt_pk_bf16(v0[0], v0[1]); w.y = cvt_pk_bf16(v0[2], v0[3]); w.z = cvt_pk_bf16(v1[0], v1[1]); w.w = cvt_pk_bf16(v1[2], v1[3]);
                    *(u32x4*)(rowp + bj * HALF) = w; } }
    }
};

struct EpiQkvB {
    static constexpr bool PERM = true, AFTER_DRAIN = false;
    const float* stat; const float* bias;
    bf16_t* Q; size_t tstride; const float* gtab; const float* cs2;
    PG8_LAS float* scr;
    __device__ __forceinline__ void operator()(f32x4 (&acc)[2][2][4][2], const Unit& u, int wr, int wc, int fr, int fq) const {
        const int pn = u.pn; const bool nrm = pn < 5;
        bf16_t* base = Q + (size_t)(pn < 4 ? 0 : pn - 3) * tstride; const int ld = pn < 4 ? DM_ : 256; const float* g = gtab + (pn < 4 ? 0 : 128);
        const int col0 = (pn < 4 ? pn * BM : 0) + wc * 32 + 8 * fq, row0 = u.pm * BM + wr * 64 + fr;
        {
            const float* bp = bias + ((u.pm * BM) / SEQ_) * 1536 + pn * BM + wc * 32 + 8 * fq;
            f32x4 bv[2][2];
#pragma unroll
            for (int bj = 0; bj < 2; ++bj) { bv[bj][0] = *(const f32x4*)(bp + bj * HALF); bv[bj][1] = *(const f32x4*)(bp + bj * HALF + 4); }
#pragma unroll
            for (int ai = 0; ai < 2; ++ai)
#pragma unroll
                for (int m = 0; m < 4; ++m) { const f32x4 st = *(const f32x4*)(stat + (size_t)(row0 + ai * HALF + m * 16) * 4);
                    const float rr = __builtin_amdgcn_rsqf(((st[0] + st[1]) + (st[2] + st[3])) * (1.0f / DM_) + EPS_);
#pragma unroll
                    for (int bj = 0; bj < 2; ++bj) { acc[ai][bj][m][0] = acc[ai][bj][m][0] * rr + bv[bj][0]; acc[ai][bj][m][1] = acc[ai][bj][m][1] * rr + bv[bj][1]; } }
        }
        if (nrm) {
#pragma unroll
            for (int ai = 0; ai < 2; ++ai)
#pragma unroll
                for (int m = 0; m < 4; ++m)
#pragma unroll
                    for (int bj = 0; bj < 2; ++bj) { const f32x4 a = acc[ai][bj][m][0], b = acc[ai][bj][m][1];
                        float ss = (a[0] * a[0] + a[1] * a[1]) + (a[2] * a[2] + a[3] * a[3]) + (b[0] * b[0] + b[1] * b[1]) + (b[2] * b[2] + b[3] * b[3]);
                        ss += __shfl_xor(ss, 16); ss += __shfl_xor(ss, 32);
                        if (fq == 0) scr[((ai * HALF + wr * 64 + m * 16 + fr) * 2 + bj) * 4 + wc] = ss; }
            asm volatile("s_waitcnt lgkmcnt(0)" ::: "memory"); __builtin_amdgcn_s_barrier(); asm volatile("" ::: "memory");
        }
        const int f0 = 16 * (wc & 1) + 4 * fq, d1 = (wc < 2 ? 16 * wc : 16 * wc + 32) + 4 * fq;
        f32x4 g1 = (f32x4){1.f, 1.f, 1.f, 1.f}, g2 = g1;
        if (nrm) { g1 = *(const f32x4*)(g + d1); g2 = *(const f32x4*)(g + d1 + 32); }
#pragma unroll
        for (int ai = 0; ai < 2; ++ai)
#pragma unroll
            for (int m = 0; m < 4; ++m) { const int row = row0 + ai * HALF + m * 16, t = row & (SEQ_ - 1), pos = wc < 2 ? (t >> 6) : (t & 63);
                f32x4 cv = (f32x4){1.f, 1.f, 1.f, 1.f}, sv = (f32x4){0.f, 0.f, 0.f, 0.f};
                if (nrm) { cv = *(const f32x4*)(cs2 + pos * 64 + f0); sv = *(const f32x4*)(cs2 + pos * 64 + 32 + f0); }
                bf16_t* rowp = base + (size_t)row * ld + col0;
#pragma unroll
                for (int bj = 0; bj < 2; ++bj) { f32x4 v0 = acc[ai][bj][m][0], v1 = acc[ai][bj][m][1];
                    if (nrm) { const f32x4 p = *(const PG8_LAS f32x4*)(scr + ((ai * HALF + wr * 64 + m * 16 + fr) * 2 + bj) * 4);
                        const float rs = __builtin_amdgcn_rsqf(((p[0] + p[1]) + (p[2] + p[3])) * (1.0f / 128.0f) + EPS_) * (pn < 4 ? QSCALE_B : 1.0f);
                        v0[0] *= rs * g1[0]; v0[1] *= rs * g2[0]; v0[2] *= rs * g1[1]; v0[3] *= rs * g2[1]; v1[0] *= rs * g1[2]; v1[1] *= rs * g2[2]; v1[2] *= rs * g1[3]; v1[3] *= rs * g2[3];
                        rot4(v0, v1, cv, sv); }
                    u32x4 w; w.x = cvt_pk_bf16(v0[0], v0[1]); w.y = cvt_pk_bf16(v0[2], v0[3]); w.z = cvt_pk_bf16(v1[0], v1[1]); w.w = cvt_pk_bf16(v1[2], v1[3]);
                    *(u32x4*)(rowp + bj * HALF) = w; } }
    }
};

template <bool EMIT> struct EpiResid {
    static constexpr bool PERM = false, AFTER_DRAIN = false;
    const float* base; float* out; const float* gate;
    const float* g; const float* scale; bf16_t* xm; float* stat; PG8_LAS float* scr;
    __device__ __forceinline__ void operator()(const f32x4 (&acc)[2][2][4][2], const Unit& u, int wr, int wc, int fr, int fq) const {
        const int col0 = u.pn * BM + wc * 32 + 4 * fq, row0 = u.pm * BM + wr * 64 + fr, b = (u.pm * BM) / SEQ_;
        f32x4 gv[2][2], mv[2][2];
#pragma unroll
        for (int bj = 0; bj < 2; ++bj)
#pragma unroll
            for (int n = 0; n < 2; ++n) { gv[bj][n] = *(const f32x4*)(gate + b * MODW_ + col0 + bj * HALF + n * 16);
                if (EMIT) mv[bj][n] = *(const f32x4*)(g + col0 + bj * HALF + n * 16) * (*(const f32x4*)(scale + b * MODW_ + col0 + bj * HALF + n * 16) + 1.0f); }
#pragma unroll
        for (int ai = 0; ai < 2; ++ai)
#pragma unroll
            for (int m = 0; m < 4; ++m) { const size_t off = (size_t)(row0 + ai * HALF + m * 16) * DM_ + col0; float ss = 0.f;
#pragma unroll
                for (int bj = 0; bj < 2; ++bj)
#pragma unroll
                    for (int n = 0; n < 2; ++n) { const f32x4 bs = *(const f32x4*)(base + off + bj * HALF + n * 16); const f32x4 o = bs + gv[bj][n] * acc[ai][bj][m][n];
                        *(f32x4*)(out + off + bj * HALF + n * 16) = o;
                        if (EMIT) { ss += (o[0] * o[0] + o[1] * o[1]) + (o[2] * o[2] + o[3] * o[3]); const f32x4 a = o * mv[bj][n];
                            u32x2 w; w.x = cvt_pk_bf16(a[0], a[1]); w.y = cvt_pk_bf16(a[2], a[3]); *(u32x2*)(xm + off + bj * HALF + n * 16) = w; } }
                if (EMIT) { ss += __shfl_xor(ss, 16); ss += __shfl_xor(ss, 32); if (fq == 0) scr[(ai * HALF + wr * 64 + m * 16 + fr) * 4 + wc] = ss; }
                if (m & 1) asm volatile("" ::: "memory"); }
        if (EMIT) {
            asm volatile("s_waitcnt lgkmcnt(0)" ::: "memory"); __builtin_amdgcn_s_barrier(); asm volatile("" ::: "memory");
            const int t = (wr * 4 + wc) * 64 + (fq * 16 + fr);
            if (t < BM) { const f32x4 p = *(const PG8_LAS f32x4*)(scr + t * 4); stat[(size_t)(u.pm * BM + t) * 4 + u.pn] = (p[0] + p[1]) + (p[2] + p[3]); }
        }
    }
};

struct EpiSwiglu {
    static constexpr bool PERM = true, AFTER_DRAIN = false;
    bf16_t* O; int ldo; const float* stat; const float* bias;
    __device__ __forceinline__ static float sw(float g, float up) { return g * __builtin_amdgcn_rcpf(1.0f + __builtin_amdgcn_exp2f(g * -1.4426950408889634f)) * up; }
    __device__ __forceinline__ void operator()(const f32x4 (&acc)[2][2][4][2], const Unit& u, int wr, int wc, int fr, int fq) const {
        const int col0 = u.pn * HALF + wc * 32 + 8 * fq, row0 = u.pm * BM + wr * 64 + fr;
        const float* bp = bias + ((u.pm * BM) / SEQ_) * (2 * ldo) + u.pn * BM + wc * 32 + 8 * fq;
        const f32x4 bg0 = *(const f32x4*)(bp), bg1 = *(const f32x4*)(bp + 4), bu0 = *(const f32x4*)(bp + HALF), bu1 = *(const f32x4*)(bp + HALF + 4);
#pragma unroll
        for (int ai = 0; ai < 2; ++ai)
#pragma unroll
            for (int m = 0; m < 4; ++m) { const f32x4 st = *(const f32x4*)(stat + (size_t)(row0 + ai * HALF + m * 16) * 4);
                const float rr = __builtin_amdgcn_rsqf(((st[0] + st[1]) + (st[2] + st[3])) * (1.0f / DM_) + EPS_);
                const f32x4 g0 = acc[ai][0][m][0] * rr + bg0, g1 = acc[ai][0][m][1] * rr + bg1, u0 = acc[ai][1][m][0] * rr + bu0, u1 = acc[ai][1][m][1] * rr + bu1;
                u32x4 w; w.x = cvt_pk_bf16(sw(g0[0], u0[0]), sw(g0[1], u0[1])); w.y = cvt_pk_bf16(sw(g0[2], u0[2]), sw(g0[3], u0[3]));
                w.z = cvt_pk_bf16(sw(g1[0], u1[0]), sw(g1[1], u1[1])); w.w = cvt_pk_bf16(sw(g1[2], u1[2]), sw(g1[3], u1[3]));
                *(u32x4*)(O + (size_t)(row0 + ai * HALF + m * 16) * ldo + col0) = w; }
    }
};

template <class Epi, class Sched, bool ALIGN_EPI = false, bool SP2 = false>
__device__ __forceinline__ void gemm_phase(PG8_LAS unsigned char* lds, const Gemm g, const Sched& S, const Epi& E) {
    int tid_ = threadIdx.x; asm volatile("" : "+v"(tid_));
    const int tid = tid_, wid = __builtin_amdgcn_readfirstlane(tid >> 6), lane = tid & 63, wr = wid >> 2, wc = wid & 3, fr = lane & 15, fq = lane >> 4;
    const int K = g.K, nt = K / BK;
    unsigned voffA[2], voffB[2];
#pragma unroll
    for (int i = 0; i < 2; ++i) { int R, C; stage_rc(tid * 16 + i * 8192, R, C); const int Rb = Epi::PERM ? ((R & ~31) + perm32(R & 31)) : R;
        voffA[i] = (unsigned)(R * K + C) * 2u; voffB[i] = (unsigned)(Rb * K + C) * 2u; }
    const size_t kstep = (size_t)(BK * 2);
    const size_t hstep = (size_t)HALF * K * 2;
    const size_t tstep = 2 * hstep;
    const unsigned ldsw = (unsigned)wid * 1024u;
    const int aoff = lds_byte(wr * 64 + fr, fq * 8), boff = lds_byte(wc * 32 + fr, fq * 8);
#define PG8_SA(b, h) (((b) * 2 + (h)) * HTB)
#define PG8_SB(b, h) ((4 + (b) * 2 + (h)) * HTB)
#define PG8_STAGE(bufoff, gbase, voff) do { _Pragma("unroll") for (int _i = 0; _i < 2; ++_i) \
        __builtin_amdgcn_global_load_lds((const unsigned*)((const char*)(gbase) + (voff)[_i]), (PG8_LAS unsigned*)(lds + (bufoff) + ldsw + _i * 8192), 16, 0, 0); } while (0)
#define PG8_LDA(dst, b, h) do { _Pragma("unroll") for (int m = 0; m < 4; ++m) _Pragma("unroll") for (int k = 0; k < 2; ++k) dst[m][k] = *(const PG8_LAS bf16x8*)(lds + PG8_SA(b, h) + aoff + m * 2048 + k * 1024); } while (0)
#define PG8_LDB(dst, b, h) do { _Pragma("unroll") for (int n = 0; n < 2; ++n) _Pragma("unroll") for (int k = 0; k < 2; ++k) dst[n][k] = *(const PG8_LAS bf16x8*)(lds + PG8_SB(b, h) + boff + n * 2048 + k * 1024); } while (0)
#define PG8_MMA(ai, bj, At, Bt) do { __builtin_amdgcn_s_setprio(1); _Pragma("unroll") for (int m = 0; m < 4; ++m) _Pragma("unroll") for (int n = 0; n < 2; ++n) _Pragma("unroll") for (int k = 0; k < 2; ++k) \
        acc[ai][bj][m][n] = __builtin_amdgcn_mfma_f32_16x16x32_bf16(Bt[n][k], At[m][k], acc[ai][bj][m][n], 0, 0, 0); __builtin_amdgcn_s_setprio(0); } while (0)
#define PG8_WAIT_V(n) asm volatile("s_waitcnt vmcnt(" #n ")" ::: "memory")
#define PG8_WAIT_L(n) asm volatile("s_waitcnt lgkmcnt(" #n ")" ::: "memory")
#define PG8_BAR __builtin_amdgcn_s_barrier()
#define PG8_SCHED __builtin_amdgcn_sched_barrier(0)
    Unit cur, nxt; int ui = 0;
    if (!S.next(0, cur)) return;
    f32x4 acc[2][2][4][2];
#pragma unroll
    for (int a = 0; a < 2; ++a)
#pragma unroll
        for (int b = 0; b < 2; ++b)
#pragma unroll
            for (int m = 0; m < 4; ++m)
#pragma unroll
                for (int n = 0; n < 2; ++n) acc[a][b][m][n] = (f32x4){0.f, 0.f, 0.f, 0.f};
    bf16x8 At[4][2], B0[2][2], B1[2][2];
    const char* cA = (const char*)g.A + (size_t)cur.pm * tstep; const char* cB = (const char*)g.Bt + (size_t)cur.pn * tstep;
    S.a_ready(cur);
    if constexpr (SP2) {
        PG8_STAGE(PG8_SB(0, 0), cB, voffB); PG8_STAGE(PG8_SB(0, 1), cB + hstep, voffB); PG8_STAGE(PG8_SA(0, 0), cA, voffA); PG8_STAGE(PG8_SA(0, 1), cA + hstep, voffA);
        if (wr == 1) PG8_BAR;
        PG8_WAIT_V(2); PG8_BAR;
        PG8_STAGE(PG8_SB(1, 0), cB + kstep, voffB); PG8_STAGE(PG8_SA(1, 0), cA + kstep, voffA); PG8_STAGE(PG8_SB(1, 1), cB + hstep + kstep, voffB);
        PG8_WAIT_V(6); PG8_BAR;
    } else {
        PG8_STAGE(PG8_SB(0, 0), cB, voffB); PG8_STAGE(PG8_SA(0, 0), cA, voffA); PG8_STAGE(PG8_SB(0, 1), cB + hstep, voffB); PG8_STAGE(PG8_SA(0, 1), cA + hstep, voffA);
        if (wr == 1) PG8_BAR;
        PG8_WAIT_V(4); PG8_BAR;
        PG8_STAGE(PG8_SB(1, 0), cB + kstep, voffB); PG8_STAGE(PG8_SA(1, 0), cA + kstep, voffA); PG8_STAGE(PG8_SB(1, 1), cB + hstep + kstep, voffB);
        PG8_WAIT_V(6); PG8_BAR;
    }
    for (;;) {
        const bool has_next = S.next(ui + 1, nxt);
        const char* nA = has_next ? (const char*)g.A + (size_t)nxt.pm * tstep : cA; const char* nB = has_next ? (const char*)g.Bt + (size_t)nxt.pn * tstep : cB;
        for (int t = 0; t < nt; t += 2) {
            const bool last = (t == nt - 2);
            const char* a1 = cA + (size_t)(t + 1) * kstep;
            const char* a2 = last ? nA : cA + (size_t)(t + 2) * kstep; const char* b2 = last ? nB : cB + (size_t)(t + 2) * kstep;
            const char* a3 = a2 + kstep; const char* b3 = b2 + kstep;
            if (last && has_next) S.a_ready(nxt);
            if constexpr (SP2) {
            PG8_LDB(B0, 0, 0); PG8_LDB(B1, 0, 1); PG8_SCHED; PG8_LDA(At, 0, 0); PG8_STAGE(PG8_SA(1, 1), a1 + hstep, voffA);
            PG8_WAIT_V(8); PG8_WAIT_L(0); PG8_BAR; PG8_MMA(0, 0, At, B0); PG8_MMA(0, 1, At, B1); PG8_BAR; PG8_SCHED;
            PG8_LDA(At, 0, 1); PG8_STAGE(PG8_SB(0, 0), b2, voffB); PG8_STAGE(PG8_SB(0, 1), b2 + hstep, voffB); PG8_STAGE(PG8_SA(0, 0), a2, voffA);
            PG8_WAIT_V(8); PG8_WAIT_L(0); PG8_BAR; PG8_MMA(1, 0, At, B0); PG8_MMA(1, 1, At, B1); PG8_BAR; PG8_SCHED;
            PG8_LDB(B0, 1, 0); PG8_LDB(B1, 1, 1); PG8_SCHED; PG8_LDA(At, 1, 0); PG8_STAGE(PG8_SA(0, 1), a2 + hstep, voffA);
            PG8_WAIT_V(8); PG8_WAIT_L(0); PG8_BAR; PG8_MMA(0, 0, At, B0); PG8_MMA(0, 1, At, B1); PG8_BAR; PG8_SCHED;
            PG8_LDA(At, 1, 1); PG8_STAGE(PG8_SB(1, 0), b3, voffB); PG8_STAGE(PG8_SB(1, 1), b3 + hstep, voffB); PG8_STAGE(PG8_SA(1, 0), a3, voffA);
            PG8_WAIT_V(8); PG8_WAIT_L(0); PG8_BAR; PG8_MMA(1, 0, At, B0); PG8_MMA(1, 1, At, B1); PG8_BAR; PG8_SCHED;
            } else {
            PG8_LDB(B0, 0, 0); PG8_SCHED; PG8_LDA(At, 0, 0); PG8_STAGE(PG8_SA(1, 1), a1 + hstep, voffA);
            PG8_WAIT_L(8); PG8_BAR; PG8_WAIT_L(0); PG8_MMA(0, 0, At, B0); PG8_BAR; PG8_SCHED;
            PG8_LDB(B1, 0, 1); PG8_STAGE(PG8_SB(0, 0), b2, voffB);
            PG8_BAR; PG8_WAIT_L(0); PG8_MMA(0, 1, At, B1); PG8_BAR;
            PG8_LDA(At, 0, 1); PG8_STAGE(PG8_SA(0, 0), a2, voffA);
            PG8_BAR; PG8_WAIT_L(0); PG8_MMA(1, 0, At, B0); PG8_BAR; PG8_SCHED;
            PG8_STAGE(PG8_SB(0, 1), b2 + hstep, voffB);
            PG8_WAIT_V(6); PG8_BAR; PG8_MMA(1, 1, At, B1); PG8_BAR;
            PG8_LDB(B0, 1, 0); PG8_SCHED; PG8_LDA(At, 1, 0); PG8_STAGE(PG8_SA(0, 1), a2 + hstep, voffA);
            PG8_WAIT_L(8); PG8_BAR; PG8_WAIT_L(0); PG8_MMA(0, 0, At, B0); PG8_BAR; PG8_SCHED;
            PG8_LDB(B1, 1, 1); PG8_STAGE(PG8_SB(1, 0), b3, voffB);
            PG8_BAR; PG8_WAIT_L(0); PG8_MMA(0, 1, At, B1); PG8_BAR;
            PG8_LDA(At, 1, 1); PG8_STAGE(PG8_SA(1, 0), a3, voffA);
            PG8_BAR; PG8_WAIT_L(0); PG8_MMA(1, 0, At, B0); PG8_BAR; PG8_SCHED;
            PG8_STAGE(PG8_SB(1, 1), b3 + hstep, voffB);
            PG8_WAIT_V(6); PG8_BAR; PG8_MMA(1, 1, At, B1); PG8_BAR;
            }
        }
        if constexpr (ALIGN_EPI) { if (wr == 0) PG8_BAR; }
        if constexpr (!Epi::AFTER_DRAIN) { E(acc, cur, wr, wc, fr, fq); S.done(cur); }
        if (!has_next) break;
#pragma unroll
        for (int a = 0; a < 2; ++a)
#pragma unroll
            for (int b = 0; b < 2; ++b)
#pragma unroll
                for (int m = 0; m < 4; ++m)
#pragma unroll
                    for (int n = 0; n < 2; ++n) acc[a][b][m][n] = (f32x4){0.f, 0.f, 0.f, 0.f};
        cur = nxt; cA = nA; cB = nB; ++ui;
        if constexpr (ALIGN_EPI) { if (wr == 1) PG8_BAR; }
    }
    PG8_WAIT_V(0);
    if constexpr (!ALIGN_EPI) { if (wr == 0) PG8_BAR; }
    PG8_BAR;
    if constexpr (Epi::AFTER_DRAIN) { E.fused(acc, cur, wr, wc, fr, fq, lds, wid, lane); S.done(cur); }
#undef PG8_SA
#undef PG8_SB
#undef PG8_STAGE
#undef PG8_LDA
#undef PG8_LDB
#undef PG8_MMA
#undef PG8_WAIT_V
#undef PG8_WAIT_L
#undef PG8_BAR
#undef PG8_SCHED
}
}

namespace att {
#define ATT_LAS __attribute__((address_space(3)))
typedef unsigned short bf16_t;
using bf16x8 = __attribute__((ext_vector_type(8))) short;
using s16x4  = __attribute__((ext_vector_type(4))) short;
using f32x16 = __attribute__((ext_vector_type(16))) float;
using u32x4  = __attribute__((ext_vector_type(4))) unsigned;
using f32x4v = __attribute__((ext_vector_type(4))) float;
constexpr int NW = 8, QBLK = 32, KVBLK = 64, DV = 128, LDQ = 1024, SEQ = 4096;
constexpr int SHM_V = KVBLK * DV * 2, SHM_K = 64 * 272;
constexpr int LDS_V = 0, LDS_K = 2 * SHM_V, LDS_WS = 2 * SHM_V + 2 * SHM_K, LDS_BYTES = LDS_WS + NW * 64 * 4;
#define ATT_SBAR() __builtin_amdgcn_sched_barrier(0)
__device__ __forceinline__ int crow(int r, int hi) { return (r & 3) + 8 * (r >> 2) + 4 * hi; }
__device__ __forceinline__ unsigned cvtpk(float lo, float hi) { unsigned r; asm volatile("v_cvt_pk_bf16_f32 %0, %1, %2" : "=v"(r) : "v"(lo), "v"(hi)); return r; }
template <int DQK> __device__ __forceinline__ int kswz(int row, int colB) { return row * (2 * DQK + 16) + colB; }
constexpr float THRL = 11.5f;
__device__ __forceinline__ void check_tile(const bool force, f32x16& p0, f32x16& p1, float& m_ref, float& l_reg, f32x16& negm, f32x16 (&o)[4], ATT_LAS float* al_l, const int r32, const int hi) {
  float pmax = p0[0];
#pragma unroll
  for (int r = 1; r < 16; ++r) pmax = fmaxf(pmax, p0[r]);
#pragma unroll
  for (int r = 0; r < 16; ++r) pmax = fmaxf(pmax, p1[r]);
  { auto rr = __builtin_amdgcn_permlane32_swap(__float_as_uint(pmax), __float_as_uint(pmax), false, false);
    pmax = fmaxf(__uint_as_float(rr[0]), __uint_as_float(rr[1])); }
  if (force || __builtin_expect(__any(pmax > THRL), 0)) {
    const float dl = force ? pmax : fmaxf(pmax, 0.f);
    m_ref += dl;
#pragma unroll
    for (int r = 0; r < 16; ++r) { p0[r] -= dl; p1[r] -= dl; }
#pragma unroll
    for (int r = 0; r < 16; ++r) negm[r] = -m_ref;
    if (!force) {
      const float al = __builtin_amdgcn_exp2f(-dl); l_reg *= al;
      if (hi == 0) al_l[r32] = al; asm volatile("s_waitcnt lgkmcnt(0)" ::: "memory");
#pragma unroll
      for (int d = 0; d < 4; ++d)
#pragma unroll
        for (int r = 0; r < 16; ++r) o[d][r] *= al_l[crow(r, hi)];
    }
  }
}
__device__ __forceinline__ void sm_tile(f32x16& p0, f32x16& p1, float& l_reg, bf16x8& pa0, bf16x8& pa1, bf16x8& pa2, bf16x8& pa3) {
#pragma unroll
  for (int r = 0; r < 16; ++r) p0[r] = __builtin_amdgcn_exp2f(p0[r]);
#pragma unroll
  for (int r = 0; r < 16; ++r) p1[r] = __builtin_amdgcn_exp2f(p1[r]);
  float ps = 0;
#pragma unroll
  for (int r = 0; r < 16; ++r) ps += p0[r];
#pragma unroll
  for (int r = 0; r < 16; ++r) ps += p1[r];
  { auto rr = __builtin_amdgcn_permlane32_swap(__float_as_uint(ps), __float_as_uint(ps), false, false);
    ps = __uint_as_float(rr[0]) + __uint_as_float(rr[1]); }
  l_reg += ps;
#define ATT_PK4(P, BASE, OUT) do { unsigned a0 = cvtpk(P[BASE + 0], P[BASE + 1]), a1 = cvtpk(P[BASE + 2], P[BASE + 3]);   \
    unsigned b0 = cvtpk(P[BASE + 4], P[BASE + 5]), b1 = cvtpk(P[BASE + 6], P[BASE + 7]);                              \
    auto r0 = __builtin_amdgcn_permlane32_swap(a0, b0, false, false); auto r1 = __builtin_amdgcn_permlane32_swap(a1, b1, false, false); \
    u32x4 w = {r0[0], r1[0], r0[1], r1[1]}; OUT = __builtin_bit_cast(bf16x8, w); } while (0)
  ATT_PK4(p0, 0, pa0); ATT_PK4(p0, 8, pa1); ATT_PK4(p1, 0, pa2); ATT_PK4(p1, 8, pa3);
#undef ATT_PK4
}
template <int DQK> __device__ __forceinline__ void qkt(f32x16& p0, f32x16& p1, const ATT_LAS char* Ks, const bf16x8* qr, int r32, int hi) {
  p0 = f32x16{}; p1 = f32x16{};
#pragma unroll
  for (int d0 = 0; d0 < DQK / 16; ++d0) { const int cb = (d0 * 16 + hi * 8) * 2;
    const bf16x8 b0 = *reinterpret_cast<const ATT_LAS bf16x8*>(Ks + kswz<DQK>(r32, cb));
    const bf16x8 b1 = *reinterpret_cast<const ATT_LAS bf16x8*>(Ks + kswz<DQK>(32 + r32, cb));
    p0 = __builtin_amdgcn_mfma_f32_32x32x16_bf16(b0, qr[d0], p0, 0, 0, 0);
    p1 = __builtin_amdgcn_mfma_f32_32x32x16_bf16(b1, qr[d0], p1, 0, 0, 0); }
}
__device__ __forceinline__ int v_st(int k, int c) { const int kk = (k & ~0xC) | ((k & 4) << 1) | ((k & 8) >> 1); return ((kk >> 3) * 4 + (c >> 5)) * 512 + ((kk & 7) * 32 + (c & 31)) * 2; }
__device__ __forceinline__ int v_rd_base(int lane) { return ((lane & 3) << 3) | (((lane >> 2) & 3) << 6) | (((lane >> 4) & 1) << 5) | (((lane >> 5) & 1) << 8); }
constexpr int v_rd_off(int d0, int ks, int half) { return d0 * 512 + ks * 4096 + half * 2048; }
template <int OFF> __device__ __forceinline__ s16x4 tr_read(int vb) {
  s16x4 r; asm volatile("ds_read_b64_tr_b16 %0, %1 offset:%2" : "=&v"(r) : "v"(vb), "i"(OFF) : "memory"); return r;
}
template <int D0> __device__ __forceinline__ void pv_one(f32x16& od, int vb, bf16x8 pa0, bf16x8 pa1, bf16x8 pa2, bf16x8 pa3) {
  const s16x4 l0 = tr_read<v_rd_off(D0, 0, 0)>(vb), h0 = tr_read<v_rd_off(D0, 0, 1)>(vb), l1 = tr_read<v_rd_off(D0, 1, 0)>(vb), h1 = tr_read<v_rd_off(D0, 1, 1)>(vb);
  const s16x4 l2 = tr_read<v_rd_off(D0, 2, 0)>(vb), h2 = tr_read<v_rd_off(D0, 2, 1)>(vb), l3 = tr_read<v_rd_off(D0, 3, 0)>(vb), h3 = tr_read<v_rd_off(D0, 3, 1)>(vb);
  asm volatile("s_waitcnt lgkmcnt(0)" ::: "memory"); ATT_SBAR();
#define ATT_PK(L, H) (bf16x8){L[0], L[1], L[2], L[3], H[0], H[1], H[2], H[3]}
  od = __builtin_amdgcn_mfma_f32_32x32x16_bf16(pa0, ATT_PK(l0, h0), od, 0, 0, 0);
  od = __builtin_amdgcn_mfma_f32_32x32x16_bf16(pa1, ATT_PK(l1, h1), od, 0, 0, 0);
  od = __builtin_amdgcn_mfma_f32_32x32x16_bf16(pa2, ATT_PK(l2, h2), od, 0, 0, 0);
  od = __builtin_amdgcn_mfma_f32_32x32x16_bf16(pa3, ATT_PK(l3, h3), od, 0, 0, 0);
#undef ATT_PK
}
__device__ __forceinline__ void pv_d0(f32x16* o, int vb, bf16x8 pa0, bf16x8 pa1, bf16x8 pa2, bf16x8 pa3) {
  pv_one<0>(o[0], vb, pa0, pa1, pa2, pa3); pv_one<1>(o[1], vb, pa0, pa1, pa2, pa3); pv_one<2>(o[2], vb, pa0, pa1, pa2, pa3); pv_one<3>(o[3], vb, pa0, pa1, pa2, pa3);
}

template <int OFF> __device__ __forceinline__ bf16x8 rdk(int addr) {
  bf16x8 r; asm volatile("ds_read_b128 %0, %1 offset:%2" : "=v"(r) : "v"(addr), "i"(OFF) : "memory"); return r;
}
#define ATT_MF(A, B, C) __builtin_amdgcn_mfma_f32_32x32x16_bf16(A, B, C, 0, 0, 0)
#define ATT_PKV(L, H) (bf16x8){L[0], L[1], L[2], L[3], H[0], H[1], H[2], H[3]}
#define ATT_WAITL(n) do { asm volatile("s_waitcnt lgkmcnt(" #n ")" ::: "memory"); ATT_SBAR(); } while (0)
template <int DQK, int KB, int VB, bool HASQ, bool HASV>
__device__ __forceinline__ void mblock(f32x16& p0, f32x16& p1, const f32x16& negm, f32x16 (&o)[4], const bf16x8 (&qr)[DQK / 16], const int kaddr, const int vaddr,
                                       const bf16x8 pa0, const bf16x8 pa1, const bf16x8 pa2, const bf16x8 pa3) {
  constexpr int KH = 32 * (2 * DQK + 16);
  bf16x8 kA0, kA1, kA2, kA3, kB0, kB1, kB2, kB3; s16x4 vA0, vA1, vA2, vA3, vA4, vA5, vA6, vA7, vB0, vB1, vB2, vB3, vB4, vB5, vB6, vB7;
#define ATT_IK(S, d) do { k##S##0 = rdk<KB + (d) * 32>(kaddr); k##S##1 = rdk<KB + KH + (d) * 32>(kaddr); k##S##2 = rdk<KB + (d) * 32 + 32>(kaddr); k##S##3 = rdk<KB + KH + (d) * 32 + 32>(kaddr); } while (0)
#define ATT_IV(S, b) do { v##S##0 = tr_read<VB + v_rd_off(b, 0, 0)>(vaddr); v##S##1 = tr_read<VB + v_rd_off(b, 0, 1)>(vaddr); v##S##2 = tr_read<VB + v_rd_off(b, 1, 0)>(vaddr); v##S##3 = tr_read<VB + v_rd_off(b, 1, 1)>(vaddr); \
    v##S##4 = tr_read<VB + v_rd_off(b, 2, 0)>(vaddr); v##S##5 = tr_read<VB + v_rd_off(b, 2, 1)>(vaddr); v##S##6 = tr_read<VB + v_rd_off(b, 3, 0)>(vaddr); v##S##7 = tr_read<VB + v_rd_off(b, 3, 1)>(vaddr); } while (0)
#define ATT_QK0(S, d) do { p0 = ATT_MF(k##S##0, qr[d], negm); p1 = ATT_MF(k##S##1, qr[d], negm); p0 = ATT_MF(k##S##2, qr[d + 1], p0); p1 = ATT_MF(k##S##3, qr[d + 1], p1); ATT_SBAR(); } while (0)
#define ATT_QK(S, d) do { p0 = ATT_MF(k##S##0, qr[d], p0); p1 = ATT_MF(k##S##1, qr[d], p1); p0 = ATT_MF(k##S##2, qr[d + 1], p0); p1 = ATT_MF(k##S##3, qr[d + 1], p1); ATT_SBAR(); } while (0)
#define ATT_PV(S, b) do { o[b] = ATT_MF(pa0, ATT_PKV(v##S##0, v##S##1), o[b]); o[b] = ATT_MF(pa1, ATT_PKV(v##S##2, v##S##3), o[b]); o[b] = ATT_MF(pa2, ATT_PKV(v##S##4, v##S##5), o[b]); o[b] = ATT_MF(pa3, ATT_PKV(v##S##6, v##S##7), o[b]); ATT_SBAR(); } while (0)
  ATT_SBAR();
  if constexpr (HASQ && HASV) {
    if constexpr (DQK == 128) {
      ATT_IK(A, 0); ATT_IK(B, 2);
      ATT_WAITL(4); ATT_QK0(A, 0); ATT_IK(A, 4);
      ATT_WAITL(4); ATT_QK(B, 2); ATT_IK(B, 6);
      ATT_WAITL(4); ATT_QK(A, 4); ATT_IV(A, 0);
      ATT_WAITL(8); ATT_QK(B, 6); ATT_IV(B, 1);
    } else {
      ATT_IK(A, 0); ATT_IK(B, 2);
      ATT_WAITL(4); ATT_QK0(A, 0); ATT_IV(A, 0);
      ATT_WAITL(8); ATT_QK(B, 2); ATT_IV(B, 1);
    }
    ATT_WAITL(8); ATT_PV(A, 0); ATT_IV(A, 2);
    ATT_WAITL(8); ATT_PV(B, 1); ATT_IV(B, 3);
    ATT_WAITL(8); ATT_PV(A, 2);
    ATT_WAITL(0); ATT_PV(B, 3);
  } else if constexpr (HASQ) {
    ATT_IK(A, 0); ATT_IK(B, 2);
    if constexpr (DQK == 128) {
      ATT_WAITL(4); ATT_QK0(A, 0); ATT_IK(A, 4);
      ATT_WAITL(4); ATT_QK(B, 2); ATT_IK(B, 6);
      ATT_WAITL(4); ATT_QK(A, 4);
      ATT_WAITL(0); ATT_QK(B, 6);
    } else {
      ATT_WAITL(4); ATT_QK0(A, 0);
      ATT_WAITL(0); ATT_QK(B, 2);
    }
  } else {
    ATT_IV(A, 0); ATT_IV(B, 1);
    ATT_WAITL(8); ATT_PV(A, 0); ATT_IV(A, 2);
    ATT_WAITL(8); ATT_PV(B, 1); ATT_IV(B, 3);
    ATT_WAITL(8); ATT_PV(A, 2);
    ATT_WAITL(0); ATT_PV(B, 3);
  }
#undef ATT_IK
#undef ATT_IV
#undef ATT_QK0
#undef ATT_QK
#undef ATT_PV
}

template <int DQK, int LDKV>
__device__ __forceinline__ void attn_core(const bf16_t* Qb, const bf16_t* Kh, const bf16_t* Vh, ATT_LAS char* lds, f32x16 (&o)[4]) {
  int tid_ = threadIdx.x; asm volatile("" : "+v"(tid_));
  const int tid = tid_, lane = tid & 63, r32 = lane & 31, hi = lane >> 5; const int wid = __builtin_amdgcn_readfirstlane(tid >> 6); const int grp = wid >> 2;
  ATT_LAS char* V_lds = lds + LDS_V; ATT_LAS char* K_lds = lds + LDS_K;
  ATT_LAS float* ws = (ATT_LAS float*)(lds + LDS_WS) + wid * 64; ATT_LAS float* li_l = ws; ATT_LAS float* al_l = ws + 32;
  float m_ref = 0.f, l_reg = 0.f; f32x16 negm = f32x16{};
#pragma unroll
  for (int d = 0; d < 4; ++d) o[d] = f32x16{};
  bf16x8 qr[DQK / 16]; const int kaddr = (int)(size_t)K_lds + kswz<DQK>(r32, hi * 16);
  const bf16_t* Qw = Qb + (long)(wid * QBLK + r32) * LDQ + hi * 8;
#pragma unroll
  for (int d0 = 0; d0 < DQK / 16; ++d0) qr[d0] = *reinterpret_cast<const bf16x8*>(Qw + d0 * 16);
  const int vaddr = (int)(size_t)V_lds + v_rd_base(lane);
  const int t8 = tid & 255, sr = t8 >> 4, sc = (t8 & 15) * 8, kr = t8 >> 3, kc = (t8 & 7) * 8;
  bf16x8 sg0, sg1, sg2, sg3;
  const unsigned voff = (unsigned)(sr * LDKV + sc), koff = (DQK == 128) ? voff : (unsigned)(kr * LDKV + kc);
#define ATT_LOADV(t) do { const bf16_t* tb_ = Vh + (long)(t) * (KVBLK * LDKV); sg0 = *reinterpret_cast<const bf16x8*>(tb_ + voff); sg1 = *reinterpret_cast<const bf16x8*>(tb_ + 16 * LDKV + voff); \
    sg2 = *reinterpret_cast<const bf16x8*>(tb_ + 32 * LDKV + voff); sg3 = *reinterpret_cast<const bf16x8*>(tb_ + 48 * LDKV + voff); } while (0)
#define ATT_WRITEV(b) do { ATT_LAS char* q_ = V_lds + (b) * SHM_V; *(ATT_LAS bf16x8*)(q_ + v_st(sr, sc)) = sg0; *(ATT_LAS bf16x8*)(q_ + v_st(sr + 16, sc)) = sg1; \
    *(ATT_LAS bf16x8*)(q_ + v_st(sr + 32, sc)) = sg2; *(ATT_LAS bf16x8*)(q_ + v_st(sr + 48, sc)) = sg3; } while (0)
#define ATT_LOADK(t) do { const bf16_t* tb_ = Kh + (long)(t) * (KVBLK * LDKV); if constexpr (DQK == 128) { sg0 = *reinterpret_cast<const bf16x8*>(tb_ + koff); sg1 = *reinterpret_cast<const bf16x8*>(tb_ + 16 * LDKV + koff); \
      sg2 = *reinterpret_cast<const bf16x8*>(tb_ + 32 * LDKV + koff); sg3 = *reinterpret_cast<const bf16x8*>(tb_ + 48 * LDKV + koff); } \
    else { sg0 = *reinterpret_cast<const bf16x8*>(tb_ + koff); sg1 = *reinterpret_cast<const bf16x8*>(tb_ + 32 * LDKV + koff); } } while (0)
#define ATT_WRITEK(b) do { ATT_LAS char* q_ = K_lds + (b) * SHM_K; if constexpr (DQK == 128) { *(ATT_LAS bf16x8*)(q_ + kswz<128>(sr, sc * 2)) = sg0; *(ATT_LAS bf16x8*)(q_ + kswz<128>(sr + 16, sc * 2)) = sg1; \
      *(ATT_LAS bf16x8*)(q_ + kswz<128>(sr + 32, sc * 2)) = sg2; *(ATT_LAS bf16x8*)(q_ + kswz<128>(sr + 48, sc * 2)) = sg3; } \
    else { *(ATT_LAS bf16x8*)(q_ + kswz<64>(kr, kc * 2)) = sg0; *(ATT_LAS bf16x8*)(q_ + kswz<64>(kr + 32, kc * 2)) = sg1; } } while (0)
#define ATT_SBLK(t) do { ATT_SBAR(); if (((t) & 7) == 0) check_tile((t) == 0, p0, p1, m_ref, l_reg, negm, o, al_l, r32, hi); sm_tile(p0, p1, l_reg, pa0, pa1, pa2, pa3); ATT_SBAR(); } while (0)
#define ATT_SBLKU() do { ATT_SBAR(); sm_tile(p0, p1, l_reg, pa0, pa1, pa2, pa3); ATT_SBAR(); } while (0)
  f32x16 p0, p1; bf16x8 pa0 = {}, pa1 = {}, pa2 = {}, pa3 = {}; constexpr int NT = SEQ / KVBLK;
  static_assert(NT % 2 == 0 && NT >= 4, "even tile count");
  if (grp == 0) {
    ATT_LOADV(0);
    __syncthreads();
    __syncthreads();
    mblock<DQK, 0, 0, true, false>(p0, p1, negm, o, qr, kaddr, vaddr, pa0, pa1, pa2, pa3); __syncthreads();
    ATT_WRITEV(0); ATT_LOADV(1); ATT_SBLK(0); __syncthreads();
    for (int j = 1; j < NT - 1; j += 2) {
      mblock<DQK, SHM_K, 0, true, true>(p0, p1, negm, o, qr, kaddr, vaddr, pa0, pa1, pa2, pa3); __syncthreads();
      ATT_WRITEV(1); ATT_LOADV(j + 1); ATT_SBLKU(); __syncthreads();
      mblock<DQK, 0, SHM_V, true, true>(p0, p1, negm, o, qr, kaddr, vaddr, pa0, pa1, pa2, pa3); __syncthreads();
      ATT_WRITEV(0); ATT_LOADV(j + 2); ATT_SBLK(j + 1); __syncthreads();
    }
    mblock<DQK, SHM_K, 0, true, true>(p0, p1, negm, o, qr, kaddr, vaddr, pa0, pa1, pa2, pa3); __syncthreads();
    ATT_WRITEV(1); ATT_SBLKU(); __syncthreads();
    mblock<DQK, 0, SHM_V, false, true>(p0, p1, negm, o, qr, kaddr, vaddr, pa0, pa1, pa2, pa3); __syncthreads();
    __syncthreads();
  } else {
    ATT_LOADK(0);
    __syncthreads();
    ATT_WRITEK(0); ATT_LOADK(1); __syncthreads();
    ATT_WRITEK(1); ATT_LOADK(2); __syncthreads();
    mblock<DQK, 0, 0, true, false>(p0, p1, negm, o, qr, kaddr, vaddr, pa0, pa1, pa2, pa3); __syncthreads();
    for (int j = 1; j < NT - 1; j += 2) {
      ATT_WRITEK(0); if (j + 2 < NT) ATT_LOADK(j + 2); ATT_SBLK(j - 1); __syncthreads();
      mblock<DQK, SHM_K, 0, true, true>(p0, p1, negm, o, qr, kaddr, vaddr, pa0, pa1, pa2, pa3); __syncthreads();
      ATT_WRITEK(1); if (j + 3 < NT) ATT_LOADK(j + 3); ATT_SBLKU(); __syncthreads();
      mblock<DQK, 0, SHM_V, true, true>(p0, p1, negm, o, qr, kaddr, vaddr, pa0, pa1, pa2, pa3); __syncthreads();
    }
    ATT_SBLK(NT - 2); __syncthreads();
    mblock<DQK, SHM_K, 0, true, true>(p0, p1, negm, o, qr, kaddr, vaddr, pa0, pa1, pa2, pa3); __syncthreads();
    ATT_SBLKU(); __syncthreads();
    mblock<DQK, 0, SHM_V, false, true>(p0, p1, negm, o, qr, kaddr, vaddr, pa0, pa1, pa2, pa3); __syncthreads();
  }
  if (hi == 0) li_l[r32] = l_reg; asm volatile("s_waitcnt lgkmcnt(0)" ::: "memory");
#pragma unroll
  for (int r = 0; r < 16; ++r) { const float rl = __builtin_amdgcn_rcpf(li_l[crow(r, hi)]);
#pragma unroll
    for (int d = 0; d < 4; ++d) o[d][r] *= rl; }
#undef ATT_LOADV
#undef ATT_LOADK
#undef ATT_WRITEV
#undef ATT_WRITEK
#undef ATT_SBLK
#undef ATT_SBLKU
}
__device__ __forceinline__ void store_o(const f32x16 (&v)[4], bf16_t* Ob, ATT_LAS char* lds) {
  int tid_ = threadIdx.x; asm volatile("" : "+v"(tid_));
  const int tid = tid_, lane = tid & 63, r32 = lane & 31, hi = lane >> 5; const int wid = __builtin_amdgcn_readfirstlane(tid >> 6);
  ATT_LAS bf16_t* stg = (ATT_LAS bf16_t*)(lds + wid * 8192);
#pragma unroll
  for (int r = 0; r < 16; ++r) { const int orow = crow(r, hi);
#pragma unroll
    for (int d0 = 0; d0 < 4; ++d0) { const unsigned b = cvtpk(v[d0][r], 0.f); stg[orow * 128 + d0 * 32 + r32] = (bf16_t)(b & 0xffffu); } }
  asm volatile("s_waitcnt lgkmcnt(0)" ::: "memory");
#pragma unroll
  for (int i = 0; i < 8; ++i) { const int row = i * 4 + (lane >> 4), ch = lane & 15;
    const u32x4 w = *(const ATT_LAS u32x4*)(stg + row * 128 + ch * 8);
    *(u32x4*)(Ob + (long)(wid * QBLK + row) * 1024 + ch * 8) = w; }
}
}

constexpr int NWAVES = 8;
constexpr int BATCH = 4, SEQ = 4096, DM = 1024, M = BATCH * SEQ, DFF = 2816, MODW = 6 * DM;
constexpr float EPS = 1e-6f, LAM_INIT0 = 0.2f;
constexpr int NPHASE = 13;
#ifndef MK_N_LAUNCHES
#define MK_N_LAUNCHES 1
#endif
constexpr size_t MiB = 1u << 20;
constexpr size_t WS_CTL = 0, CTL_ZERO_BYTES = 64 * 1024;
constexpr size_t WS_BIAS = 256 * 1024;
constexpr size_t WS_STAT = 1 * MiB + 768 * 1024;
constexpr size_t WS_MOD = 1 * MiB;
constexpr size_t WS_CSA = 1 * MiB + 256 * 1024;
constexpr size_t WS_CSB = 1 * MiB + 512 * 1024;
constexpr size_t WS_GQK = WS_CSB + 16384;
constexpr size_t WS_WAQKV = 2 * MiB, WS_WAO = 8 * MiB, WS_WIN0 = 10 * MiB, WS_WOUT0 = 21 * MiB;
constexpr size_t WS_WBQKV = 26 * MiB + 512 * 1024, WS_WBO = 29 * MiB + 512 * 1024, WS_WIN1 = 31 * MiB + 512 * 1024, WS_WOUT1 = 42 * MiB + 512 * 1024;
constexpr size_t WS_H = 48 * MiB, WS_O = 80 * MiB, WS_Q = 112 * MiB, WS_K = 144 * MiB, WS_V = 176 * MiB, WS_END = 208 * MiB;
constexpr size_t WS_ACT = WS_Q;
static_assert(WS_ACT + (size_t)M * DFF * 2 <= WS_END, "act overlay");
constexpr int RING_BYTES = 131072;
constexpr int EPI_OFF = RING_BYTES;
constexpr int MISC_OFF = RING_BYTES + 8192;
constexpr int LDS_BYTES = 147456;
static_assert(MISC_OFF + 128 <= LDS_BYTES, "LDS map");

#define GAS __attribute__((address_space(1)))
#define LAS __attribute__((address_space(3)))
typedef unsigned short bf16;
typedef unsigned v4u __attribute__((ext_vector_type(4)));
typedef unsigned v2u __attribute__((ext_vector_type(2)));
typedef float f32x4 __attribute__((ext_vector_type(4)));
typedef GAS unsigned gu32;
#define RLX_AGENT __ATOMIC_RELAXED, __HIP_MEMORY_SCOPE_AGENT
#define LDS_WAIT() asm volatile("s_waitcnt lgkmcnt(0)" ::: "memory")
#define VM_WAIT() asm volatile("s_waitcnt vmcnt(0)" ::: "memory")
__device__ __forceinline__ unsigned f2bf(float f) { unsigned u = __builtin_bit_cast(unsigned, f); return (u + 0x7fffu + ((u >> 16) & 1u)) >> 16; }
__device__ __forceinline__ unsigned pk2(float lo, float hi) { return f2bf(lo) | (f2bf(hi) << 16); }

#define XB_TMO      128
#define XB_XCNT(j)  (256  + 64 * (j))
#define XB_XSUB(j)  (1280 + 64 * (j))
#define XB_XGEN(j)  (2304 + 64 * (j))
#define XB_TOP      3328
#define XB_TOPGEN   3392
#define XCD_BAR_WORDS 3456
#define XB_SPIN_CAP (1u << 18)

__device__ __forceinline__ unsigned xb_ld(unsigned* p)              { return __hip_atomic_load(p, __ATOMIC_RELAXED, __HIP_MEMORY_SCOPE_AGENT); }
__device__ __forceinline__ unsigned xb_add(unsigned* p, unsigned v) { return __hip_atomic_fetch_add(p, v, __ATOMIC_RELAXED, __HIP_MEMORY_SCOPE_AGENT); }
__device__ __forceinline__ unsigned xb_xcc_id() { return (unsigned)__builtin_amdgcn_s_getreg((3 << 11) | 20) & 0xFu; }
#define XB_SPIN(cond, bar) do { unsigned _sp = 0; while (cond) { __builtin_amdgcn_s_sleep(1); \
    if ((++_sp & 255u) == 0u) { if (xb_ld(&(bar)[XB_TMO])) break; if (_sp > XB_SPIN_CAP) { atomicAdd(&(bar)[XB_TMO], 1u); break; } } } } while (0)

struct XcdBarrier {
    unsigned* bar; unsigned x;
    volatile LAS unsigned* st;
};

__device__ __forceinline__ XcdBarrier xcd_barrier_post(unsigned* bar, volatile LAS unsigned* st) {
    XcdBarrier b; b.bar = bar; b.x = xb_xcc_id(); b.st = st;
    if (threadIdx.x == 0) (void)xb_add(&bar[XB_XCNT(b.x)], 1u);
    return b;
}
__device__ __forceinline__ void xcd_barrier_complete(unsigned* bar, unsigned x, unsigned& nloc, unsigned& nx) {
    const unsigned G = gridDim.x * gridDim.y * gridDim.z;
    unsigned sum, cnt, mine, sp = 0u;
    for (;;) {
        sum = 0u; cnt = 0u; mine = 0u;
#pragma unroll
        for (unsigned j = 0; j < 16; ++j) { const unsigned c = xb_ld(&bar[XB_XCNT(j)]); sum += c; cnt += (c > 0u) ? 1u : 0u; mine = (j == x) ? c : mine; }
        if (sum == G) break;
        __builtin_amdgcn_s_sleep(1);
        if ((++sp & 255u) == 0u) { if (xb_ld(&bar[XB_TMO])) break; if (sp > XB_SPIN_CAP) { atomicAdd(&bar[XB_TMO], 1u); break; } }
    }
    nloc = mine > 0u ? mine : 1u; nx = cnt > 0u ? cnt : 1u;
}

__device__ __forceinline__ void xcd_barrier(const XcdBarrier& b) {
    asm volatile("s_waitcnt vmcnt(0)" ::: "memory");
    __syncthreads();
    if (threadIdx.x == 0) {
        unsigned* bar = b.bar;
        __builtin_amdgcn_s_waitcnt(0);
        unsigned nloc = b.st[0], nx = b.st[1];
        if (nloc == 0u) { xcd_barrier_complete(bar, b.x, nloc, nx); b.st[0] = nloc; b.st[1] = nx; }
        const unsigned old = xb_add(&bar[XB_XSUB(b.x)], 1u);
        const unsigned gen = old / nloc;
        if (old + 1u == (gen + 1u) * nloc) {
            __builtin_amdgcn_fence(__ATOMIC_RELEASE, "agent");
            asm volatile("s_waitcnt vmcnt(0)" ::: "memory");
            const unsigned og = xb_add(&bar[XB_TOP], 1u);
            const unsigned tg = og / nx;
            if (og + 1u == (tg + 1u) * nx) xb_add(&bar[XB_TOPGEN], 1u);
            else XB_SPIN(xb_ld(&bar[XB_TOPGEN]) == tg, bar);
            __builtin_amdgcn_fence(__ATOMIC_ACQUIRE, "agent");
            xb_add(&bar[XB_XGEN(b.x)], 1u);
            asm volatile("s_waitcnt vmcnt(0)" ::: "memory");
        } else {
            XB_SPIN(xb_ld(&bar[XB_XGEN(b.x)]) == gen, bar);
            __builtin_amdgcn_fence(__ATOMIC_ACQUIRE, "agent");
            asm volatile("s_waitcnt vmcnt(0)" ::: "memory");
        }
    }
    __syncthreads();
}


struct Frame {
    LAS unsigned char* lds;
    volatile LAS unsigned* MISC;
    int tid, lane, wave, vcu, G;
};
__device__ __forceinline__ float wave_sum(float v) {
#pragma unroll
    for (int o = 1; o < 64; o <<= 1) v += __shfl_xor(v, o);
    return v;
}
__device__ const float FREQ_A[8] = {1.000000000e+00f, 1.939227432e-01f, 3.760603070e-02f, 7.292664610e-03f, 1.414213562e-03f, 2.742481884e-04f, 5.318296098e-05f, 1.031338616e-05f};
__device__ const float FREQ_B[32] = {1.000000000e+00f, 7.498942614e-01f, 5.623413324e-01f, 4.216965139e-01f, 3.162277639e-01f, 2.371373773e-01f, 1.778279394e-01f, 1.333521307e-01f, 1.000000015e-01f, 7.498941571e-02f, 5.623413250e-02f, 4.216965288e-02f, 3.162277490e-02f, 2.371373773e-02f, 1.778279431e-02f, 1.333521493e-02f, 9.999999776e-03f, 7.498941850e-03f, 5.623413250e-03f, 4.216964822e-03f, 3.162277630e-03f, 2.371373586e-03f, 1.778279431e-03f, 1.333521446e-03f, 1.000000047e-03f, 7.498942432e-04f, 5.623413017e-04f, 4.216965172e-04f, 3.162277571e-04f, 2.371373703e-04f, 1.778279402e-04f, 1.333521504e-04f};
__device__ __forceinline__ void sincos_acc(float a, float& c, float& s) {
    const double TWO_PI = 6.283185307179586476925286766559, x0 = (double)a;
    const double n = __builtin_rint(x0 * (1.0 / TWO_PI)), x = x0 - n * TWO_PI, x2 = x * x;
    double ts = 1.0, tc = 1.0;
#pragma unroll
    for (int k = 14; k >= 1; --k) { ts = 1.0 - x2 * ts * (1.0 / (double)((2 * k) * (2 * k + 1))); tc = 1.0 - x2 * tc * (1.0 / (double)((2 * k - 1) * (2 * k))); }
    s = (float)(x * ts); c = (float)tc;
}
__device__ __forceinline__ int colmap(int kind, int n) {
    if (kind == 1) { if (n >= 2048) return n; const int p = n & 63, d = p < 16 ? ((p & 1) ? (p >> 1) + 8 : (p >> 1)) : p; return (n & ~63) + d; }
    if (kind == 2) { if (n >= 1280) return n; const int p = n & 127, pr = p >> 1, first = pr < 32 ? pr : pr + 32; return (n & ~127) + ((p & 1) ? first + 32 : first); }
    if (kind == 3) { const int t = n >> 8, r = n & 255; return r < 128 ? t * 128 + r : DFF + t * 128 + (r - 128); }
    return n;
}
__device__ __forceinline__ void transpose_item(const float* W, int K, int N, bf16* WT, int kind, LAS float* scr, int item, int lane) {
    const int nblk = N / 32, kb = item / nblk, nb = item % nblk, k0 = 64 * kb, n0 = 32 * nb;
    const int src = colmap(kind, n0 + (lane & 31));
#pragma unroll 8
    for (int i = 0; i < 32; ++i) { const int kk = 2 * i + (lane >> 5); scr[kk * 33 + (lane & 31)] = W[(size_t)(k0 + kk) * N + src]; }
    LDS_WAIT(); asm volatile("" ::: "memory");
    const int c = lane & 7;
#pragma unroll
    for (int j = 0; j < 4; ++j) { const int n = (lane >> 3) + 8 * j; const LAS float* s = scr + (8 * c) * 33 + n;
        v4u o; o.x = pk2(s[0 * 33], s[1 * 33]); o.y = pk2(s[2 * 33], s[3 * 33]); o.z = pk2(s[4 * 33], s[5 * 33]); o.w = pk2(s[6 * 33], s[7 * 33]);
        *(GAS v4u*)(WT + (size_t)(n0 + n) * K + k0 + 8 * c) = o; }
    LDS_WAIT(); asm volatile("" ::: "memory");
}
struct Args { const float* in[20]; float* out; unsigned char* ws; int ph_lo, ph_hi; };

__device__ __forceinline__ void p0_prologue(Frame& F, const Args& a) {
    unsigned char* ws = a.ws;
    {
        LAS float* scr = (LAS float*)(F.lds + F.wave * 16384);
        const int gw = F.vcu * NWAVES + F.wave, NGW = F.G * NWAVES;
        constexpr int I0 = (DM / 64) * (3072 / 32), I1 = (DM / 64) * (DM / 32), I2 = (DM / 64) * (2 * DFF / 32), I3 = (DFF / 64) * (DM / 32), I4 = (DM / 64) * (1536 / 32);
        constexpr int NITEMS = I0 + I1 + I2 + I3 + I4 + I1 + I2 + I3;
        for (int it = gw; it < NITEMS; it += NGW) {
            int r = it;
            if (r < I0) { transpose_item(a.in[6], DM, 3072, (bf16*)(ws + WS_WAQKV), 1, scr, r, F.lane); continue; } r -= I0;
            if (r < I1) { transpose_item(a.in[7], DM, DM, (bf16*)(ws + WS_WAO), 0, scr, r, F.lane); continue; } r -= I1;
            if (r < I2) { transpose_item(a.in[17], DM, 2 * DFF, (bf16*)(ws + WS_WIN0), 3, scr, r, F.lane); continue; } r -= I2;
            if (r < I3) { transpose_item(a.in[18], DFF, DM, (bf16*)(ws + WS_WOUT0), 0, scr, r, F.lane); continue; } r -= I3;
            if (r < I4) { transpose_item(a.in[13], DM, 1536, (bf16*)(ws + WS_WBQKV), 2, scr, r, F.lane); continue; } r -= I4;
            if (r < I1) { transpose_item(a.in[14], DM, DM, (bf16*)(ws + WS_WBO), 0, scr, r, F.lane); continue; } r -= I1;
            if (r < I2) { transpose_item(a.in[17] + (size_t)DM * 2 * DFF, DM, 2 * DFF, (bf16*)(ws + WS_WIN1), 3, scr, r, F.lane); continue; } r -= I2;
            transpose_item(a.in[18] + (size_t)DFF * DM, DFF, DM, (bf16*)(ws + WS_WOUT1), 0, scr, r, F.lane);
        }
    }
    __syncthreads();
    {
        LAS float* cond = (LAS float*)F.lds;
        LAS float* part = (LAS float*)(F.lds + 16384);
        const float* c = a.in[1]; float* mod = (float*)(ws + WS_MOD);
        for (int i = F.tid; i < BATCH * DM; i += NWAVES * 64) { const float v = c[i]; cond[i] = v / (1.0f + __expf(-v)); }
        __syncthreads();
        for (int task = F.vcu; task < 2 * (MODW / 64); task += F.G) {
            const int L = task / (MODW / 64), n0 = (task % (MODW / 64)) * 64;
            const float* W = a.in[2] + (size_t)L * DM * MODW + n0 + F.lane;
            float acc0 = 0.f, acc1 = 0.f, acc2 = 0.f, acc3 = 0.f;
            const int kb = F.wave * 128;
#pragma unroll 8
            for (int k = 0; k < 128; ++k) { const float w = W[(size_t)(kb + k) * MODW];
                acc0 += cond[kb + k] * w; acc1 += cond[DM + kb + k] * w; acc2 += cond[2 * DM + kb + k] * w; acc3 += cond[3 * DM + kb + k] * w; }
            part[(F.wave * 4 + 0) * 64 + F.lane] = acc0; part[(F.wave * 4 + 1) * 64 + F.lane] = acc1; part[(F.wave * 4 + 2) * 64 + F.lane] = acc2; part[(F.wave * 4 + 3) * 64 + F.lane] = acc3;
            __syncthreads();
            if (F.tid < 256) { const int b = F.tid >> 6, l = F.tid & 63; float s = 0.f;
#pragma unroll
                for (int w = 0; w < 8; ++w) s += part[(w * 4 + b) * 64 + l];
                mod[((size_t)L * BATCH + b) * MODW + n0 + l] = s + a.in[3][(size_t)L * MODW + n0 + l]; }
            __syncthreads();
        }
    }
    {
        float* csa = (float*)(ws + WS_CSA); float* csb = (float*)(ws + WS_CSB);
        if (F.vcu == 0 && F.tid < 256) ((float*)(ws + WS_GQK))[F.tid] = F.tid < 128 ? a.in[15][F.tid] : a.in[16][F.tid - 128];
        for (int e = F.vcu * (NWAVES * 64) + F.tid; e < SEQ * 8 + 64 * 32; e += F.G * NWAVES * 64) {
            float cc, ss;
            if (e < SEQ * 8) { const int t = e >> 3, i = e & 7; sincos_acc((float)t * FREQ_A[i], cc, ss); csa[t * 16 + i] = cc; csa[t * 16 + 8 + i] = ss; }
            else { const int e2 = e - SEQ * 8, p = e2 >> 5, i = e2 & 31; sincos_acc((float)p * FREQ_B[i], cc, ss); csb[p * 64 + i] = cc; csb[p * 64 + 32 + i] = ss; }
        }
    }
}
__device__ __forceinline__ void bias_tasks(Frame& F, const Args& a) {
    unsigned char* ws = a.ws;
    LAS float* shl = (LAS float*)F.lds;
    LAS float* part = (LAS float*)(F.lds + 16384);
    const float* mod = (const float*)(ws + WS_MOD); float* bias = (float*)(ws + WS_BIAS);
    constexpr int T0 = 2 * DFF / 64, T1 = 1536 / 64;
    for (int task = F.vcu; task < 2 * T0 + T1; task += F.G) {
        const float* W; const float* sh; float* out; int N, kind, n0;
        if (task < T0) { W = a.in[17]; N = 2 * DFF; kind = 3; n0 = task * 64; sh = mod + 3 * DM; out = bias; }
        else if (task < T0 + T1) { W = a.in[13]; N = 1536; kind = 2; n0 = (task - T0) * 64; sh = mod + (size_t)BATCH * MODW; out = bias + 4 * 2 * DFF; }
        else { W = a.in[17] + (size_t)DM * 2 * DFF; N = 2 * DFF; kind = 3; n0 = (task - T0 - T1) * 64; sh = mod + (size_t)BATCH * MODW + 3 * DM; out = bias + 4 * 2 * DFF + 4 * 1536; }
        for (int i = F.tid; i < BATCH * DM; i += NWAVES * 64) shl[i] = sh[(size_t)(i >> 10) * MODW + (i & 1023)];
        __syncthreads();
        const float* Wc = W + colmap(kind, n0 + F.lane);
        float acc0 = 0.f, acc1 = 0.f, acc2 = 0.f, acc3 = 0.f;
        const int kb = F.wave * 128;
#pragma unroll 8
        for (int k = 0; k < 128; ++k) { const float w = Wc[(size_t)(kb + k) * N];
            acc0 += shl[kb + k] * w; acc1 += shl[DM + kb + k] * w; acc2 += shl[2 * DM + kb + k] * w; acc3 += shl[3 * DM + kb + k] * w; }
        part[(F.wave * 4 + 0) * 64 + F.lane] = acc0; part[(F.wave * 4 + 1) * 64 + F.lane] = acc1; part[(F.wave * 4 + 2) * 64 + F.lane] = acc2; part[(F.wave * 4 + 3) * 64 + F.lane] = acc3;
        __syncthreads();
        if (F.tid < 256) { const int b = F.tid >> 6, l = F.tid & 63; float s = 0.f;
#pragma unroll
            for (int w = 0; w < 8; ++w) s += part[(w * 4 + b) * 64 + l];
            out[(size_t)b * N + n0 + l] = s; }
        __syncthreads();
    }
}
__device__ __forceinline__ void norm_rows(Frame& F, const float* x, const float* g, const float* shift, const float* scale, bf16* h) {
    const int gw = F.vcu * NWAVES + F.wave, NGW = F.G * NWAVES;
    for (int m = gw; m < M; m += NGW) {
        const GAS f32x4* xr = (const GAS f32x4*)(x + (size_t)m * DM) + F.lane;
        f32x4 v[4]; float s = 0.f;
#pragma unroll
        for (int j = 0; j < 4; ++j) { v[j] = xr[64 * j]; s += (v[j].x * v[j].x + v[j].y * v[j].y) + (v[j].z * v[j].z + v[j].w * v[j].w); }
        const float rstd = 1.0f / sqrtf(wave_sum(s) * (1.f / DM) + EPS);
        const int b = m / SEQ; const float* sh = shift + (size_t)b * MODW; const float* sc = scale + (size_t)b * MODW;
        GAS v2u* o8 = (GAS v2u*)(h + (size_t)m * DM) + F.lane;
#pragma unroll
        for (int j = 0; j < 4; ++j) { const int col = 4 * F.lane + 256 * j;
            const f32x4 gg = *(const f32x4*)(g + col), s1 = *(const f32x4*)(sc + col), s0 = *(const f32x4*)(sh + col);
            const f32x4 y = ((v[j] * rstd) * gg) * (s1 + 1.0f) + s0;
            v2u w; w.x = pk2(y.x, y.y); w.y = pk2(y.z, y.w); o8[64 * j] = w; }
    }
}
__device__ __forceinline__ void final_norm(Frame& F, float* x, const float* g) {
    const int gw = F.vcu * NWAVES + F.wave, NGW = F.G * NWAVES;
    for (int m = gw; m < M; m += NGW) {
        GAS f32x4* xr = (GAS f32x4*)(x + (size_t)m * DM) + F.lane;
        f32x4 v[4]; float s = 0.f;
#pragma unroll
        for (int j = 0; j < 4; ++j) { v[j] = xr[64 * j]; s += (v[j].x * v[j].x + v[j].y * v[j].y) + (v[j].z * v[j].z + v[j].w * v[j].w); }
        const float rstd = 1.0f / sqrtf(wave_sum(s) * (1.f / DM) + EPS);
#pragma unroll
        for (int j = 0; j < 4; ++j) { const f32x4 gg = *(const f32x4*)(g + 4 * F.lane + 256 * j); xr[64 * j] = (v[j] * rstd) * gg; }
    }
}
__device__ __forceinline__ void attn_phase_A(Frame& F, const bf16* Q, const bf16* K, const bf16* V, bf16* O, float* scr, const float* lq1, const float* lk1, const float* lq2, const float* lk2, const float* subg) {
    const float lam = __expf(wave_sum(lq1[F.lane] * lk1[F.lane])) - __expf(wave_sum(lq2[F.lane] * lk2[F.lane])) + LAM_INIT0;
    const int wid = F.wave;
    LAS char* lds = (LAS char*)F.lds;
    for (int uid = F.vcu; uid < 512; uid += F.G) {
        const int bh = (uid & 255) >> 3, qb = ((uid & 7) << 1) | (uid >> 8), b = bh >> 3, h = bh & 7;
        const size_t row0 = (size_t)b * SEQ + (size_t)qb * 256, krow0 = (size_t)b * SEQ;
#pragma unroll 1
        for (int c = 0; c < 2; ++c) {
            att::f32x16 o[4];
            att::attn_core<64, 1024>(Q + row0 * DM + h * 128 + c * 64, K + krow0 * DM + h * 128 + c * 64, V + krow0 * DM + h * 128, lds, o);
            int ln = threadIdx.x & 63; asm volatile("" : "+v"(ln));
            att::f32x4v* sw = (att::f32x4v*)scr + ((size_t)(uid * 8 + wid) * 16) * 64 + ln;
            if (c == 0) {
#pragma unroll
                for (int r = 0; r < 16; ++r) sw[r * 64] = (att::f32x4v){o[0][r], o[1][r], o[2][r], o[3][r]};
            } else {
                float gs[4];
#pragma unroll
                for (int d0 = 0; d0 < 4; ++d0) gs[d0] = subg[d0 * 32 + (ln & 31)] * (1.0f - LAM_INIT0);
#pragma unroll
                for (int r = 0; r < 16; ++r) { const att::f32x4v o0 = sw[r * 64]; float ss = 0.f;
#pragma unroll
                    for (int d0 = 0; d0 < 4; ++d0) { const float v = o0[d0] - lam * o[d0][r]; o[d0][r] = v; ss += v * v; }
                    ss += __shfl_xor(ss, 1); ss += __shfl_xor(ss, 2); ss += __shfl_xor(ss, 4); ss += __shfl_xor(ss, 8); ss += __shfl_xor(ss, 16);
                    const float rs = 1.0f / sqrtf(ss * (1.0f / 128.0f) + EPS);
#pragma unroll
                    for (int d0 = 0; d0 < 4; ++d0) o[d0][r] *= rs * gs[d0];
                    if ((r & 3) == 3) asm volatile("" ::: "memory"); }
                __syncthreads();
                att::store_o(o, O + row0 * DM + h * 128, lds);
            }
        }
    }
}
__device__ __forceinline__ void attn_phase_B(Frame& F, const bf16* Q, const bf16* K, const bf16* V, bf16* O) {
    LAS char* lds = (LAS char*)F.lds;
    for (int uid = F.vcu; uid < 512; uid += F.G) {
        const int grp = (uid & 255) >> 5, w = ((uid & 31) << 1) | (uid >> 8), b = grp >> 1, kvh = grp & 1, hq = kvh * 4 + (w >> 4), qb = w & 15;
        const size_t row0 = (size_t)b * SEQ + (size_t)qb * 256, krow0 = (size_t)b * SEQ;
        att::f32x16 o[4];
        att::attn_core<128, 256>(Q + row0 * DM + hq * 128, K + krow0 * 256 + kvh * 128, V + krow0 * 256 + kvh * 128, lds, o);
        __syncthreads();
        att::store_o(o, O + row0 * DM + hq * 128, lds);
    }
}

#ifndef PHMASK
#define PHMASK 0xFFFF
#endif
#define KIND(b) (((PHMASK) >> (b)) & 1)
#ifndef REPMASK
#define REPMASK 0
#endif
#define REP(b) for (int rep_ = 0; rep_ < 1 + (((REPMASK) >> (b)) & 1); ++rep_)
constexpr bool USE_BAR = (MK_N_LAUNCHES != NPHASE);
#define IN(k) (lo <= (k) && (k) < hi)
#define SEAM(k) do { if (USE_BAR && IN((k) + 1)) xcd_barrier(bar); } while (0)
__device__ __forceinline__ void refresh(Frame& F) { int t = threadIdx.x; asm volatile("" : "+v"(t)); F.tid = t; F.lane = t & 63; F.wave = __builtin_amdgcn_readfirstlane(t >> 6); }

template <int L>
__device__ __forceinline__ void layer_phases(Frame& F, const Args& args, const int lo, const int hi, const XcdBarrier& bar) {
    constexpr int pb = (L == 0) ? 1 : 6;
    unsigned char* ws = args.ws;
    const float* x = args.in[0]; float* out = args.out;
    const float* modL = (const float*)(ws + WS_MOD) + (size_t)L * BATCH * MODW;
    const float* xin = (L == 0) ? x : (const float*)out;
    bf16 *H = (bf16*)(ws + WS_H), *O = (bf16*)(ws + WS_O), *Qb = (bf16*)(ws + WS_Q), *ACT = (bf16*)(ws + WS_ACT);
    float* stat = (float*)(ws + WS_STAT); const float* biasb = (const float*)(ws + WS_BIAS);
    LAS float* escr = (LAS float*)(F.lds + EPI_OFF);
    if constexpr (L == 0) { if (KIND(1) && IN(pb)) { refresh(F); REP(1) { bias_tasks(F, args); norm_rows(F, xin, args.in[4], modL, modL + DM, H); } SEAM(pb); } }
    if (IN(pb + 1)) {
        if constexpr (L == 0) { if (KIND(2)) REP(2) { pg8::Gemm g{H, (const bf16*)(ws + WS_WAQKV), M, 3072, DM}; pg8::StaticOrder S; S.init(M, 3072, F.G, (int)blockIdx.x);
            pg8::EpiQkvA E{Qb, (size_t)(WS_K - WS_Q) / 2, (const float*)(ws + WS_CSA)};
            pg8::gemm_phase<pg8::EpiQkvA, pg8::StaticOrder, true, true>(F.lds, g, S, E); } }
        else { if (KIND(3)) REP(3) { pg8::Gemm g{H, (const bf16*)(ws + WS_WBQKV), M, 1536, DM}; pg8::StaticOrder S; S.init(M, 1536, F.G, (int)blockIdx.x);
            pg8::EpiQkvB E{stat, biasb + 4 * 2 * DFF, Qb, (size_t)(WS_K - WS_Q) / 2, (const float*)(ws + WS_GQK), (const float*)(ws + WS_CSB), escr};
            pg8::gemm_phase<pg8::EpiQkvB, pg8::StaticOrder, true, true>(F.lds, g, S, E); } }
        SEAM(pb + 1);
    }
    if (IN(pb + 2)) {
        refresh(F);
        bf16 *Kb = (bf16*)(ws + WS_K), *Vb = (bf16*)(ws + WS_V);
        if constexpr (L == 0) { if (KIND(4)) REP(4) attn_phase_A(F, Qb, Kb, Vb, O, out, args.in[8], args.in[9], args.in[10], args.in[11], args.in[12]); }
        else { if (KIND(5)) REP(5) attn_phase_B(F, Qb, Kb, Vb, O); }
        SEAM(pb + 2);
    }
    if (KIND(6) && IN(pb + 3)) { pg8::Gemm g{O, (const bf16*)(ws + (L == 0 ? WS_WAO : WS_WBO)), M, DM, DM}; pg8::StaticOrder S; S.init(M, DM, F.G, (int)blockIdx.x);
        pg8::EpiResid<true> E{xin, out, modL + 2 * DM, args.in[5] + L * DM, modL + 4 * DM, H, stat, escr};
        pg8::gemm_phase<pg8::EpiResid<true>, pg8::StaticOrder, true, true>(F.lds, g, S, E);
        SEAM(pb + 3); }
    if (KIND(8) && IN(pb + 4)) { pg8::Gemm g{H, (const bf16*)(ws + (L == 0 ? WS_WIN0 : WS_WIN1)), M, 2 * DFF, DM}; pg8::StaticOrder S; S.init(M, 2 * DFF, F.G, (int)blockIdx.x);
        pg8::EpiSwiglu E{ACT, DFF, stat, biasb + (L == 0 ? 0 : 4 * 2 * DFF + 4 * 1536)};
        REP(8) pg8::gemm_phase<pg8::EpiSwiglu, pg8::StaticOrder, true, true>(F.lds, g, S, E);
        SEAM(pb + 4); }
    if (KIND(9) && IN(pb + 5)) { pg8::Gemm g{ACT, (const bf16*)(ws + (L == 0 ? WS_WOUT0 : WS_WOUT1)), M, DM, DFF}; pg8::StaticOrder S; S.init(M, DM, F.G, (int)blockIdx.x);
        if constexpr (L == 0) { pg8::EpiResid<true> E{out, out, modL + 5 * DM, args.in[4] + DM, modL + (size_t)BATCH * MODW + DM, H, stat, escr};
            pg8::gemm_phase<pg8::EpiResid<true>, pg8::StaticOrder, true, true>(F.lds, g, S, E); }
        else { pg8::EpiResid<false> E{out, out, modL + 5 * DM, nullptr, nullptr, nullptr, nullptr, escr};
            pg8::gemm_phase<pg8::EpiResid<false>, pg8::StaticOrder, true, true>(F.lds, g, S, E); }
        SEAM(pb + 5); }
}

__global__ void __launch_bounds__(NWAVES * 64, 2) mk_fwd(Args args) {
    extern __shared__ __attribute__((aligned(16))) unsigned char lds[];
    Frame F;
    F.lds = (LAS unsigned char*)lds;
    F.MISC = (volatile LAS unsigned*)(F.lds + MISC_OFF);
    F.tid = threadIdx.x; F.lane = F.tid & 63; F.wave = __builtin_amdgcn_readfirstlane(F.tid >> 6);
    F.G = gridDim.x; { const int bx = blockIdx.x; F.vcu = (F.G % 8 == 0) ? (bx % 8) * (F.G / 8) + bx / 8 : bx; }
    if (F.tid < 32) F.MISC[F.tid] = 0u;
    __syncthreads();
    const int lo = args.ph_lo, hi = args.ph_hi;
    XcdBarrier bar; bar.bar = (unsigned*)(args.ws + WS_CTL); bar.x = 0; bar.st = nullptr;
    if (USE_BAR) bar = xcd_barrier_post((unsigned*)(args.ws + WS_CTL), F.MISC + 8);
    if (KIND(0) && IN(0)) { REP(0) { p0_prologue(F, args); __syncthreads(); } SEAM(0); }
    layer_phases<0>(F, args, lo, hi, bar);
    layer_phases<1>(F, args, lo, hi, bar);
    if (KIND(10) && IN(12)) { refresh(F); final_norm(F, args.out, args.in[19]); }
}
#undef IN
#undef SEAM

extern "C" void kernel_launch(void* const* d_in, const int* in_sizes, int n_in, void* d_out, int out_size, void* d_ws, size_t ws_size, hipStream_t stream) {
    static int grid = 0;
    if (grid == 0) {
        if (n_in != 20 || in_sizes[0] != M * DM || out_size != M * DM || ws_size < WS_END) { fprintf(stderr, "kernel_launch: unexpected shapes (n_in %d, in0 %d, out %d, ws %zu)\n", n_in, n_in > 0 ? in_sizes[0] : -1, out_size, ws_size); grid = -1; return; }
        int dev = 0, cus = 0, per_cu = 0;
        if (hipGetDevice(&dev) != hipSuccess || hipDeviceGetAttribute(&cus, hipDeviceAttributeMultiprocessorCount, dev) != hipSuccess) { grid = -1; return; }
        if (hipFuncSetAttribute((const void*)mk_fwd, hipFuncAttributeMaxDynamicSharedMemorySize, LDS_BYTES) != hipSuccess) { fprintf(stderr, "kernel_launch: hipFuncSetAttribute failed\n"); grid = -1; return; }
        if (hipOccupancyMaxActiveBlocksPerMultiprocessor(&per_cu, (const void*)mk_fwd, NWAVES * 64, LDS_BYTES) != hipSuccess || per_cu < 1) { fprintf(stderr, "kernel_launch: occupancy query says %d blocks per CU\n", per_cu); grid = -1; (void)hipGetLastError(); return; }
        grid = cus;
    }
    if (grid < 0) return;
    if (hipMemsetAsync((char*)d_ws + WS_CTL, 0, CTL_ZERO_BYTES, stream) != hipSuccess) return;
    Args a{};
    for (int i = 0; i < 20; ++i) a.in[i] = (const float*)d_in[i];
    a.out = (float*)d_out; a.ws = (unsigned char*)d_ws;
    constexpr int NL = MK_N_LAUNCHES;
    for (int li = 0; li < NL; ++li) {
        a.ph_lo = li * NPHASE / NL; a.ph_hi = (li + 1) * NPHASE / NL;
        hipLaunchKernelGGL(mk_fwd, dim3(grid), dim3(NWAVES * 64), LDS_BYTES, stream, a);
        const hipError_t le = hipPeekAtLastError();
        if (le != hipSuccess) { fprintf(stderr, "kernel_launch: launch %d failed: %s\n", li, hipGetErrorName(le)); break; }
    }
}
```

```cpp
#include <hip/hip_runtime.h>
#include <hip/hip_bf16.h>
#include <cstdio>
#include <cstdint>
#include <type_traits>
namespace pg8 {
#define PG8_LAS __attribute__((address_space(3)))
typedef unsigned short bf16_t;
typedef short bf16x8 __attribute__((ext_vector_type(8)));
typedef float f32x4 __attribute__((ext_vector_type(4)));
typedef unsigned u32x4 __attribute__((ext_vector_type(4)));
constexpr int BM = 256, BK = 64, HALF = 128, HTB = HALF * BK * 2  , STAGE_BYTES = 8 * HTB, NXCD = 8, WGM = 8;

__host__ __device__ __forceinline__ int lds_byte(int r, int c) { const int st = (r >> 4) * 2 + (c >> 5), rr = r & 15, cc = c & 31, ob = rr * 64 + cc * 2; return st * 1024 + (ob ^ (((ob >> 9) & 1) << 5)); }
__host__ __device__ __forceinline__ void stage_rc(int b, int& R, int& C) { const int st = b / 1024, sb = b % 1024, swz = sb ^ (((sb >> 9) & 1) << 5); R = (st >> 1) * 16 + swz / 64; C = (st & 1) * 32 + (swz % 64) / 2; }
__host__ __device__ __forceinline__ int perm32(int rho) { const int n = rho >> 4, i = rho & 15; return 8 * (i >> 2) + 4 * n + (i & 3); }

struct Unit { int pm, pn; };
struct Gemm { const bf16_t* A; const bf16_t* Bt; int M, N, K; };

struct StaticOrder {
    int nM, nN, nwg, G, c;
    __host__ __device__ void init(int M, int N, int G_, int c_) { nM = M / BM; nN = N / BM; nwg = nM * nN; G = G_; c = c_; }
    __host__ __device__ bool next(int i, Unit& u) const {
        const long L = (long)i * G + c; if (L >= nwg) return false;
        int wgid = (int)L; { const int q = nwg / NXCD, r = nwg % NXCD, xcd = wgid % NXCD, off = wgid / NXCD; wgid = (xcd < r ? xcd * (q + 1) : r * (q + 1) + (xcd - r) * q) + off; }
        const int nig = WGM * nN, gid = wgid / nig, fm = gid * WGM, gsz = (nM - fm) < WGM ? (nM - fm) : WGM;
        u.pm = fm + ((wgid % nig) % gsz); u.pn = (wgid % nig) / gsz; return true;
    }
    __device__ __forceinline__ void a_ready(const Unit&) const {}
    __device__ __forceinline__ void done(const Unit&) const {}
};


__device__ __forceinline__ unsigned cvt_pk_bf16(float lo, float hi) { unsigned r; asm volatile("v_cvt_pk_bf16_f32 %0, %1, %2" : "=v"(r) : "v"(lo), "v"(hi)); return r; }
constexpr int SEQ_ = 4096, DM_ = 1024, MODW_ = 6144;
constexpr float EPS_ = 1e-6f, QSCALE_A = 0.125f * 1.4426950408889634f, QSCALE_B = 0.08838834764831845f * 1.4426950408889634f;
typedef unsigned u32x2 __attribute__((ext_vector_type(2)));

__device__ __forceinline__ void rot4(f32x4& v0, f32x4& v1, const f32x4 c, const f32x4 s) {
    f32x4 r0, r1;
    r0[0] = v0[0] * c[0] - v0[1] * s[0]; r0[1] = v0[1] * c[0] + v0[0] * s[0]; r0[2] = v0[2] * c[1] - v0[3] * s[1]; r0[3] = v0[3] * c[1] + v0[2] * s[1];
    r1[0] = v1[0] * c[2] - v1[1] * s[2]; r1[1] = v1[1] * c[2] + v1[0] * s[2]; r1[2] = v1[2] * c[3] - v1[3] * s[3]; r1[3] = v1[3] * c[3] + v1[2] * s[3];
    v0 = r0; v1 = r1;
}

struct EpiQkvA {
    static constexpr bool PERM = true, AFTER_DRAIN = false;
    bf16_t* Q; size_t tstride; const float* cs;
    __device__ __forceinline__ void operator()(const f32x4 (&acc)[2][2][4][2], const Unit& u, int wr, int wc, int fr, int fq) const {
        const int t3 = u.pn >> 2; bf16_t* base = Q + (size_t)t3 * tstride;
        const int col0 = (u.pn & 3) * BM + wc * 32 + 8 * fq, row0 = u.pm * BM + wr * 64 + fr;
        const bool rope = (t3 < 2) && ((wc & 1) == 0) && (fq < 2);
#pragma unroll
        for (int ai = 0; ai < 2; ++ai)
#pragma unroll
            for (int m = 0; m < 4; ++m) { const int row = row0 + ai * HALF + m * 16, t = row & (SEQ_ - 1);
                f32x4 cv = (f32x4){1.f, 1.f, 1.f, 1.f}, sv = (f32x4){0.f, 0.f, 0.f, 0.f};
                if (rope) { cv = *(const f32x4*)(cs + t * 16 + 4 * fq); sv = *(const f32x4*)(cs + t * 16 + 8 + 4 * fq); }
                bf16_t* rowp = base + (size_t)row * DM_ + col0;
#pragma unroll
                for (int bj = 0; bj < 2; ++bj) { f32x4 v0 = acc[ai][bj][m][0], v1 = acc[ai][bj][m][1];
                    rot4(v0, v1, cv, sv);
                    if (t3 == 0) { v0 = v0 * QSCALE_A; v1 = v1 * QSCALE_A; }
                    u32x4 w; w.x = cvt_pk_bf16(v0[0], v0[1]); w.y = cvt_pk_bf16(v0[2], v0[3]); w.z = cvt_pk_bf16(v1[0], v1[1]); w.w = cvt_pk_bf16(v1[2], v1[3]);
                    *(u32x4*)(rowp + bj * HALF) = w; } }
    }
};

struct EpiQkvB {
    static constexpr bool PERM = true, AFTER_DRAIN = false;
    const float* stat; const float* bias;
    bf16_t* Q; size_t tstride; const float* gtab; const float* cs2;
    PG8_LAS float* scr;
    __device__ __forceinline__ void operator()(f32x4 (&acc)[2][2][4][2], const Unit& u, int wr, int wc, int fr, int fq) const {
        const int pn = u.pn; const bool nrm = pn < 5;
        bf16_t* base = Q + (size_t)(pn < 4 ? 0 : pn - 3) * tstride; const int ld = pn < 4 ? DM_ : 256; const float* g = gtab + (pn < 4 ? 0 : 128);
        const int col0 = (pn < 4 ? pn * BM : 0) + wc * 32 + 8 * fq, row0 = u.pm * BM + wr * 64 + fr;
        {
            const float* bp = bias + ((u.pm * BM) / SEQ_) * 1536 + pn * BM + wc * 32 + 8 * fq;
            f32x4 bv[2][2];
#pragma unroll
            for (int bj = 0; bj < 2; ++bj) { bv[bj][0] = *(const f32x4*)(bp + bj * HALF); bv[bj][1] = *(const f32x4*)(bp + bj * HALF + 4); }
#pragma unroll
            for (int ai = 0; ai < 2; ++ai)
#pragma unroll
                for (int m = 0; m < 4; ++m) { const f32x4 st = *(const f32x4*)(stat + (size_t)(row0 + ai * HALF + m * 16) * 4);
                    const float rr = __builtin_amdgcn_rsqf(((st[0] + st[1]) + (st[2] + st[3])) * (1.0f / DM_) + EPS_);
#pragma unroll
                    for (int bj = 0; bj < 2; ++bj) { acc[ai][bj][m][0] = acc[ai][bj][m][0] * rr + bv[bj][0]; acc[ai][bj][m][1] = acc[ai][bj][m][1] * rr + bv[bj][1]; } }
        }
        if (nrm) {
#pragma unroll
            for (int ai = 0; ai < 2; ++ai)
#pragma unroll
                for (int m = 0; m < 4; ++m)
#pragma unroll
                    for (int bj = 0; bj < 2; ++bj) { const f32x4 a = acc[ai][bj][m][0], b = acc[ai][bj][m][1];
                        float ss = (a[0] * a[0] + a[1] * a[1]) + (a[2] * a[2] + a[3] * a[3]) + (b[0] * b[0] + b[1] * b[1]) + (b[2] * b[2] + b[3] * b[3]);
                        ss += __shfl_xor(ss, 16); ss += __shfl_xor(ss, 32);
                        if (fq == 0) scr[((ai * HALF + wr * 64 + m * 16 + fr) * 2 + bj) * 4 + wc] = ss; }
            asm volatile("s_waitcnt lgkmcnt(0)" ::: "memory"); __builtin_amdgcn_s_barrier(); asm volatile("" ::: "memory");
        }
        const int f0 = 16 * (wc & 1) + 4 * fq, d1 = (wc < 2 ? 16 * wc : 16 * wc + 32) + 4 * fq;
        f32x4 g1 = (f32x4){1.f, 1.f, 1.f, 1.f}, g2 = g1;
        if (nrm) { g1 = *(const f32x4*)(g + d1); g2 = *(const f32x4*)(g + d1 + 32); }
#pragma unroll
        for (int ai = 0; ai < 2; ++ai)
#pragma unroll
            for (int m = 0; m < 4; ++m) { const int row = row0 + ai * HALF + m * 16, t = row & (SEQ_ - 1), pos = wc < 2 ? (t >> 6) : (t & 63);
                f32x4 cv = (f32x4){1.f, 1.f, 1.f, 1.f}, sv = (f32x4){0.f, 0.f, 0.f, 0.f};
                if (nrm) { cv = *(const f32x4*)(cs2 + pos * 64 + f0); sv = *(const f32x4*)(cs2 + pos * 64 + 32 + f0); }
                bf16_t* rowp = base + (size_t)row * ld + col0;
#pragma unroll
                for (int bj = 0; bj < 2; ++bj) { f32x4 v0 = acc[ai][bj][m][0], v1 = acc[ai][bj][m][1];
                    if (nrm) { const f32x4 p = *(const PG8_LAS f32x4*)(scr + ((ai * HALF + wr * 64 + m * 16 + fr) * 2 + bj) * 4);
                        const float rs = __builtin_amdgcn_rsqf(((p[0] + p[1]) + (p[2] + p[3])) * (1.0f / 128.0f) + EPS_) * (pn < 4 ? QSCALE_B : 1.0f);
                        v0[0] *= rs * g1[0]; v0[1] *= rs * g2[0]; v0[2] *= rs * g1[1]; v0[3] *= rs * g2[1]; v1[0] *= rs * g1[2]; v1[1] *= rs * g2[2]; v1[2] *= rs * g1[3]; v1[3] *= rs * g2[3];
                        rot4(v0, v1, cv, sv); }
                    u32x4 w; w.x = cvt_pk_bf16(v0[0], v0[1]); w.y = cvt_pk_bf16(v0[2], v0[3]); w.z = cvt_pk_bf16(v1[0], v1[1]); w.w = cvt_pk_bf16(v1[2], v1[3]);
                    *(u32x4*)(rowp + bj * HALF) = w; } }
    }
};

template <bool EMIT> struct EpiResid {
    static constexpr bool PERM = false, AFTER_DRAIN = false;
    const float* base; float* out; const float* gate;
    const float* g; const float* scale; bf16_t* xm; float* stat; PG8_LAS float* scr;
    __device__ __forceinline__ void operator()(const f32x4 (&acc)[2][2][4][2], const Unit& u, int wr, int wc, int fr, int fq) const {
        const int col0 = u.pn * BM + wc * 32 + 4 * fq, row0 = u.pm * BM + wr * 64 + fr, b = (u.pm * BM) / SEQ_;
        f32x4 gv[2][2], mv[2][2];
#pragma unroll
        for (int bj = 0; bj < 2; ++bj)
#pragma unroll
            for (int n = 0; n < 2; ++n) { gv[bj][n] = *(const f32x4*)(gate + b * MODW_ + col0 + bj * HALF + n * 16);
                if (EMIT) mv[bj][n] = *(const f32x4*)(g + col0 + bj * HALF + n * 16) * (*(const f32x4*)(scale + b * MODW_ + col0 + bj * HALF + n * 16) + 1.0f); }
#pragma unroll
        for (int ai = 0; ai < 2; ++ai)
#pragma unroll
            for (int m = 0; m < 4; ++m) { const size_t off = (size_t)(row0 + ai * HALF + m * 16) * DM_ + col0; float ss = 0.f;
#pragma unroll
                for (int bj = 0; bj < 2; ++bj)
#pragma unroll
                    for (int n = 0; n < 2; ++n) { const f32x4 bs = *(const f32x4*)(base + off + bj * HALF + n * 16); const f32x4 o = bs + gv[bj][n] * acc[ai][bj][m][n];
                        *(f32x4*)(out + off + bj * HALF + n * 16) = o;
                        if (EMIT) { ss += (o[0] * o[0] + o[1] * o[1]) + (o[2] * o[2] + o[3] * o[3]); const f32x4 a = o * mv[bj][n];
                            u32x2 w; w.x = cvt_pk_bf16(a[0], a[1]); w.y = cvt_pk_bf16(a[2], a[3]); *(u32x2*)(xm + off + bj * HALF + n * 16) = w; } }
                if (EMIT) { ss += __shfl_xor(ss, 16); ss += __shfl_xor(ss, 32); if (fq == 0) scr[(ai * HALF + wr * 64 + m * 16 + fr) * 4 + wc] = ss; }
                if (m & 1) asm volatile("" ::: "memory"); }
        if (EMIT) {
            asm volatile("s_waitcnt lgkmcnt(0)" ::: "memory"); __builtin_amdgcn_s_barrier(); asm volatile("" ::: "memory");
            const int t = (wr * 4 + wc) * 64 + (fq * 16 + fr);
            if (t < BM) { const f32x4 p = *(const PG8_LAS f32x4*)(scr + t * 4); stat[(size_t)(u.pm * BM + t) * 4 + u.pn] = (p[0] + p[1]) + (p[2] + p[3]); }
        }
    }
};

struct EpiSwiglu {
    static constexpr bool PERM = true, AFTER_DRAIN = false;
    bf16_t* O; int ldo; const float* stat; const float* bias;
    __device__ __forceinline__ static float sw(float g, float up) { return g * __builtin_amdgcn_rcpf(1.0f + __builtin_amdgcn_exp2f(g * -1.4426950408889634f)) * up; }
    __device__ __forceinline__ void operator()(const f32x4 (&acc)[2][2][4][2], const Unit& u, int wr, int wc, int fr, int fq) const {
        const int col0 = u.pn * HALF + wc * 32 + 8 * fq, row0 = u.pm * BM + wr * 64 + fr;
        const float* bp = bias + ((u.pm * BM) / SEQ_) * (2 * ldo) + u.pn * BM + wc * 32 + 8 * fq;
        const f32x4 bg0 = *(const f32x4*)(bp), bg1 = *(const f32x4*)(bp + 4), bu0 = *(const f32x4*)(bp + HALF), bu1 = *(const f32x4*)(bp + HALF + 4);
#pragma unroll
        for (int ai = 0; ai < 2; ++ai)
#pragma unroll
            for (int m = 0; m < 4; ++m) { const f32x4 st = *(const f32x4*)(stat + (size_t)(row0 + ai * HALF + m * 16) * 4);
                const float rr = __builtin_amdgcn_rsqf(((st[0] + st[1]) + (st[2] + st[3])) * (1.0f / DM_) + EPS_);
                const f32x4 g0 = acc[ai][0][m][0] * rr + bg0, g1 = acc[ai][0][m][1] * rr + bg1, u0 = acc[ai][1][m][0] * rr + bu0, u1 = acc[ai][1][m][1] * rr + bu1;
                u32x4 w; w.x = cvt_pk_bf16(sw(g0[0], u0[0]), sw(g0[1], u0[1])); w.y = cvt_pk_bf16(sw(g0[2], u0[2]), sw(g0[3], u0[3]));
                w.z = cvt_pk_bf16(sw(g1[0], u1[0]), sw(g1[1], u1[1])); w.w = cvt_pk_bf16(sw(g1[2], u1[2]), sw(g1[3], u1[3]));
                *(u32x4*)(O + (size_t)(row0 + ai * HALF + m * 16) * ldo + col0) = w; }
    }
};

template <class Epi, class Sched, bool ALIGN_EPI = false, bool SP2 = false>
__device__ __forceinline__ void gemm_phase(PG8_LAS unsigned char* lds, const Gemm g, const Sched& S, const Epi& E) {
    int tid_ = threadIdx.x; asm volatile("" : "+v"(tid_));
    const int tid = tid_, wid = __builtin_amdgcn_readfirstlane(tid >> 6), lane = tid & 63, wr = wid >> 2, wc = wid & 3, fr = lane & 15, fq = lane >> 4;
    const int K = g.K, nt = K / BK;
    unsigned voffA[2], voffB[2];
#pragma unroll
    for (int i = 0; i < 2; ++i) { int R, C; stage_rc(tid * 16 + i * 8192, R, C); const int Rb = Epi::PERM ? ((R & ~31) + perm32(R & 31)) : R;
        voffA[i] = (unsigned)(R * K + C) * 2u; voffB[i] = (unsigned)(Rb * K + C) * 2u; }
    const size_t kstep = (size_t)(BK * 2);
    const size_t hstep = (size_t)HALF * K * 2;
    const size_t tstep = 2 * hstep;
    const unsigned ldsw = (unsigned)wid * 1024u;
    const int aoff = lds_byte(wr * 64 + fr, fq * 8), boff = lds_byte(wc * 32 + fr, fq * 8);
#define PG8_SA(b, h) (((b) * 2 + (h)) * HTB)
#define PG8_SB(b, h) ((4 + (b) * 2 + (h)) * HTB)
#define PG8_STAGE(bufoff, gbase, voff) do { _Pragma("unroll") for (int _i = 0; _i < 2; ++_i) \
        __builtin_amdgcn_global_load_lds((const unsigned*)((const char*)(gbase) + (voff)[_i]), (PG8_LAS unsigned*)(lds + (bufoff) + ldsw + _i * 8192), 16, 0, 0); } while (0)
#define PG8_LDA(dst, b, h) do { _Pragma("unroll") for (int m = 0; m < 4; ++m) _Pragma("unroll") for (int k = 0; k < 2; ++k) dst[m][k] = *(const PG8_LAS bf16x8*)(lds + PG8_SA(b, h) + aoff + m * 2048 + k * 1024); } while (0)
#define PG8_LDB(dst, b, h) do { _Pragma("unroll") for (int n = 0; n < 2; ++n) _Pragma("unroll") for (int k = 0; k < 2; ++k) dst[n][k] = *(const PG8_LAS bf16x8*)(lds + PG8_SB(b, h) + boff + n * 2048 + k * 1024); } while (0)
#define PG8_MMA(ai, bj, At, Bt) do { __builtin_amdgcn_s_setprio(1); _Pragma("unroll") for (int m = 0; m < 4; ++m) _Pragma("unroll") for (int n = 0; n < 2; ++n) _Pragma("unroll") for (int k = 0; k < 2; ++k) \
        acc[ai][bj][m][n] = __builtin_amdgcn_mfma_f32_16x16x32_bf16(Bt[n][k], At[m][k], acc[ai][bj][m][n], 0, 0, 0); __builtin_amdgcn_s_setprio(0); } while (0)
#define PG8_WAIT_V(n) asm volatile("s_waitcnt vmcnt(" #n ")" ::: "memory")
#define PG8_WAIT_L(n) asm volatile("s_waitcnt lgkmcnt(" #n ")" ::: "memory")
#define PG8_BAR __builtin_amdgcn_s_barrier()
#define PG8_SCHED __builtin_amdgcn_sched_barrier(0)
    Unit cur, nxt; int ui = 0;
    if (!S.next(0, cur)) return;
    f32x4 acc[2][2][4][2];
#pragma unroll
    for (int a = 0; a < 2; ++a)
#pragma unroll
        for (int b = 0; b < 2; ++b)
#pragma unroll
            for (int m = 0; m < 4; ++m)
#pragma unroll
                for (int n = 0; n < 2; ++n) acc[a][b][m][n] = (f32x4){0.f, 0.f, 0.f, 0.f};
    bf16x8 At[4][2], B0[2][2], B1[2][2];
    const char* cA = (const char*)g.A + (size_t)cur.pm * tstep; const char* cB = (const char*)g.Bt + (size_t)cur.pn * tstep;
    S.a_ready(cur);
    if constexpr (SP2) {
        PG8_STAGE(PG8_SB(0, 0), cB, voffB); PG8_STAGE(PG8_SB(0, 1), cB + hstep, voffB); PG8_STAGE(PG8_SA(0, 0), cA, voffA); PG8_STAGE(PG8_SA(0, 1), cA + hstep, voffA);
        if (wr == 1) PG8_BAR;
        PG8_WAIT_V(2); PG8_BAR;
        PG8_STAGE(PG8_SB(1, 0), cB + kstep, voffB); PG8_STAGE(PG8_SA(1, 0), cA + kstep, voffA); PG8_STAGE(PG8_SB(1, 1), cB + hstep + kstep, voffB);
        PG8_WAIT_V(6); PG8_BAR;
    } else {
        PG8_STAGE(PG8_SB(0, 0), cB, voffB); PG8_STAGE(PG8_SA(0, 0), cA, voffA); PG8_STAGE(PG8_SB(0, 1), cB + hstep, voffB); PG8_STAGE(PG8_SA(0, 1), cA + hstep, voffA);
        if (wr == 1) PG8_BAR;
        PG8_WAIT_V(4); PG8_BAR;
        PG8_STAGE(PG8_SB(1, 0), cB + kstep, voffB); PG8_STAGE(PG8_SA(1, 0), cA + kstep, voffA); PG8_STAGE(PG8_SB(1, 1), cB + hstep + kstep, voffB);
        PG8_WAIT_V(6); PG8_BAR;
    }
    for (;;) {
        const bool has_next = S.next(ui + 1, nxt);
        const char* nA = has_next ? (const char*)g.A + (size_t)nxt.pm * tstep : cA; const char* nB = has_next ? (const char*)g.Bt + (size_t)nxt.pn * tstep : cB;
        for (int t = 0; t < nt; t += 2) {
            const bool last = (t == nt - 2);
            const char* a1 = cA + (size_t)(t + 1) * kstep;
            const char* a2 = last ? nA : cA + (size_t)(t + 2) * kstep; const char* b2 = last ? nB : cB + (size_t)(t + 2) * kstep;
            const char* a3 = a2 + kstep; const char* b3 = b2 + kstep;
            if (last && has_next) S.a_ready(nxt);
            if constexpr (SP2) {
            PG8_LDB(B0, 0, 0); PG8_LDB(B1, 0, 1); PG8_SCHED; PG8_LDA(At, 0, 0); PG8_STAGE(PG8_SA(1, 1), a1 + hstep, voffA);
            PG8_WAIT_V(8); PG8_WAIT_L(0); PG8_BAR; PG8_MMA(0, 0, At, B0); PG8_MMA(0, 1, At, B1); PG8_BAR; PG8_SCHED;
            PG8_LDA(At, 0, 1); PG8_STAGE(PG8_SB(0, 0), b2, voffB); PG8_STAGE(PG8_SB(0, 1), b2 + hstep, voffB); PG8_STAGE(PG8_SA(0, 0), a2, voffA);
            PG8_WAIT_V(8); PG8_WAIT_L(0); PG8_BAR; PG8_MMA(1, 0, At, B0); PG8_MMA(1, 1, At, B1); PG8_BAR; PG8_SCHED;
            PG8_LDB(B0, 1, 0); PG8_LDB(B1, 1, 1); PG8_SCHED; PG8_LDA(At, 1, 0); PG8_STAGE(PG8_SA(0, 1), a2 + hstep, voffA);
            PG8_WAIT_V(8); PG8_WAIT_L(0); PG8_BAR; PG8_MMA(0, 0, At, B0); PG8_MMA(0, 1, At, B1); PG8_BAR; PG8_SCHED;
            PG8_LDA(At, 1, 1); PG8_STAGE(PG8_SB(1, 0), b3, voffB); PG8_STAGE(PG8_SB(1, 1), b3 + hstep, voffB); PG8_STAGE(PG8_SA(1, 0), a3, voffA);
            PG8_WAIT_V(8); PG8_WAIT_L(0); PG8_BAR; PG8_MMA(1, 0, At, B0); PG8_MMA(1, 1, At, B1); PG8_BAR; PG8_SCHED;
            } else {
            PG8_LDB(B0, 0, 0); PG8_SCHED; PG8_LDA(At, 0, 0); PG8_STAGE(PG8_SA(1, 1), a1 + hstep, voffA);
            PG8_WAIT_L(8); PG8_BAR; PG8_WAIT_L(0); PG8_MMA(0, 0, At, B0); PG8_BAR; PG8_SCHED;
            PG8_LDB(B1, 0, 1); PG8_STAGE(PG8_SB(0, 0), b2, voffB);
            PG8_BAR; PG8_WAIT_L(0); PG8_MMA(0, 1, At, B1); PG8_BAR;
            PG8_LDA(At, 0, 1); PG8_STAGE(PG8_SA(0, 0), a2, voffA);
            PG8_BAR; PG8_WAIT_L(0); PG8_MMA(1, 0, At, B0); PG8_BAR; PG8_SCHED;
            PG8_STAGE(PG8_SB(0, 1), b2 + hstep, voffB);
            PG8_WAIT_V(6); PG8_BAR; PG8_MMA(1, 1, At, B1); PG8_BAR;
            PG8_LDB(B0, 1, 0); PG8_SCHED; PG8_LDA(At, 1, 0); PG8_STAGE(PG8_SA(0, 1), a2 + hstep, voffA);
            PG8_WAIT_L(8); PG8_BAR; PG8_WAIT_L(0); PG8_MMA(0, 0, At, B0); PG8_BAR; PG8_SCHED;
            PG8_LDB(B1, 1, 1); PG8_STAGE(PG8_SB(1, 0), b3, voffB);
            PG8_BAR; PG8_WAIT_L(0); PG8_MMA(0, 1, At, B1); PG8_BAR;
            PG8_LDA(At, 1, 1); PG8_STAGE(PG8_SA(1, 0), a3, voffA);
            PG8_BAR; PG8_WAIT_L(0); PG8_MMA(1, 0, At, B0); PG8_BAR; PG8_SCHED;
            PG8_STAGE(PG8_SB(1, 1), b3 + hstep, voffB);
            PG8_WAIT_V(6); PG8_BAR; PG8_MMA(1, 1, At, B1); PG8_BAR;
            }
        }
        if constexpr (ALIGN_EPI) { if (wr == 0) PG8_BAR; }
        if constexpr (!Epi::AFTER_DRAIN) { E(acc, cur, wr, wc, fr, fq); S.done(cur); }
        if (!has_next) break;
#pragma unroll
        for (int a = 0; a < 2; ++a)
#pragma unroll
            for (int b = 0; b < 2; ++b)
#pragma unroll
                for (int m = 0; m < 4; ++m)
#pragma unroll
                    for (int n = 0; n < 2; ++n) acc[a][b][m][n] = (f32x4){0.f, 0.f, 0.f, 0.f};
        cur = nxt; cA = nA; cB = nB; ++ui;
        if constexpr (ALIGN_EPI) { if (wr == 1) PG8_BAR; }
    }
    PG8_WAIT_V(0);
    if constexpr (!ALIGN_EPI) { if (wr == 0) PG8_BAR; }
    PG8_BAR;
    if constexpr (Epi::AFTER_DRAIN) { E.fused(acc, cur, wr, wc, fr, fq, lds, wid, lane); S.done(cur); }
#undef PG8_SA
#undef PG8_SB
#undef PG8_STAGE
#undef PG8_LDA
#undef PG8_LDB
#undef PG8_MMA
#undef PG8_WAIT_V
#undef PG8_WAIT_L
#undef PG8_BAR
#undef PG8_SCHED
}
}

namespace att {
#define ATT_LAS __attribute__((address_space(3)))
typedef unsigned short bf16_t;
using bf16x8 = __attribute__((ext_vector_type(8))) short;
using s16x4  = __attribute__((ext_vector_type(4))) short;
using f32x16 = __attribute__((ext_vector_type(16))) float;
using u32x4  = __attribute__((ext_vector_type(4))) unsigned;
using f32x4v = __attribute__((ext_vector_type(4))) float;
constexpr int NW = 8, QBLK = 32, KVBLK = 64, DV = 128, LDQ = 1024, SEQ = 4096;
constexpr int SHM_V = KVBLK * DV * 2;
constexpr int NRING = 4;
constexpr int LDS_V = 0, LDS_K = NRING * SHM_V, LDS_BYTES = LDS_K + NRING * 16384;
#define ATT_SBAR() __builtin_amdgcn_sched_barrier(0)
__device__ __forceinline__ int crow(int r, int hi) { return (r & 3) + 8 * (r >> 2) + 4 * hi; }
__device__ __forceinline__ unsigned cvtpk(float lo, float hi) { unsigned r; asm volatile("v_cvt_pk_bf16_f32 %0, %1, %2" : "=v"(r) : "v"(lo), "v"(hi)); return r; }
template <int DQK> __device__ __forceinline__ int kswz(int row, int colB) {
  if constexpr (DQK == 128) return row * 256 + (colB ^ ((row & 15) << 4));
  else return row * 128 + (colB ^ (((row >> 1) & 7) << 4));
}
constexpr float THRL = 11.5f;
__device__ __forceinline__ void check_tile(const bool force, f32x16& p0, f32x16& p1, float& m_ref, float& l_reg, f32x16& negm, f32x16 (&o)[4], ATT_LAS float* al_l, const int r32, const int hi) {
  float pmax = p0[0];
#pragma unroll
  for (int r = 1; r < 16; ++r) pmax = fmaxf(pmax, p0[r]);
#pragma unroll
  for (int r = 0; r < 16; ++r) pmax = fmaxf(pmax, p1[r]);
  { auto rr = __builtin_amdgcn_permlane32_swap(__float_as_uint(pmax), __float_as_uint(pmax), false, false);
    pmax = fmaxf(__uint_as_float(rr[0]), __uint_as_float(rr[1])); }
  if (force || __builtin_expect(__any(pmax > THRL), 0)) {
    const float dl = force ? pmax : fmaxf(pmax, 0.f);
    m_ref += dl;
#pragma unroll
    for (int r = 0; r < 16; ++r) { p0[r] -= dl; p1[r] -= dl; }
#pragma unroll
    for (int r = 0; r < 16; ++r) negm[r] = -m_ref;
    if (!force) {
      const float al = __builtin_amdgcn_exp2f(-dl); l_reg *= al;
      if (hi == 0) al_l[r32] = al; asm volatile("s_waitcnt lgkmcnt(0)" ::: "memory");
#pragma unroll
      for (int d = 0; d < 4; ++d)
#pragma unroll
        for (int r = 0; r < 16; ++r) o[d][r] *= al_l[crow(r, hi)];
    }
  }
}
template <bool PRB> __device__ __forceinline__ void sm_tile(f32x16& p0, f32x16& p1, float& l_reg, bf16x8& pa0, bf16x8& pa1, bf16x8& pa2, bf16x8& pa3) {
#pragma unroll
  for (int r = 0; r < 16; ++r) p0[r] = __builtin_amdgcn_exp2f(p0[r]);
#pragma unroll
  for (int r = 0; r < 16; ++r) p1[r] = __builtin_amdgcn_exp2f(p1[r]);
#ifdef PROBE_EXP
  if constexpr (PRB) { f32x16 t0 = p0; _Pragma("unroll") for (int i = 0; i < PROBE_EXP; ++i) { _Pragma("unroll") for (int r = 0; r < 16; ++r) t0[r] = __builtin_amdgcn_exp2f(t0[r]); } asm volatile("" :: "v"(t0)); }
#endif
  float ps = 0;
#pragma unroll
  for (int r = 0; r < 16; ++r) ps += p0[r];
#pragma unroll
  for (int r = 0; r < 16; ++r) ps += p1[r];
  { auto rr = __builtin_amdgcn_permlane32_swap(__float_as_uint(ps), __float_as_uint(ps), false, false);
    ps = __uint_as_float(rr[0]) + __uint_as_float(rr[1]); }
  l_reg += ps;
#define ATT_PK4(P, BASE, OUT) do { u32x4 w = {cvtpk(P[BASE + 0], P[BASE + 1]), cvtpk(P[BASE + 2], P[BASE + 3]), cvtpk(P[BASE + 4], P[BASE + 5]), cvtpk(P[BASE + 6], P[BASE + 7])}; OUT = __builtin_bit_cast(bf16x8, w); } while (0)
  ATT_PK4(p0, 0, pa0); ATT_PK4(p0, 8, pa1); ATT_PK4(p1, 0, pa2); ATT_PK4(p1, 8, pa3);
#undef ATT_PK4
}
template <int DQK> __device__ __forceinline__ void qkt(f32x16& p0, f32x16& p1, const ATT_LAS char* Ks, const bf16x8* qr, int r32, int hi) {
  p0 = f32x16{}; p1 = f32x16{};
#pragma unroll
  for (int d0 = 0; d0 < DQK / 16; ++d0) { const int cb = (d0 * 16 + hi * 8) * 2;
    const bf16x8 b0 = *reinterpret_cast<const ATT_LAS bf16x8*>(Ks + kswz<DQK>(r32, cb));
    const bf16x8 b1 = *reinterpret_cast<const ATT_LAS bf16x8*>(Ks + kswz<DQK>(32 + r32, cb));
    p0 = __builtin_amdgcn_mfma_f32_32x32x16_bf16(b0, qr[d0], p0, 0, 0, 0);
    p1 = __builtin_amdgcn_mfma_f32_32x32x16_bf16(b1, qr[d0], p1, 0, 0, 0); }
}
__device__ __forceinline__ int v_st(int k, int c) { const int kk = k; return ((kk >> 3) * 4 + (c >> 5)) * 512 + ((kk & 7) * 32 + (c & 31)) * 2; }
__device__ __forceinline__ int v_rd_base(int lane) { return ((lane & 3) << 3) | (((lane >> 2) & 3) << 6) | (((lane >> 4) & 1) << 5) | (((lane >> 5) & 1) << 8); }
constexpr int v_rd_off(int d0, int ks, int half) { return d0 * 512 + ks * 4096 + half * 2048; }
template <int OFF> __device__ __forceinline__ s16x4 tr_read(int vb) {
  s16x4 r; asm volatile("ds_read_b64_tr_b16 %0, %1 offset:%2" : "=&v"(r) : "v"(vb), "i"(OFF) : "memory"); return r;
}
template <int D0> __device__ __forceinline__ void pv_one(f32x16& od, int vb, bf16x8 pa0, bf16x8 pa1, bf16x8 pa2, bf16x8 pa3) {
  const s16x4 l0 = tr_read<v_rd_off(D0, 0, 0)>(vb), h0 = tr_read<v_rd_off(D0, 0, 1)>(vb), l1 = tr_read<v_rd_off(D0, 1, 0)>(vb), h1 = tr_read<v_rd_off(D0, 1, 1)>(vb);
  const s16x4 l2 = tr_read<v_rd_off(D0, 2, 0)>(vb), h2 = tr_read<v_rd_off(D0, 2, 1)>(vb), l3 = tr_read<v_rd_off(D0, 3, 0)>(vb), h3 = tr_read<v_rd_off(D0, 3, 1)>(vb);
  asm volatile("s_waitcnt lgkmcnt(0)" ::: "memory"); ATT_SBAR();
#define ATT_PK(L, H) (bf16x8){L[0], L[1], L[2], L[3], H[0], H[1], H[2], H[3]}
  od = __builtin_amdgcn_mfma_f32_32x32x16_bf16(pa0, ATT_PK(l0, h0), od, 0, 0, 0);
  od = __builtin_amdgcn_mfma_f32_32x32x16_bf16(pa1, ATT_PK(l1, h1), od, 0, 0, 0);
  od = __builtin_amdgcn_mfma_f32_32x32x16_bf16(pa2, ATT_PK(l2, h2), od, 0, 0, 0);
  od = __builtin_amdgcn_mfma_f32_32x32x16_bf16(pa3, ATT_PK(l3, h3), od, 0, 0, 0);
#undef ATT_PK
}
__device__ __forceinline__ void pv_d0(f32x16* o, int vb, bf16x8 pa0, bf16x8 pa1, bf16x8 pa2, bf16x8 pa3) {
  pv_one<0>(o[0], vb, pa0, pa1, pa2, pa3); pv_one<1>(o[1], vb, pa0, pa1, pa2, pa3); pv_one<2>(o[2], vb, pa0, pa1, pa2, pa3); pv_one<3>(o[3], vb, pa0, pa1, pa2, pa3);
}

template <int OFF> __device__ __forceinline__ bf16x8 rdk(int addr) {
  bf16x8 r; asm volatile("ds_read_b128 %0, %1 offset:%2" : "=v"(r) : "v"(addr), "i"(OFF) : "memory"); return r;
}
#ifndef ATT_MPRIO
#define ATT_MPRIO 2
#endif
#define ATT_MF(A, B, C) __builtin_amdgcn_mfma_f32_32x32x16_bf16(A, B, C, 0, 0, 0)
#define ATT_PKV(L, H) (bf16x8){L[0], L[1], L[2], L[3], H[0], H[1], H[2], H[3]}
#define ATT_WAITL(n) do { asm volatile("s_waitcnt lgkmcnt(" #n ")" ::: "memory"); ATT_SBAR(); } while (0)
template <int DQK, int KB, int VB, bool HASQ, bool HASV, class DT>
__device__ __forceinline__ void mblock(DT& dmy, f32x16& p0, f32x16& p1, const f32x16& negm, f32x16 (&o)[4], const bf16x8 (&qr)[DQK / 16], const int (&kaddr)[DQK / 16], const int vaddr,
                                       const bf16x8 pa0, const bf16x8 pa1, const bf16x8 pa2, const bf16x8 pa3) {
  constexpr int KH = 32 * 2 * DQK;
  bf16x8 kA0, kA1, kA2, kA3, kB0, kB1, kB2, kB3; s16x4 vA0, vA1, vA2, vA3, vA4, vA5, vA6, vA7, vB0, vB1, vB2, vB3, vB4, vB5, vB6, vB7;
#define ATT_IK(S, d) do { k##S##0 = rdk<KB>(kaddr[d]); k##S##1 = rdk<KB + KH>(kaddr[d]); k##S##2 = rdk<KB>(kaddr[d + 1]); k##S##3 = rdk<KB + KH>(kaddr[d + 1]); } while (0)
#define ATT_IV(S, b) do { v##S##0 = tr_read<VB + v_rd_off(b, 0, 0)>(vaddr); v##S##1 = tr_read<VB + v_rd_off(b, 0, 1)>(vaddr); v##S##2 = tr_read<VB + v_rd_off(b, 1, 0)>(vaddr); v##S##3 = tr_read<VB + v_rd_off(b, 1, 1)>(vaddr); \
    v##S##4 = tr_read<VB + v_rd_off(b, 2, 0)>(vaddr); v##S##5 = tr_read<VB + v_rd_off(b, 2, 1)>(vaddr); v##S##6 = tr_read<VB + v_rd_off(b, 3, 0)>(vaddr); v##S##7 = tr_read<VB + v_rd_off(b, 3, 1)>(vaddr); } while (0)
#define ATT_QK0(S, d) do { p0 = ATT_MF(k##S##0, qr[d], negm); p1 = ATT_MF(k##S##1, qr[d], negm); p0 = ATT_MF(k##S##2, qr[d + 1], p0); p1 = ATT_MF(k##S##3, qr[d + 1], p1); ATT_SBAR(); } while (0)
#define ATT_QK(S, d) do { p0 = ATT_MF(k##S##0, qr[d], p0); p1 = ATT_MF(k##S##1, qr[d], p1); p0 = ATT_MF(k##S##2, qr[d + 1], p0); p1 = ATT_MF(k##S##3, qr[d + 1], p1); ATT_SBAR(); } while (0)
#define ATT_PV(S, b) do { o[b] = ATT_MF(pa0, ATT_PKV(v##S##0, v##S##1), o[b]); o[b] = ATT_MF(pa1, ATT_PKV(v##S##2, v##S##3), o[b]); o[b] = ATT_MF(pa2, ATT_PKV(v##S##4, v##S##5), o[b]); o[b] = ATT_MF(pa3, ATT_PKV(v##S##6, v##S##7), o[b]); ATT_SBAR(); } while (0)
  ATT_SBAR(); __builtin_amdgcn_s_setprio(ATT_MPRIO);
  if constexpr (HASQ && HASV) {
    if constexpr (DQK == 128) {
      ATT_IK(A, 0); ATT_IK(B, 2);
      ATT_WAITL(4); ATT_QK0(A, 0); ATT_IK(A, 4);
      ATT_WAITL(4); ATT_QK(B, 2); ATT_IK(B, 6);
      ATT_WAITL(4); ATT_QK(A, 4); ATT_IV(A, 0);
      ATT_WAITL(8); ATT_QK(B, 6); ATT_IV(B, 1);
    } else {
      ATT_IK(A, 0); ATT_IK(B, 2);
      ATT_WAITL(4); ATT_QK0(A, 0); ATT_IV(A, 0);
      ATT_WAITL(8); ATT_QK(B, 2); ATT_IV(B, 1);
    }
    ATT_WAITL(8); ATT_PV(A, 0); ATT_IV(A, 2);
    ATT_WAITL(8); ATT_PV(B, 1); ATT_IV(B, 3);
    ATT_WAITL(8); ATT_PV(A, 2);
    ATT_WAITL(0); ATT_PV(B, 3);
#ifdef PROBE_MFMA
    if constexpr (sizeof(DT) > 4) { _Pragma("unroll") for (int i = 0; i < PROBE_MFMA; ++i) dmy = ATT_MF(pa0, pa1, dmy); ATT_SBAR(); }
#endif
  } else if constexpr (HASQ) {
    ATT_IK(A, 0); ATT_IK(B, 2);
    if constexpr (DQK == 128) {
      ATT_WAITL(4); ATT_QK0(A, 0); ATT_IK(A, 4);
      ATT_WAITL(4); ATT_QK(B, 2); ATT_IK(B, 6);
      ATT_WAITL(4); ATT_QK(A, 4);
      ATT_WAITL(0); ATT_QK(B, 6);
    } else {
      ATT_WAITL(4); ATT_QK0(A, 0);
      ATT_WAITL(0); ATT_QK(B, 2);
    }
  } else {
    ATT_IV(A, 0); ATT_IV(B, 1);
    ATT_WAITL(8); ATT_PV(A, 0); ATT_IV(A, 2);
    ATT_WAITL(8); ATT_PV(B, 1); ATT_IV(B, 3);
    ATT_WAITL(8); ATT_PV(A, 2);
    ATT_WAITL(0); ATT_PV(B, 3);
  }
  __builtin_amdgcn_s_setprio(0);
#undef ATT_IK
#undef ATT_IV
#undef ATT_QK0
#undef ATT_QK
#undef ATT_PV
}

__device__ __forceinline__ void dma16(const __amdgpu_buffer_rsrc_t srd, const unsigned voff, const unsigned soff, const unsigned m0v) {
  asm volatile("s_nop 4\n\ts_mov_b32 m0, %0\n\ts_nop 0\n\tbuffer_load_dwordx4 %1, %2, %3 offen lds" :: "s"(m0v), "v"(voff), "s"(srd), "s"(soff) : "m0", "memory");
}
#define ATT_VMW(n) asm volatile("s_waitcnt vmcnt(" #n ")" ::: "memory")
#define ATT_BAR() do { asm volatile("s_waitcnt lgkmcnt(0)\n\ts_barrier" ::: "memory"); ATT_SBAR(); } while (0)
template <int DQK, int LDKV>
__device__ __forceinline__ void attn_core(const bf16_t* Qb, const bf16_t* Kh, const bf16_t* Vh, ATT_LAS char* lds, ATT_LAS float* wsf, f32x16 (&o)[4]) {
  int tid_ = threadIdx.x; asm volatile("" : "+v"(tid_));
  const int tid = tid_, lane = tid & 63, r32 = lane & 31, hi = lane >> 5; const int wid = __builtin_amdgcn_readfirstlane(tid >> 6); const int grp = wid >> 2, w4 = wid & 3;
  ATT_LAS float* ws = wsf + wid * 64; ATT_LAS float* li_l = ws; ATT_LAS float* al_l = ws + 32;
  constexpr int SHM_K = 64 * DQK * 2, ROWB = LDKV * 2, NT = SEQ / KVBLK;
  const unsigned ldsV = (unsigned)(size_t)(lds + LDS_V), ldsK = (unsigned)(size_t)(lds + LDS_K);
  float m_ref = 0.f, l_reg = 0.f; f32x16 negm = f32x16{}; float dmy = 0.f;
#pragma unroll
  for (int d = 0; d < 4; ++d) o[d] = f32x16{};
  bf16x8 qr[DQK / 16]; int kaddr[DQK / 16];
  const bf16_t* Qw = Qb + (long)(wid * QBLK + r32) * LDQ + hi * 8;
#pragma unroll
  for (int d0 = 0; d0 < DQK / 16; ++d0) { qr[d0] = *reinterpret_cast<const bf16x8*>(Qw + d0 * 16); kaddr[d0] = (int)ldsK + kswz<DQK>(r32, (d0 * 16 + hi * 8) * 2); }
  const int vaddr = (int)ldsV + v_rd_base(lane);
  const __amdgpu_buffer_rsrc_t srd = __builtin_amdgcn_make_buffer_rsrc((void*)(grp == 0 ? Vh : Kh), (short)0, SEQ * ROWB, 0x00020000);
  unsigned voff;
  if (grp == 0) voff = (unsigned)((8 * (w4 >> 1) + ((lane & 31) >> 2)) * ROWB + 128 * (w4 & 1) + 64 * (lane >> 5) + 16 * (lane & 3));
  else if constexpr (DQK == 128) voff = (unsigned)((4 * w4 + (lane >> 4)) * ROWB + ((((lane & 15) ^ (lane >> 4)) ^ (4 * w4)) << 4));
  else voff = (unsigned)((8 * w4 + (lane >> 3)) * ROWB + ((((lane & 7) ^ (lane >> 4)) ^ (4 * (w4 & 1))) << 4));
#define ATT_DMAV(t) do { const unsigned sb_ = (unsigned)(t) * (KVBLK * ROWB), mb_ = ldsV + (unsigned)((t) & 3) * SHM_V + (unsigned)w4 * 1024u; \
    _Pragma("unroll") for (int q_ = 0; q_ < 4; ++q_) dma16(srd, voff, sb_ + q_ * 16 * ROWB, mb_ + q_ * 4096u); } while (0)
#define ATT_DMAK(t) do { const unsigned sb_ = (unsigned)(t) * (KVBLK * ROWB), mb_ = ldsK + (unsigned)((t) & 3) * SHM_K + (unsigned)w4 * 1024u; \
    if constexpr (DQK == 128) { _Pragma("unroll") for (int q_ = 0; q_ < 4; ++q_) dma16(srd, voff, sb_ + q_ * 16 * ROWB, mb_ + q_ * 4096u); } \
    else { _Pragma("unroll") for (int q_ = 0; q_ < 2; ++q_) dma16(srd, voff, sb_ + q_ * 32 * ROWB, mb_ + q_ * 4096u); } } while (0)
#define ATT_STGV(j) do { if ((j) + 1 < NT) ATT_VMW(4); else ATT_VMW(0); if ((j) + 2 < NT) ATT_DMAV((j) + 2); } while (0)
#define ATT_STGK(j) do { if ((j) + 2 < NT) { if constexpr (DQK == 128) ATT_VMW(4); else ATT_VMW(2); } else ATT_VMW(0); if ((j) + 3 < NT) ATT_DMAK((j) + 3); } while (0)
#define ATT_SBLK(t) do { ATT_SBAR(); if (((t) & 7) == 0) check_tile((t) == 0, p0, p1, m_ref, l_reg, negm, o, al_l, r32, hi); sm_tile<false>(p0, p1, l_reg, pa0, pa1, pa2, pa3); ATT_SBAR(); } while (0)
#define ATT_M(R, HQ, HV) mblock<DQK, (R) * SHM_K, (((R) + 3) & 3) * SHM_V, HQ, HV>(dmy, p0, p1, negm, o, qr, kaddr, vaddr, pa0, pa1, pa2, pa3)
  f32x16 p0, p1; bf16x8 pa0 = {}, pa1 = {}, pa2 = {}, pa3 = {};
  static_assert(NT % 4 == 0 && NT >= 8, "tile count: a multiple of 4");
  ATT_BAR();
  if (grp == 0) {
    ATT_DMAV(0); ATT_DMAV(1);
    ATT_BAR();
    ATT_M(0, true, false); ATT_BAR(); ATT_STGV(0); ATT_SBLK(0); ATT_BAR();
    ATT_M(1, true, true); ATT_BAR(); ATT_STGV(1); ATT_SBLK(1); ATT_BAR();
    ATT_M(2, true, true); ATT_BAR(); ATT_STGV(2); ATT_SBLK(2); ATT_BAR();
    ATT_M(3, true, true); ATT_BAR(); ATT_STGV(3); ATT_SBLK(3); ATT_BAR();
    for (int j = 4; j < NT; j += 4) {
      ATT_M(0, true, true); ATT_BAR(); ATT_STGV(j); ATT_SBLK(j); ATT_BAR();
      ATT_M(1, true, true); ATT_BAR(); ATT_STGV(j + 1); ATT_SBLK(j + 1); ATT_BAR();
      ATT_M(2, true, true); ATT_BAR(); ATT_STGV(j + 2); ATT_SBLK(j + 2); ATT_BAR();
      ATT_M(3, true, true); ATT_BAR(); ATT_STGV(j + 3); ATT_SBLK(j + 3); ATT_BAR();
    }
    ATT_M(0, false, true); ATT_BAR();
    ATT_BAR();
  } else {
    ATT_DMAK(0); ATT_DMAK(1); ATT_DMAK(2);
    if constexpr (DQK == 128) ATT_VMW(8); else ATT_VMW(4);
    ATT_BAR();
    ATT_STGK(0); ATT_BAR(); ATT_M(0, true, false); ATT_BAR();
    ATT_STGK(1); ATT_SBLK(0); ATT_BAR(); ATT_M(1, true, true); ATT_BAR();
    ATT_STGK(2); ATT_SBLK(1); ATT_BAR(); ATT_M(2, true, true); ATT_BAR();
    ATT_STGK(3); ATT_SBLK(2); ATT_BAR(); ATT_M(3, true, true); ATT_BAR();
    for (int j = 4; j < NT; j += 4) {
      ATT_STGK(j); ATT_SBLK(j - 1); ATT_BAR(); ATT_M(0, true, true); ATT_BAR();
      ATT_STGK(j + 1); ATT_SBLK(j); ATT_BAR(); ATT_M(1, true, true); ATT_BAR();
      ATT_STGK(j + 2); ATT_SBLK(j + 1); ATT_BAR(); ATT_M(2, true, true); ATT_BAR();
      ATT_STGK(j + 3); ATT_SBLK(j + 2); ATT_BAR(); ATT_M(3, true, true); ATT_BAR();
    }
    ATT_SBLK(NT - 1); ATT_BAR();
    ATT_M(0, false, true); ATT_BAR();
  }
  if (hi == 0) li_l[r32] = l_reg; asm volatile("s_waitcnt lgkmcnt(0)" ::: "memory");
#pragma unroll
  for (int r = 0; r < 16; ++r) { const float rl = __builtin_amdgcn_rcpf(li_l[crow(r, hi)]);
#pragma unroll
    for (int d = 0; d < 4; ++d) o[d][r] *= rl; }
#undef ATT_DMAV
#undef ATT_DMAK
#undef ATT_STGV
#undef ATT_STGK
#undef ATT_SBLK
#undef ATT_M
}
__device__ __forceinline__ void store_o(const f32x16 (&v)[4], bf16_t* Ob, ATT_LAS char* lds) {
  int tid_ = threadIdx.x; asm volatile("" : "+v"(tid_));
  const int tid = tid_, lane = tid & 63, r32 = lane & 31, hi = lane >> 5; const int wid = __builtin_amdgcn_readfirstlane(tid >> 6);
  ATT_LAS bf16_t* stg = (ATT_LAS bf16_t*)(lds + wid * 8192);
#pragma unroll
  for (int r = 0; r < 16; ++r) { const int orow = crow(r, hi);
#pragma unroll
    for (int d0 = 0; d0 < 4; ++d0) { const unsigned b = cvtpk(v[d0][r], 0.f); stg[orow * 128 + d0 * 32 + r32] = (bf16_t)(b & 0xffffu); } }
  asm volatile("s_waitcnt lgkmcnt(0)" ::: "memory");
#pragma unroll
  for (int i = 0; i < 8; ++i) { const int row = i * 4 + (lane >> 4), ch = lane & 15;
    const u32x4 w = *(const ATT_LAS u32x4*)(stg + row * 128 + ch * 8);
    *(u32x4*)(Ob + (long)(wid * QBLK + row) * 1024 + ch * 8) = w; }
}
}

constexpr int NWAVES = 8;
constexpr int BATCH = 4, SEQ = 4096, DM = 1024, M = BATCH * SEQ, DFF = 2816, MODW = 6 * DM;
constexpr float EPS = 1e-6f, LAM_INIT0 = 0.2f;
constexpr int NPHASE = 13;
#ifndef MK_N_LAUNCHES
#define MK_N_LAUNCHES 1
#endif
constexpr size_t MiB = 1u << 20;
constexpr size_t WS_CTL = 0, CTL_ZERO_BYTES = 64 * 1024;
constexpr size_t WS_BIAS = 256 * 1024;
constexpr size_t WS_STAT = 1 * MiB + 768 * 1024;
constexpr size_t WS_MOD = 1 * MiB;
constexpr size_t WS_CSA = 1 * MiB + 256 * 1024;
constexpr size_t WS_CSB = 1 * MiB + 512 * 1024;
constexpr size_t WS_GQK = WS_CSB + 16384;
constexpr size_t WS_WAQKV = 2 * MiB, WS_WAO = 8 * MiB, WS_WIN0 = 10 * MiB, WS_WOUT0 = 21 * MiB;
constexpr size_t WS_WBQKV = 26 * MiB + 512 * 1024, WS_WBO = 29 * MiB + 512 * 1024, WS_WIN1 = 31 * MiB + 512 * 1024, WS_WOUT1 = 42 * MiB + 512 * 1024;
constexpr size_t WS_H = 48 * MiB, WS_O = 80 * MiB, WS_Q = 112 * MiB, WS_K = 144 * MiB, WS_V = 176 * MiB, WS_END = 208 * MiB;
constexpr size_t WS_ACT = WS_Q;
static_assert(WS_ACT + (size_t)M * DFF * 2 <= WS_END, "act overlay");
constexpr int RING_BYTES = 131072;
constexpr int EPI_OFF = RING_BYTES;
constexpr int MISC_OFF = RING_BYTES + 8192;
constexpr int LDS_BYTES = 147456;
static_assert(MISC_OFF + 128 <= LDS_BYTES, "LDS map");

#define GAS __attribute__((address_space(1)))
#define LAS __attribute__((address_space(3)))
typedef unsigned short bf16;
typedef unsigned v4u __attribute__((ext_vector_type(4)));
typedef unsigned v2u __attribute__((ext_vector_type(2)));
typedef float f32x4 __attribute__((ext_vector_type(4)));
typedef GAS unsigned gu32;
#define RLX_AGENT __ATOMIC_RELAXED, __HIP_MEMORY_SCOPE_AGENT
#define LDS_WAIT() asm volatile("s_waitcnt lgkmcnt(0)" ::: "memory")
#define VM_WAIT() asm volatile("s_waitcnt vmcnt(0)" ::: "memory")
__device__ __forceinline__ unsigned f2bf(float f) { unsigned u = __builtin_bit_cast(unsigned, f); return (u + 0x7fffu + ((u >> 16) & 1u)) >> 16; }
__device__ __forceinline__ unsigned pk2(float lo, float hi) { return f2bf(lo) | (f2bf(hi) << 16); }

#define XB_TMO      128
#define XB_XCNT(j)  (256  + 64 * (j))
#define XB_XSUB(j)  (1280 + 64 * (j))
#define XB_XGEN(j)  (2304 + 64 * (j))
#define XB_TOP      3328
#define XB_TOPGEN   3392
#define XCD_BAR_WORDS 3456
#define XB_SPIN_CAP (1u << 18)

__device__ __forceinline__ unsigned xb_ld(unsigned* p)              { return __hip_atomic_load(p, __ATOMIC_RELAXED, __HIP_MEMORY_SCOPE_AGENT); }
__device__ __forceinline__ unsigned xb_add(unsigned* p, unsigned v) { return __hip_atomic_fetch_add(p, v, __ATOMIC_RELAXED, __HIP_MEMORY_SCOPE_AGENT); }
__device__ __forceinline__ unsigned xb_xcc_id() { return (unsigned)__builtin_amdgcn_s_getreg((3 << 11) | 20) & 0xFu; }
#define XB_SPIN(cond, bar) do { unsigned _sp = 0; while (cond) { __builtin_amdgcn_s_sleep(1); \
    if ((++_sp & 255u) == 0u) { if (xb_ld(&(bar)[XB_TMO])) break; if (_sp > XB_SPIN_CAP) { atomicAdd(&(bar)[XB_TMO], 1u); break; } } } } while (0)

struct XcdBarrier {
    unsigned* bar; unsigned x;
    volatile LAS unsigned* st;
};

__device__ __forceinline__ XcdBarrier xcd_barrier_post(unsigned* bar, volatile LAS unsigned* st) {
    XcdBarrier b; b.bar = bar; b.x = xb_xcc_id(); b.st = st;
    if (threadIdx.x == 0) (void)xb_add(&bar[XB_XCNT(b.x)], 1u);
    return b;
}
__device__ __forceinline__ void xcd_barrier_complete(unsigned* bar, unsigned x, unsigned& nloc, unsigned& nx) {
    const unsigned G = gridDim.x * gridDim.y * gridDim.z;
    unsigned sum, cnt, mine, sp = 0u;
    for (;;) {
        sum = 0u; cnt = 0u; mine = 0u;
#pragma unroll
        for (unsigned j = 0; j < 16; ++j) { const unsigned c = xb_ld(&bar[XB_XCNT(j)]); sum += c; cnt += (c > 0u) ? 1u : 0u; mine = (j == x) ? c : mine; }
        if (sum == G) break;
        __builtin_amdgcn_s_sleep(1);
        if ((++sp & 255u) == 0u) { if (xb_ld(&bar[XB_TMO])) break; if (sp > XB_SPIN_CAP) { atomicAdd(&bar[XB_TMO], 1u); break; } }
    }
    nloc = mine > 0u ? mine : 1u; nx = cnt > 0u ? cnt : 1u;
}

__device__ __forceinline__ void xcd_barrier(const XcdBarrier& b) {
    asm volatile("s_waitcnt vmcnt(0)" ::: "memory");
    __syncthreads();
    if (threadIdx.x == 0) {
        unsigned* bar = b.bar;
        __builtin_amdgcn_s_waitcnt(0);
        unsigned nloc = b.st[0], nx = b.st[1];
        if (nloc == 0u) { xcd_barrier_complete(bar, b.x, nloc, nx); b.st[0] = nloc; b.st[1] = nx; }
        const unsigned old = xb_add(&bar[XB_XSUB(b.x)], 1u);
        const unsigned gen = old / nloc;
        if (old + 1u == (gen + 1u) * nloc) {
            __builtin_amdgcn_fence(__ATOMIC_RELEASE, "agent");
            asm volatile("s_waitcnt vmcnt(0)" ::: "memory");
            const unsigned og = xb_add(&bar[XB_TOP], 1u);
            const unsigned tg = og / nx;
            if (og + 1u == (tg + 1u) * nx) xb_add(&bar[XB_TOPGEN], 1u);
            else XB_SPIN(xb_ld(&bar[XB_TOPGEN]) == tg, bar);
            __builtin_amdgcn_fence(__ATOMIC_ACQUIRE, "agent");
            xb_add(&bar[XB_XGEN(b.x)], 1u);
            asm volatile("s_waitcnt vmcnt(0)" ::: "memory");
        } else {
            XB_SPIN(xb_ld(&bar[XB_XGEN(b.x)]) == gen, bar);
            __builtin_amdgcn_fence(__ATOMIC_ACQUIRE, "agent");
            asm volatile("s_waitcnt vmcnt(0)" ::: "memory");
        }
    }
    __syncthreads();
}


struct Frame {
    LAS unsigned char* lds;
    volatile LAS unsigned* MISC;
    int tid, lane, wave, vcu, G;
};
__device__ __forceinline__ float wave_sum(float v) {
#pragma unroll
    for (int o = 1; o < 64; o <<= 1) v += __shfl_xor(v, o);
    return v;
}
__device__ const float FREQ_A[8] = {1.000000000e+00f, 1.939227432e-01f, 3.760603070e-02f, 7.292664610e-03f, 1.414213562e-03f, 2.742481884e-04f, 5.318296098e-05f, 1.031338616e-05f};
__device__ const float FREQ_B[32] = {1.000000000e+00f, 7.498942614e-01f, 5.623413324e-01f, 4.216965139e-01f, 3.162277639e-01f, 2.371373773e-01f, 1.778279394e-01f, 1.333521307e-01f, 1.000000015e-01f, 7.498941571e-02f, 5.623413250e-02f, 4.216965288e-02f, 3.162277490e-02f, 2.371373773e-02f, 1.778279431e-02f, 1.333521493e-02f, 9.999999776e-03f, 7.498941850e-03f, 5.623413250e-03f, 4.216964822e-03f, 3.162277630e-03f, 2.371373586e-03f, 1.778279431e-03f, 1.333521446e-03f, 1.000000047e-03f, 7.498942432e-04f, 5.623413017e-04f, 4.216965172e-04f, 3.162277571e-04f, 2.371373703e-04f, 1.778279402e-04f, 1.333521504e-04f};
__device__ __forceinline__ void sincos_acc(float a, float& c, float& s) {
    const double TWO_PI = 6.283185307179586476925286766559, x0 = (double)a;
    const double n = __builtin_rint(x0 * (1.0 / TWO_PI)), x = x0 - n * TWO_PI, x2 = x * x;
    double ts = 1.0, tc = 1.0;
#pragma unroll
    for (int k = 14; k >= 1; --k) { ts = 1.0 - x2 * ts * (1.0 / (double)((2 * k) * (2 * k + 1))); tc = 1.0 - x2 * tc * (1.0 / (double)((2 * k - 1) * (2 * k))); }
    s = (float)(x * ts); c = (float)tc;
}
__device__ __forceinline__ int colmap(int kind, int n) {
    if (kind == 1) { if (n >= 2048) return n; const int p = n & 63, d = p < 16 ? ((p & 1) ? (p >> 1) + 8 : (p >> 1)) : p; return (n & ~63) + d; }
    if (kind == 2) { if (n >= 1280) return n; const int p = n & 127, pr = p >> 1, first = pr < 32 ? pr : pr + 32; return (n & ~127) + ((p & 1) ? first + 32 : first); }
    if (kind == 3) { const int t = n >> 8, r = n & 255; return r < 128 ? t * 128 + r : DFF + t * 128 + (r - 128); }
    return n;
}
__device__ __forceinline__ void transpose_item(const float* W, int K, int N, bf16* WT, int kind, LAS float* scr, int item, int lane) {
    const int nblk = N / 32, kb = item / nblk, nb = item % nblk, k0 = 64 * kb, n0 = 32 * nb;
    const int src = colmap(kind, n0 + (lane & 31));
#pragma unroll 8
    for (int i = 0; i < 32; ++i) { const int kk = 2 * i + (lane >> 5); scr[kk * 33 + (lane & 31)] = W[(size_t)(k0 + kk) * N + src]; }
    LDS_WAIT(); asm volatile("" ::: "memory");
    const int c = lane & 7;
#pragma unroll
    for (int j = 0; j < 4; ++j) { const int n = (lane >> 3) + 8 * j; const LAS float* s = scr + (8 * c) * 33 + n;
        v4u o; o.x = pk2(s[0 * 33], s[1 * 33]); o.y = pk2(s[2 * 33], s[3 * 33]); o.z = pk2(s[4 * 33], s[5 * 33]); o.w = pk2(s[6 * 33], s[7 * 33]);
        *(GAS v4u*)(WT + (size_t)(n0 + n) * K + k0 + 8 * c) = o; }
    LDS_WAIT(); asm volatile("" ::: "memory");
}
struct Args { const float* in[20]; float* out; unsigned char* ws; int ph_lo, ph_hi; };

__device__ __forceinline__ void p0_prologue(Frame& F, const Args& a) {
    unsigned char* ws = a.ws;
    {
        LAS float* scr = (LAS float*)(F.lds + F.wave * 16384);
        const int gw = F.vcu * NWAVES + F.wave, NGW = F.G * NWAVES;
        constexpr int I0 = (DM / 64) * (3072 / 32), I1 = (DM / 64) * (DM / 32), I2 = (DM / 64) * (2 * DFF / 32), I3 = (DFF / 64) * (DM / 32), I4 = (DM / 64) * (1536 / 32);
        constexpr int NITEMS = I0 + I1 + I2 + I3 + I4 + I1 + I2 + I3;
        for (int it = gw; it < NITEMS; it += NGW) {
            int r = it;
            if (r < I0) { transpose_item(a.in[6], DM, 3072, (bf16*)(ws + WS_WAQKV), 1, scr, r, F.lane); continue; } r -= I0;
            if (r < I1) { transpose_item(a.in[7], DM, DM, (bf16*)(ws + WS_WAO), 0, scr, r, F.lane); continue; } r -= I1;
            if (r < I2) { transpose_item(a.in[17], DM, 2 * DFF, (bf16*)(ws + WS_WIN0), 3, scr, r, F.lane); continue; } r -= I2;
            if (r < I3) { transpose_item(a.in[18], DFF, DM, (bf16*)(ws + WS_WOUT0), 0, scr, r, F.lane); continue; } r -= I3;
            if (r < I4) { transpose_item(a.in[13], DM, 1536, (bf16*)(ws + WS_WBQKV), 2, scr, r, F.lane); continue; } r -= I4;
            if (r < I1) { transpose_item(a.in[14], DM, DM, (bf16*)(ws + WS_WBO), 0, scr, r, F.lane); continue; } r -= I1;
            if (r < I2) { transpose_item(a.in[17] + (size_t)DM * 2 * DFF, DM, 2 * DFF, (bf16*)(ws + WS_WIN1), 3, scr, r, F.lane); continue; } r -= I2;
            transpose_item(a.in[18] + (size_t)DFF * DM, DFF, DM, (bf16*)(ws + WS_WOUT1), 0, scr, r, F.lane);
        }
    }
    __syncthreads();
    {
        LAS float* cond = (LAS float*)F.lds;
        LAS float* part = (LAS float*)(F.lds + 16384);
        const float* c = a.in[1]; float* mod = (float*)(ws + WS_MOD);
        for (int i = F.tid; i < BATCH * DM; i += NWAVES * 64) { const float v = c[i]; cond[i] = v / (1.0f + __expf(-v)); }
        __syncthreads();
        for (int task = F.vcu; task < 2 * (MODW / 64); task += F.G) {
            const int L = task / (MODW / 64), n0 = (task % (MODW / 64)) * 64;
            const float* W = a.in[2] + (size_t)L * DM * MODW + n0 + F.lane;
            float acc0 = 0.f, acc1 = 0.f, acc2 = 0.f, acc3 = 0.f;
            const int kb = F.wave * 128;
#pragma unroll 8
            for (int k = 0; k < 128; ++k) { const float w = W[(size_t)(kb + k) * MODW];
                acc0 += cond[kb + k] * w; acc1 += cond[DM + kb + k] * w; acc2 += cond[2 * DM + kb + k] * w; acc3 += cond[3 * DM + kb + k] * w; }
            part[(F.wave * 4 + 0) * 64 + F.lane] = acc0; part[(F.wave * 4 + 1) * 64 + F.lane] = acc1; part[(F.wave * 4 + 2) * 64 + F.lane] = acc2; part[(F.wave * 4 + 3) * 64 + F.lane] = acc3;
            __syncthreads();
            if (F.tid < 256) { const int b = F.tid >> 6, l = F.tid & 63; float s = 0.f;
#pragma unroll
                for (int w = 0; w < 8; ++w) s += part[(w * 4 + b) * 64 + l];
                mod[((size_t)L * BATCH + b) * MODW + n0 + l] = s + a.in[3][(size_t)L * MODW + n0 + l]; }
            __syncthreads();
        }
    }
    {
        float* csa = (float*)(ws + WS_CSA); float* csb = (float*)(ws + WS_CSB);
        if (F.vcu == 0 && F.tid < 256) ((float*)(ws + WS_GQK))[F.tid] = F.tid < 128 ? a.in[15][F.tid] : a.in[16][F.tid - 128];
        for (int e = F.vcu * (NWAVES * 64) + F.tid; e < SEQ * 8 + 64 * 32; e += F.G * NWAVES * 64) {
            float cc, ss;
            if (e < SEQ * 8) { const int t = e >> 3, i = e & 7; sincos_acc((float)t * FREQ_A[i], cc, ss); csa[t * 16 + i] = cc; csa[t * 16 + 8 + i] = ss; }
            else { const int e2 = e - SEQ * 8, p = e2 >> 5, i = e2 & 31; sincos_acc((float)p * FREQ_B[i], cc, ss); csb[p * 64 + i] = cc; csb[p * 64 + 32 + i] = ss; }
        }
    }
}
__device__ __forceinline__ void bias_tasks(Frame& F, const Args& a) {
    unsigned char* ws = a.ws;
    LAS float* shl = (LAS float*)F.lds;
    LAS float* part = (LAS float*)(F.lds + 16384);
    const float* mod = (const float*)(ws + WS_MOD); float* bias = (float*)(ws + WS_BIAS);
    constexpr int T0 = 2 * DFF / 64, T1 = 1536 / 64;
    for (int task = F.vcu; task < 2 * T0 + T1; task += F.G) {
        const float* W; const float* sh; float* out; int N, kind, n0;
        if (task < T0) { W = a.in[17]; N = 2 * DFF; kind = 3; n0 = task * 64; sh = mod + 3 * DM; out = bias; }
        else if (task < T0 + T1) { W = a.in[13]; N = 1536; kind = 2; n0 = (task - T0) * 64; sh = mod + (size_t)BATCH * MODW; out = bias + 4 * 2 * DFF; }
        else { W = a.in[17] + (size_t)DM * 2 * DFF; N = 2 * DFF; kind = 3; n0 = (task - T0 - T1) * 64; sh = mod + (size_t)BATCH * MODW + 3 * DM; out = bias + 4 * 2 * DFF + 4 * 1536; }
        for (int i = F.tid; i < BATCH * DM; i += NWAVES * 64) shl[i] = sh[(size_t)(i >> 10) * MODW + (i & 1023)];
        __syncthreads();
        const float* Wc = W + colmap(kind, n0 + F.lane);
        float acc0 = 0.f, acc1 = 0.f, acc2 = 0.f, acc3 = 0.f;
        const int kb = F.wave * 128;
#pragma unroll 8
        for (int k = 0; k < 128; ++k) { const float w = Wc[(size_t)(kb + k) * N];
            acc0 += shl[kb + k] * w; acc1 += shl[DM + kb + k] * w; acc2 += shl[2 * DM + kb + k] * w; acc3 += shl[3 * DM + kb + k] * w; }
        part[(F.wave * 4 + 0) * 64 + F.lane] = acc0; part[(F.wave * 4 + 1) * 64 + F.lane] = acc1; part[(F.wave * 4 + 2) * 64 + F.lane] = acc2; part[(F.wave * 4 + 3) * 64 + F.lane] = acc3;
        __syncthreads();
        if (F.tid < 256) { const int b = F.tid >> 6, l = F.tid & 63; float s = 0.f;
#pragma unroll
            for (int w = 0; w < 8; ++w) s += part[(w * 4 + b) * 64 + l];
            out[(size_t)b * N + n0 + l] = s; }
        __syncthreads();
    }
}
__device__ __forceinline__ void norm_rows(Frame& F, const float* x, const float* g, const float* shift, const float* scale, bf16* h) {
    const int gw = F.vcu * NWAVES + F.wave, NGW = F.G * NWAVES;
    for (int m = gw; m < M; m += NGW) {
        const GAS f32x4* xr = (const GAS f32x4*)(x + (size_t)m * DM) + F.lane;
        f32x4 v[4]; float s = 0.f;
#pragma unroll
        for (int j = 0; j < 4; ++j) { v[j] = xr[64 * j]; s += (v[j].x * v[j].x + v[j].y * v[j].y) + (v[j].z * v[j].z + v[j].w * v[j].w); }
        const float rstd = 1.0f / sqrtf(wave_sum(s) * (1.f / DM) + EPS);
        const int b = m / SEQ; const float* sh = shift + (size_t)b * MODW; const float* sc = scale + (size_t)b * MODW;
        GAS v2u* o8 = (GAS v2u*)(h + (size_t)m * DM) + F.lane;
#pragma unroll
        for (int j = 0; j < 4; ++j) { const int col = 4 * F.lane + 256 * j;
            const f32x4 gg = *(const f32x4*)(g + col), s1 = *(const f32x4*)(sc + col), s0 = *(const f32x4*)(sh + col);
            const f32x4 y = ((v[j] * rstd) * gg) * (s1 + 1.0f) + s0;
            v2u w; w.x = pk2(y.x, y.y); w.y = pk2(y.z, y.w); o8[64 * j] = w; }
    }
}
__device__ __forceinline__ void final_norm(Frame& F, float* x, const float* g) {
    const int gw = F.vcu * NWAVES + F.wave, NGW = F.G * NWAVES;
    for (int m = gw; m < M; m += NGW) {
        GAS f32x4* xr = (GAS f32x4*)(x + (size_t)m * DM) + F.lane;
        f32x4 v[4]; float s = 0.f;
#pragma unroll
        for (int j = 0; j < 4; ++j) { v[j] = xr[64 * j]; s += (v[j].x * v[j].x + v[j].y * v[j].y) + (v[j].z * v[j].z + v[j].w * v[j].w); }
        const float rstd = 1.0f / sqrtf(wave_sum(s) * (1.f / DM) + EPS);
#pragma unroll
        for (int j = 0; j < 4; ++j) { const f32x4 gg = *(const f32x4*)(g + 4 * F.lane + 256 * j); xr[64 * j] = (v[j] * rstd) * gg; }
    }
}
__device__ __forceinline__ void attn_phase_A(unsigned long long& tacc, Frame& F, const bf16* Q, const bf16* K, const bf16* V, bf16* O, float* scr, const float* lq1, const float* lk1, const float* lq2, const float* lk2, const float* subg) {
    const float lam = __expf(wave_sum(lq1[F.lane] * lk1[F.lane])) - __expf(wave_sum(lq2[F.lane] * lk2[F.lane])) + LAM_INIT0;
    const int wid = F.wave;
    LAS char* lds = (LAS char*)F.lds;
    for (int uid = F.vcu; uid < 512; uid += F.G) {
        const int bh = (uid & 255) >> 3, qb = ((uid & 7) << 1) | (uid >> 8), b = bh >> 3, h = bh & 7;
        const size_t row0 = (size_t)b * SEQ + (size_t)qb * 256, krow0 = (size_t)b * SEQ;
#pragma unroll 1
        for (int c = 0; c < 2; ++c) {
            att::f32x16 o[4];
            att::attn_core<64, 1024>(Q + row0 * DM + h * 128 + c * 64, K + krow0 * DM + h * 128 + c * 64, V + krow0 * DM + h * 128, lds, (LAS float*)(F.lds + EPI_OFF), o);
            int ln = threadIdx.x & 63; asm volatile("" : "+v"(ln));
            att::f32x4v* sw = (att::f32x4v*)scr + ((size_t)(uid * 8 + wid) * 16) * 64 + ln;
            if (c == 0) {
#pragma unroll
                for (int r = 0; r < 16; ++r) sw[r * 64] = (att::f32x4v){o[0][r], o[1][r], o[2][r], o[3][r]};
            } else {
                float gs[4];
#pragma unroll
                for (int d0 = 0; d0 < 4; ++d0) gs[d0] = subg[d0 * 32 + (ln & 31)] * (1.0f - LAM_INIT0);
#pragma unroll
                for (int r = 0; r < 16; ++r) { const att::f32x4v o0 = sw[r * 64]; float ss = 0.f;
#pragma unroll
                    for (int d0 = 0; d0 < 4; ++d0) { const float v = o0[d0] - lam * o[d0][r]; o[d0][r] = v; ss += v * v; }
                    ss += __shfl_xor(ss, 1); ss += __shfl_xor(ss, 2); ss += __shfl_xor(ss, 4); ss += __shfl_xor(ss, 8); ss += __shfl_xor(ss, 16);
                    const float rs = 1.0f / sqrtf(ss * (1.0f / 128.0f) + EPS);
#pragma unroll
                    for (int d0 = 0; d0 < 4; ++d0) o[d0][r] *= rs * gs[d0];
                    if ((r & 3) == 3) asm volatile("" ::: "memory"); }
                __syncthreads();
                att::store_o(o, O + row0 * DM + h * 128, lds);
            }
        }
    }
}
__device__ __forceinline__ void attn_phase_B(unsigned long long& tacc, Frame& F, const bf16* Q, const bf16* K, const bf16* V, bf16* O) {
    LAS char* lds = (LAS char*)F.lds;
    for (int uid = F.vcu; uid < 512; uid += F.G) {
        const int grp = (uid & 255) >> 5, w = ((uid & 31) << 1) | (uid >> 8), b = grp >> 1, kvh = grp & 1, hq = kvh * 4 + (w >> 4), qb = w & 15;
        const size_t row0 = (size_t)b * SEQ + (size_t)qb * 256, krow0 = (size_t)b * SEQ;
        att::f32x16 o[4];
        att::attn_core<128, 256>(Q + row0 * DM + hq * 128, K + krow0 * 256 + kvh * 128, V + krow0 * 256 + kvh * 128, lds, (LAS float*)(F.lds + EPI_OFF), o);
        __syncthreads();
        att::store_o(o, O + row0 * DM + hq * 128, lds);
    }
}

#ifndef PHMASK
#define PHMASK 0xFFFF
#endif
#define KIND(b) (((PHMASK) >> (b)) & 1)
#ifndef REPMASK
#define REPMASK 0
#endif
#define REP(b) for (int rep_ = 0; rep_ < 1 + (((REPMASK) >> (b)) & 1); ++rep_)
constexpr bool USE_BAR = (MK_N_LAUNCHES != NPHASE);
#define IN(k) (lo <= (k) && (k) < hi)
#define SEAM(k) do { if (USE_BAR && IN((k) + 1)) xcd_barrier(bar); } while (0)
__device__ __forceinline__ void refresh(Frame& F) { int t = threadIdx.x; asm volatile("" : "+v"(t)); F.tid = t; F.lane = t & 63; F.wave = __builtin_amdgcn_readfirstlane(t >> 6); }

template <int L>
__device__ __forceinline__ void layer_phases(Frame& F, const Args& args, const int lo, const int hi, const XcdBarrier& bar) {
    constexpr int pb = (L == 0) ? 1 : 6;
    unsigned char* ws = args.ws;
    const float* x = args.in[0]; float* out = args.out;
    const float* modL = (const float*)(ws + WS_MOD) + (size_t)L * BATCH * MODW;
    const float* xin = (L == 0) ? x : (const float*)out;
    bf16 *H = (bf16*)(ws + WS_H), *O = (bf16*)(ws + WS_O), *Qb = (bf16*)(ws + WS_Q), *ACT = (bf16*)(ws + WS_ACT);
    float* stat = (float*)(ws + WS_STAT); const float* biasb = (const float*)(ws + WS_BIAS);
    LAS float* escr = (LAS float*)(F.lds + EPI_OFF);
    if constexpr (L == 0) { if (KIND(1) && IN(pb)) { refresh(F); REP(1) { bias_tasks(F, args); norm_rows(F, xin, args.in[4], modL, modL + DM, H); } SEAM(pb); } }
    if (IN(pb + 1)) {
        if constexpr (L == 0) { if (KIND(2)) REP(2) { pg8::Gemm g{H, (const bf16*)(ws + WS_WAQKV), M, 3072, DM}; pg8::StaticOrder S; S.init(M, 3072, F.G, (int)blockIdx.x);
            pg8::EpiQkvA E{Qb, (size_t)(WS_K - WS_Q) / 2, (const float*)(ws + WS_CSA)};
            pg8::gemm_phase<pg8::EpiQkvA, pg8::StaticOrder, true, true>(F.lds, g, S, E); } }
        else { if (KIND(3)) REP(3) { pg8::Gemm g{H, (const bf16*)(ws + WS_WBQKV), M, 1536, DM}; pg8::StaticOrder S; S.init(M, 1536, F.G, (int)blockIdx.x);
            pg8::EpiQkvB E{stat, biasb + 4 * 2 * DFF, Qb, (size_t)(WS_K - WS_Q) / 2, (const float*)(ws + WS_GQK), (const float*)(ws + WS_CSB), escr};
            pg8::gemm_phase<pg8::EpiQkvB, pg8::StaticOrder, true, true>(F.lds, g, S, E); } }
        SEAM(pb + 1);
    }
    if (IN(pb + 2)) {
        refresh(F); unsigned long long tacc = 0;
        bf16 *Kb = (bf16*)(ws + WS_K), *Vb = (bf16*)(ws + WS_V);
#ifdef PROBE_CLK
        unsigned long long t0_ = __builtin_amdgcn_s_memtime(), r0_ = __builtin_amdgcn_s_memrealtime();
#endif
        if constexpr (L == 0) { if (KIND(4)) REP(4) attn_phase_A(tacc, F, Qb, Kb, Vb, O, out, args.in[8], args.in[9], args.in[10], args.in[11], args.in[12]); }
        else { if (KIND(5)) REP(5) attn_phase_B(tacc, F, Qb, Kb, Vb, O); }
#ifdef PROBE_T
        if (L == PROBE_L && blockIdx.x == 0 && threadIdx.x == ((PROBE_T <= 4 || PROBE_T >= 9) ? 0 : 256)) ((float*)(ws + WS_GQK))[300] = (float)tacc * (1.0f / (2 * 31 * (L == 0 ? 2 : 1))) * 0.001f;
#endif
#ifdef PROBE_CLK
        if (L == PROBE_CLK && blockIdx.x == 0 && threadIdx.x == 0) { const unsigned long long t1_ = __builtin_amdgcn_s_memtime(), r1_ = __builtin_amdgcn_s_memrealtime(); ((float*)(ws + WS_GQK))[300] = (float)(t1_ - t0_) / (float)(r1_ - r0_) * 0.1f; ((float*)(ws + WS_GQK))[301] = (float)(r1_ - r0_) * 0.01f; }
#endif
        SEAM(pb + 2);
    }
    if (KIND(6) && IN(pb + 3)) { pg8::Gemm g{O, (const bf16*)(ws + (L == 0 ? WS_WAO : WS_WBO)), M, DM, DM}; pg8::StaticOrder S; S.init(M, DM, F.G, (int)blockIdx.x);
        pg8::EpiResid<true> E{xin, out, modL + 2 * DM, args.in[5] + L * DM, modL + 4 * DM, H, stat, escr};
        pg8::gemm_phase<pg8::EpiResid<true>, pg8::StaticOrder, true, true>(F.lds, g, S, E);
        SEAM(pb + 3); }
    if (KIND(8) && IN(pb + 4)) { pg8::Gemm g{H, (const bf16*)(ws + (L == 0 ? WS_WIN0 : WS_WIN1)), M, 2 * DFF, DM}; pg8::StaticOrder S; S.init(M, 2 * DFF, F.G, (int)blockIdx.x);
        pg8::EpiSwiglu E{ACT, DFF, stat, biasb + (L == 0 ? 0 : 4 * 2 * DFF + 4 * 1536)};
        REP(8) pg8::gemm_phase<pg8::EpiSwiglu, pg8::StaticOrder, true, true>(F.lds, g, S, E);
        SEAM(pb + 4); }
    if (KIND(9) && IN(pb + 5)) { pg8::Gemm g{ACT, (const bf16*)(ws + (L == 0 ? WS_WOUT0 : WS_WOUT1)), M, DM, DFF}; pg8::StaticOrder S; S.init(M, DM, F.G, (int)blockIdx.x);
        if constexpr (L == 0) { pg8::EpiResid<true> E{out, out, modL + 5 * DM, args.in[4] + DM, modL + (size_t)BATCH * MODW + DM, H, stat, escr};
            pg8::gemm_phase<pg8::EpiResid<true>, pg8::StaticOrder, true, true>(F.lds, g, S, E); }
        else { pg8::EpiResid<false> E{out, out, modL + 5 * DM, nullptr, nullptr, nullptr, nullptr, escr};
            pg8::gemm_phase<pg8::EpiResid<false>, pg8::StaticOrder, true, true>(F.lds, g, S, E); }
        SEAM(pb + 5); }
}

__global__ void __launch_bounds__(NWAVES * 64, 2) mk_fwd(Args args) {
    extern __shared__ __attribute__((aligned(16))) unsigned char lds[];
    Frame F;
    F.lds = (LAS unsigned char*)lds;
    F.MISC = (volatile LAS unsigned*)(F.lds + MISC_OFF);
    F.tid = threadIdx.x; F.lane = F.tid & 63; F.wave = __builtin_amdgcn_readfirstlane(F.tid >> 6);
    F.G = gridDim.x; { const int bx = blockIdx.x; F.vcu = (F.G % 8 == 0) ? (bx % 8) * (F.G / 8) + bx / 8 : bx; }
    if (F.tid < 32) F.MISC[F.tid] = 0u;
    __syncthreads();
    const int lo = args.ph_lo, hi = args.ph_hi;
    XcdBarrier bar; bar.bar = (unsigned*)(args.ws + WS_CTL); bar.x = 0; bar.st = nullptr;
    if (USE_BAR) bar = xcd_barrier_post((unsigned*)(args.ws + WS_CTL), F.MISC + 8);
    if (KIND(0) && IN(0)) { REP(0) { p0_prologue(F, args); __syncthreads(); } SEAM(0); }
    layer_phases<0>(F, args, lo, hi, bar);
    layer_phases<1>(F, args, lo, hi, bar);
    if (KIND(10) && IN(12)) { refresh(F); final_norm(F, args.out, args.in[19]);
#if defined(PROBE_CLK) || defined(PROBE_T)
        if (F.vcu == 0) { __syncthreads(); if (threadIdx.x == 0) { args.out[0] += 0.05f * ((const float*)(args.ws + WS_GQK))[300]; } }
#endif
    }
}
#undef IN
#undef SEAM

extern "C" void kernel_launch(void* const* d_in, const int* in_sizes, int n_in, void* d_out, int out_size, void* d_ws, size_t ws_size, hipStream_t stream) {
    static int grid = 0;
    if (grid == 0) {
        if (n_in != 20 || in_sizes[0] != M * DM || out_size != M * DM || ws_size < WS_END) { fprintf(stderr, "kernel_launch: unexpected shapes (n_in %d, in0 %d, out %d, ws %zu)\n", n_in, n_in > 0 ? in_sizes[0] : -1, out_size, ws_size); grid = -1; return; }
        int dev = 0, cus = 0, per_cu = 0;
        if (hipGetDevice(&dev) != hipSuccess || hipDeviceGetAttribute(&cus, hipDeviceAttributeMultiprocessorCount, dev) != hipSuccess) { grid = -1; return; }
        if (hipFuncSetAttribute((const void*)mk_fwd, hipFuncAttributeMaxDynamicSharedMemorySize, LDS_BYTES) != hipSuccess) { fprintf(stderr, "kernel_launch: hipFuncSetAttribute failed\n"); grid = -1; return; }
        if (hipOccupancyMaxActiveBlocksPerMultiprocessor(&per_cu, (const void*)mk_fwd, NWAVES * 64, LDS_BYTES) != hipSuccess || per_cu < 1) { fprintf(stderr, "kernel_launch: occupancy query says %d blocks per CU\n", per_cu); grid = -1; (void)hipGetLastError(); return; }
        grid = cus;
    }
    if (grid < 0) return;
    if (hipMemsetAsync((char*)d_ws + WS_CTL, 0, CTL_ZERO_BYTES, stream) != hipSuccess) return;
    Args a{};
    for (int i = 0; i < 20; ++i) a.in[i] = (const float*)d_in[i];
    a.out = (float*)d_out; a.ws = (unsigned char*)d_ws;
    constexpr int NL = MK_N_LAUNCHES;
    for (int li = 0; li < NL; ++li) {
        a.ph_lo = li * NPHASE / NL; a.ph_hi = (li + 1) * NPHASE / NL;
        hipLaunchKernelGGL(mk_fwd, dim3(grid), dim3(NWAVES * 64), LDS_BYTES, stream, a);
        const hipError_t le = hipPeekAtLastError();
        if (le != hipSuccess) { fprintf(stderr, "kernel_launch: launch %d failed: %s\n", li, hipGetErrorName(le)); break; }
    }
}
```

```cpp
#include <hip/hip_runtime.h>
#include <hip/hip_bf16.h>
#include <cstdio>
#include <cstdint>
#include <type_traits>
namespace pg8 {
#define PG8_LAS __attribute__((address_space(3)))
typedef unsigned short bf16_t;
typedef short bf16x8 __attribute__((ext_vector_type(8)));
typedef float f32x4 __attribute__((ext_vector_type(4)));
typedef unsigned u32x4 __attribute__((ext_vector_type(4)));
constexpr int BM = 256, BK = 64, HALF = 128, HTB = HALF * BK * 2  , STAGE_BYTES = 8 * HTB, NXCD = 8, WGM = 8;

__host__ __device__ __forceinline__ int lds_byte(int r, int c) { const int st = (r >> 4) * 2 + (c >> 5), rr = r & 15, cc = c & 31, ob = rr * 64 + cc * 2; return st * 1024 + (ob ^ (((ob >> 9) & 1) << 5)); }
__host__ __device__ __forceinline__ void stage_rc(int b, int& R, int& C) { const int st = b / 1024, sb = b % 1024, swz = sb ^ (((sb >> 9) & 1) << 5); R = (st >> 1) * 16 + swz / 64; C = (st & 1) * 32 + (swz % 64) / 2; }
__host__ __device__ __forceinline__ int perm32(int rho) { const int n = rho >> 4, i = rho & 15; return 8 * (i >> 2) + 4 * n + (i & 3); }

struct Unit { int pm, pn; };
struct Gemm { const bf16_t* A; const bf16_t* Bt; int M, N, K; };

struct StaticOrder {
    int nM, nN, nwg, G, c;
    __host__ __device__ void init(int M, int N, int G_, int c_) { nM = M / BM; nN = N / BM; nwg = nM * nN; G = G_; c = c_; }
    __host__ __device__ bool next(int i, Unit& u) const {
        const long L = (long)i * G + c; if (L >= nwg) return false;
        int wgid = (int)L; { const int q = nwg / NXCD, r = nwg % NXCD, xcd = wgid % NXCD, off = wgid / NXCD; wgid = (xcd < r ? xcd * (q + 1) : r * (q + 1) + (xcd - r) * q) + off; }
        const int nig = WGM * nN, gid = wgid / nig, fm = gid * WGM, gsz = (nM - fm) < WGM ? (nM - fm) : WGM;
        u.pm = fm + ((wgid % nig) % gsz); u.pn = (wgid % nig) / gsz; return true;
    }
    __device__ __forceinline__ void a_ready(const Unit&) const {}
    __device__ __forceinline__ void done(const Unit&) const {}
};


__device__ __forceinline__ unsigned cvt_pk_bf16(float lo, float hi) { unsigned r; asm volatile("v_cvt_pk_bf16_f32 %0, %1, %2" : "=v"(r) : "v"(lo), "v"(hi)); return r; }
constexpr int SEQ_ = 4096, DM_ = 1024, MODW_ = 6144;
constexpr float EPS_ = 1e-6f, QSCALE_A = 0.125f * 1.4426950408889634f, QSCALE_B = 0.08838834764831845f * 1.4426950408889634f;
typedef unsigned u32x2 __attribute__((ext_vector_type(2)));

__device__ __forceinline__ void rot4(f32x4& v0, f32x4& v1, const f32x4 c, const f32x4 s) {
    f32x4 r0, r1;
    r0[0] = v0[0] * c[0] - v0[1] * s[0]; r0[1] = v0[1] * c[0] + v0[0] * s[0]; r0[2] = v0[2] * c[1] - v0[3] * s[1]; r0[3] = v0[3] * c[1] + v0[2] * s[1];
    r1[0] = v1[0] * c[2] - v1[1] * s[2]; r1[1] = v1[1] * c[2] + v1[0] * s[2]; r1[2] = v1[2] * c[3] - v1[3] * s[3]; r1[3] = v1[3] * c[3] + v1[2] * s[3];
    v0 = r0; v1 = r1;
}

struct EpiQkvA {
    static constexpr bool PERM = true, AFTER_DRAIN = false;
    bf16_t* Q; size_t tstride; const float* cs;
    __device__ __forceinline__ void operator()(const f32x4 (&acc)[2][2][4][2], const Unit& u, int wr, int wc, int fr, int fq) const {
        const int t3 = u.pn >> 2; bf16_t* base = Q + (size_t)t3 * tstride;
        const int col0 = (u.pn & 3) * BM + wc * 32 + 8 * fq, row0 = u.pm * BM + wr * 64 + fr;
        const bool rope = (t3 < 2) && ((wc & 1) == 0) && (fq < 2);
#pragma unroll
        for (int ai = 0; ai < 2; ++ai)
#pragma unroll
            for (int m = 0; m < 4; ++m) { const int row = row0 + ai * HALF + m * 16, t = row & (SEQ_ - 1);
                f32x4 cv = (f32x4){1.f, 1.f, 1.f, 1.f}, sv = (f32x4){0.f, 0.f, 0.f, 0.f};
                if (rope) { cv = *(const f32x4*)(cs + t * 16 + 4 * fq); sv = *(const f32x4*)(cs + t * 16 + 8 + 4 * fq); }
                bf16_t* rowp = base + (size_t)row * DM_ + col0;
#pragma unroll
                for (int bj = 0; bj < 2; ++bj) { f32x4 v0 = acc[ai][bj][m][0], v1 = acc[ai][bj][m][1];
                    rot4(v0, v1, cv, sv);
                    if (t3 == 0) { v0 = v0 * QSCALE_A; v1 = v1 * QSCALE_A; }
                    u32x4 w; w.x = cvt_pk_bf16(v0[0], v0[1]); w.y = cvt_pk_bf16(v0[2], v0[3]); w.z = cvt_pk_bf16(v1[0], v1[1]); w.w = cvt_pk_bf16(v1[2], v1[3]);
                    *(u32x4*)(rowp + bj * HALF) = w; } }
    }
};

struct EpiQkvB {
    static constexpr bool PERM = true, AFTER_DRAIN = false;
    const float* stat; const float* bias;
    bf16_t* Q; size_t tstride; const float* gtab; const float* cs2;
    PG8_LAS float* scr;
    __device__ __forceinline__ void operator()(f32x4 (&acc)[2][2][4][2], const Unit& u, int wr, int wc, int fr, int fq) const {
        const int pn = u.pn; const bool nrm = pn < 5;
        bf16_t* base = Q + (size_t)(pn < 4 ? 0 : pn - 3) * tstride; const int ld = pn < 4 ? DM_ : 256; const float* g = gtab + (pn < 4 ? 0 : 128);
        const int col0 = (pn < 4 ? pn * BM : 0) + wc * 32 + 8 * fq, row0 = u.pm * BM + wr * 64 + fr;
        {
            const float* bp = bias + ((u.pm * BM) / SEQ_) * 1536 + pn * BM + wc * 32 + 8 * fq;
            f32x4 bv[2][2];
#pragma unroll
            for (int bj = 0; bj < 2; ++bj) { bv[bj][0] = *(const f32x4*)(bp + bj * HALF); bv[bj][1] = *(const f32x4*)(bp + bj * HALF + 4); }
#pragma unroll
            for (int ai = 0; ai < 2; ++ai)
#pragma unroll
                for (int m = 0; m < 4; ++m) { const f32x4 st = *(const f32x4*)(stat + (size_t)(row0 + ai * HALF + m * 16) * 4);
                    const float rr = __builtin_amdgcn_rsqf(((st[0] + st[1]) + (st[2] + st[3])) * (1.0f / DM_) + EPS_);
#pragma unroll
                    for (int bj = 0; bj < 2; ++bj) { acc[ai][bj][m][0] = acc[ai][bj][m][0] * rr + bv[bj][0]; acc[ai][bj][m][1] = acc[ai][bj][m][1] * rr + bv[bj][1]; } }
        }
        if (nrm) {
#pragma unroll
            for (int ai = 0; ai < 2; ++ai)
#pragma unroll
                for (int m = 0; m < 4; ++m)
#pragma unroll
                    for (int bj = 0; bj < 2; ++bj) { const f32x4 a = acc[ai][bj][m][0], b = acc[ai][bj][m][1];
                        float ss = (a[0] * a[0] + a[1] * a[1]) + (a[2] * a[2] + a[3] * a[3]) + (b[0] * b[0] + b[1] * b[1]) + (b[2] * b[2] + b[3] * b[3]);
                        ss += __shfl_xor(ss, 16); ss += __shfl_xor(ss, 32);
                        if (fq == 0) scr[((ai * HALF + wr * 64 + m * 16 + fr) * 2 + bj) * 4 + wc] = ss; }
            asm volatile("s_waitcnt lgkmcnt(0)" ::: "memory"); __builtin_amdgcn_s_barrier(); asm volatile("" ::: "memory");
        }
        const int f0 = 16 * (wc & 1) + 4 * fq, d1 = (wc < 2 ? 16 * wc : 16 * wc + 32) + 4 * fq;
        f32x4 g1 = (f32x4){1.f, 1.f, 1.f, 1.f}, g2 = g1;
        if (nrm) { g1 = *(const f32x4*)(g + d1); g2 = *(const f32x4*)(g + d1 + 32); }
#pragma unroll
        for (int ai = 0; ai < 2; ++ai)
#pragma unroll
            for (int m = 0; m < 4; ++m) { const int row = row0 + ai * HALF + m * 16, t = row & (SEQ_ - 1), pos = wc < 2 ? (t >> 6) : (t & 63);
                f32x4 cv = (f32x4){1.f, 1.f, 1.f, 1.f}, sv = (f32x4){0.f, 0.f, 0.f, 0.f};
                if (nrm) { cv = *(const f32x4*)(cs2 + pos * 64 + f0); sv = *(const f32x4*)(cs2 + pos * 64 + 32 + f0); }
                bf16_t* rowp = base + (size_t)row * ld + col0;
#pragma unroll
                for (int bj = 0; bj < 2; ++bj) { f32x4 v0 = acc[ai][bj][m][0], v1 = acc[ai][bj][m][1];
                    if (nrm) { const f32x4 p = *(const PG8_LAS f32x4*)(scr + ((ai * HALF + wr * 64 + m * 16 + fr) * 2 + bj) * 4);
                        const float rs = __builtin_amdgcn_rsqf(((p[0] + p[1]) + (p[2] + p[3])) * (1.0f / 128.0f) + EPS_) * (pn < 4 ? QSCALE_B : 1.0f);
                        v0[0] *= rs * g1[0]; v0[1] *= rs * g2[0]; v0[2] *= rs * g1[1]; v0[3] *= rs * g2[1]; v1[0] *= rs * g1[2]; v1[1] *= rs * g2[2]; v1[2] *= rs * g1[3]; v1[3] *= rs * g2[3];
                        rot4(v0, v1, cv, sv); }
                    u32x4 w; w.x = cvt_pk_bf16(v0[0], v0[1]); w.y = cvt_pk_bf16(v0[2], v0[3]); w.z = cvt_pk_bf16(v1[0], v1[1]); w.w = cvt_pk_bf16(v1[2], v1[3]);
                    *(u32x4*)(rowp + bj * HALF) = w; } }
    }
};

template <bool EMIT> struct EpiResid {
    static constexpr bool PERM = false, AFTER_DRAIN = false;
    const float* base; float* out; const float* gate;
    const float* g; const float* scale; bf16_t* xm; float* stat; PG8_LAS float* scr;
    __device__ __forceinline__ void operator()(const f32x4 (&acc)[2][2][4][2], const Unit& u, int wr, int wc, int fr, int fq) const {
        const int col0 = u.pn * BM + wc * 32 + 4 * fq, row0 = u.pm * BM + wr * 64 + fr, b = (u.pm * BM) / SEQ_;
        f32x4 gv[2][2], mv[2][2];
#pragma unroll
        for (int bj = 0; bj < 2; ++bj)
#pragma unroll
            for (int n = 0; n < 2; ++n) { gv[bj][n] = *(const f32x4*)(gate + b * MODW_ + col0 + bj * HALF + n * 16);
                if (EMIT) mv[bj][n] = *(const f32x4*)(g + col0 + bj * HALF + n * 16) * (*(const f32x4*)(scale + b * MODW_ + col0 + bj * HALF + n * 16) + 1.0f); }
#pragma unroll
        for (int ai = 0; ai < 2; ++ai)
#pragma unroll
            for (int m = 0; m < 4; ++m) { const size_t off = (size_t)(row0 + ai * HALF + m * 16) * DM_ + col0; float ss = 0.f;
#pragma unroll
                for (int bj = 0; bj < 2; ++bj)
#pragma unroll
                    for (int n = 0; n < 2; ++n) { const f32x4 bs = *(const f32x4*)(base + off + bj * HALF + n * 16); const f32x4 o = bs + gv[bj][n] * acc[ai][bj][m][n];
                        *(f32x4*)(out + off + bj * HALF + n * 16) = o;
                        if (EMIT) { ss += (o[0] * o[0] + o[1] * o[1]) + (o[2] * o[2] + o[3] * o[3]); const f32x4 a = o * mv[bj][n];
                            u32x2 w; w.x = cvt_pk_bf16(a[0], a[1]); w.y = cvt_pk_bf16(a[2], a[3]); *(u32x2*)(xm + off + bj * HALF + n * 16) = w; } }
                if (EMIT) { ss += __shfl_xor(ss, 16); ss += __shfl_xor(ss, 32); if (fq == 0) scr[(ai * HALF + wr * 64 + m * 16 + fr) * 4 + wc] = ss; }
                if (m & 1) asm volatile("" ::: "memory"); }
        if (EMIT) {
            asm volatile("s_waitcnt lgkmcnt(0)" ::: "memory"); __builtin_amdgcn_s_barrier(); asm volatile("" ::: "memory");
            const int t = (wr * 4 + wc) * 64 + (fq * 16 + fr);
            if (t < BM) { const f32x4 p = *(const PG8_LAS f32x4*)(scr + t * 4); stat[(size_t)(u.pm * BM + t) * 4 + u.pn] = (p[0] + p[1]) + (p[2] + p[3]); }
        }
    }
};

struct EpiSwiglu {
    static constexpr bool PERM = true, AFTER_DRAIN = false;
    bf16_t* O; int ldo; const float* stat; const float* bias;
    __device__ __forceinline__ static float sw(float g, float up) { return g * __builtin_amdgcn_rcpf(1.0f + __builtin_amdgcn_exp2f(g * -1.4426950408889634f)) * up; }
    __device__ __forceinline__ void operator()(const f32x4 (&acc)[2][2][4][2], const Unit& u, int wr, int wc, int fr, int fq) const {
        const int col0 = u.pn * HALF + wc * 32 + 8 * fq, row0 = u.pm * BM + wr * 64 + fr;
        const float* bp = bias + ((u.pm * BM) / SEQ_) * (2 * ldo) + u.pn * BM + wc * 32 + 8 * fq;
        const f32x4 bg0 = *(const f32x4*)(bp), bg1 = *(const f32x4*)(bp + 4), bu0 = *(const f32x4*)(bp + HALF), bu1 = *(const f32x4*)(bp + HALF + 4);
#pragma unroll
        for (int ai = 0; ai < 2; ++ai)
#pragma unroll
            for (int m = 0; m < 4; ++m) { const f32x4 st = *(const f32x4*)(stat + (size_t)(row0 + ai * HALF + m * 16) * 4);
                const float rr = __builtin_amdgcn_rsqf(((st[0] + st[1]) + (st[2] + st[3])) * (1.0f / DM_) + EPS_);
                const f32x4 g0 = acc[ai][0][m][0] * rr + bg0, g1 = acc[ai][0][m][1] * rr + bg1, u0 = acc[ai][1][m][0] * rr + bu0, u1 = acc[ai][1][m][1] * rr + bu1;
                u32x4 w; w.x = cvt_pk_bf16(sw(g0[0], u0[0]), sw(g0[1], u0[1])); w.y = cvt_pk_bf16(sw(g0[2], u0[2]), sw(g0[3], u0[3]));
                w.z = cvt_pk_bf16(sw(g1[0], u1[0]), sw(g1[1], u1[1])); w.w = cvt_pk_bf16(sw(g1[2], u1[2]), sw(g1[3], u1[3]));
                *(u32x4*)(O + (size_t)(row0 + ai * HALF + m * 16) * ldo + col0) = w; }
    }
};

template <class Epi, class Sched, bool ALIGN_EPI = false, bool SP2 = false>
__device__ __forceinline__ void gemm_phase(PG8_LAS unsigned char* lds, const Gemm g, const Sched& S, const Epi& E) {
    int tid_ = threadIdx.x; asm volatile("" : "+v"(tid_));
    const int tid = tid_, wid = __builtin_amdgcn_readfirstlane(tid >> 6), lane = tid & 63, wr = wid >> 2, wc = wid & 3, fr = lane & 15, fq = lane >> 4;
    const int K = g.K, nt = K / BK;
    unsigned voffA[2], voffB[2];
#pragma unroll
    for (int i = 0; i < 2; ++i) { int R, C; stage_rc(tid * 16 + i * 8192, R, C); const int Rb = Epi::PERM ? ((R & ~31) + perm32(R & 31)) : R;
        voffA[i] = (unsigned)(R * K + C) * 2u; voffB[i] = (unsigned)(Rb * K + C) * 2u; }
    const size_t kstep = (size_t)(BK * 2);
    const size_t hstep = (size_t)HALF * K * 2;
    const size_t tstep = 2 * hstep;
    const unsigned ldsw = (unsigned)wid * 1024u;
    const int aoff = lds_byte(wr * 64 + fr, fq * 8), boff = lds_byte(wc * 32 + fr, fq * 8);
#define PG8_SA(b, h) (((b) * 2 + (h)) * HTB)
#define PG8_SB(b, h) ((4 + (b) * 2 + (h)) * HTB)
#define PG8_STAGE(bufoff, gbase, voff) do { _Pragma("unroll") for (int _i = 0; _i < 2; ++_i) \
        __builtin_amdgcn_global_load_lds((const unsigned*)((const char*)(gbase) + (voff)[_i]), (PG8_LAS unsigned*)(lds + (bufoff) + ldsw + _i * 8192), 16, 0, 0); } while (0)
#define PG8_LDA(dst, b, h) do { _Pragma("unroll") for (int m = 0; m < 4; ++m) _Pragma("unroll") for (int k = 0; k < 2; ++k) dst[m][k] = *(const PG8_LAS bf16x8*)(lds + PG8_SA(b, h) + aoff + m * 2048 + k * 1024); } while (0)
#define PG8_LDB(dst, b, h) do { _Pragma("unroll") for (int n = 0; n < 2; ++n) _Pragma("unroll") for (int k = 0; k < 2; ++k) dst[n][k] = *(const PG8_LAS bf16x8*)(lds + PG8_SB(b, h) + boff + n * 2048 + k * 1024); } while (0)
#define PG8_MMA(ai, bj, At, Bt) do { __builtin_amdgcn_s_setprio(1); _Pragma("unroll") for (int m = 0; m < 4; ++m) _Pragma("unroll") for (int n = 0; n < 2; ++n) _Pragma("unroll") for (int k = 0; k < 2; ++k) \
        acc[ai][bj][m][n] = __builtin_amdgcn_mfma_f32_16x16x32_bf16(Bt[n][k], At[m][k], acc[ai][bj][m][n], 0, 0, 0); __builtin_amdgcn_s_setprio(0); } while (0)
#define PG8_WAIT_V(n) asm volatile("s_waitcnt vmcnt(" #n ")" ::: "memory")
#define PG8_WAIT_L(n) asm volatile("s_waitcnt lgkmcnt(" #n ")" ::: "memory")
#define PG8_BAR __builtin_amdgcn_s_barrier()
#define PG8_SCHED __builtin_amdgcn_sched_barrier(0)
    Unit cur, nxt; int ui = 0;
    if (!S.next(0, cur)) return;
    f32x4 acc[2][2][4][2];
#pragma unroll
    for (int a = 0; a < 2; ++a)
#pragma unroll
        for (int b = 0; b < 2; ++b)
#pragma unroll
            for (int m = 0; m < 4; ++m)
#pragma unroll
                for (int n = 0; n < 2; ++n) acc[a][b][m][n] = (f32x4){0.f, 0.f, 0.f, 0.f};
    bf16x8 At[4][2], B0[2][2], B1[2][2];
    const char* cA = (const char*)g.A + (size_t)cur.pm * tstep; const char* cB = (const char*)g.Bt + (size_t)cur.pn * tstep;
    S.a_ready(cur);
    if constexpr (SP2) {
        PG8_STAGE(PG8_SB(0, 0), cB, voffB); PG8_STAGE(PG8_SB(0, 1), cB + hstep, voffB); PG8_STAGE(PG8_SA(0, 0), cA, voffA); PG8_STAGE(PG8_SA(0, 1), cA + hstep, voffA);
        if (wr == 1) PG8_BAR;
        PG8_WAIT_V(2); PG8_BAR;
        PG8_STAGE(PG8_SB(1, 0), cB + kstep, voffB); PG8_STAGE(PG8_SA(1, 0), cA + kstep, voffA); PG8_STAGE(PG8_SB(1, 1), cB + hstep + kstep, voffB);
        PG8_WAIT_V(6); PG8_BAR;
    } else {
        PG8_STAGE(PG8_SB(0, 0), cB, voffB); PG8_STAGE(PG8_SA(0, 0), cA, voffA); PG8_STAGE(PG8_SB(0, 1), cB + hstep, voffB); PG8_STAGE(PG8_SA(0, 1), cA + hstep, voffA);
        if (wr == 1) PG8_BAR;
        PG8_WAIT_V(4); PG8_BAR;
        PG8_STAGE(PG8_SB(1, 0), cB + kstep, voffB); PG8_STAGE(PG8_SA(1, 0), cA + kstep, voffA); PG8_STAGE(PG8_SB(1, 1), cB + hstep + kstep, voffB);
        PG8_WAIT_V(6); PG8_BAR;
    }
    for (;;) {
        const bool has_next = S.next(ui + 1, nxt);
        const char* nA = has_next ? (const char*)g.A + (size_t)nxt.pm * tstep : cA; const char* nB = has_next ? (const char*)g.Bt + (size_t)nxt.pn * tstep : cB;
        for (int t = 0; t < nt; t += 2) {
            const bool last = (t == nt - 2);
            const char* a1 = cA + (size_t)(t + 1) * kstep;
            const char* a2 = last ? nA : cA + (size_t)(t + 2) * kstep; const char* b2 = last ? nB : cB + (size_t)(t + 2) * kstep;
            const char* a3 = a2 + kstep; const char* b3 = b2 + kstep;
            if (last && has_next) S.a_ready(nxt);
            if constexpr (SP2) {
            PG8_LDB(B0, 0, 0); PG8_LDB(B1, 0, 1); PG8_SCHED; PG8_LDA(At, 0, 0); PG8_STAGE(PG8_SA(1, 1), a1 + hstep, voffA);
            PG8_WAIT_V(8); PG8_WAIT_L(0); PG8_BAR; PG8_MMA(0, 0, At, B0); PG8_MMA(0, 1, At, B1); PG8_BAR; PG8_SCHED;
            PG8_LDA(At, 0, 1); PG8_STAGE(PG8_SB(0, 0), b2, voffB); PG8_STAGE(PG8_SB(0, 1), b2 + hstep, voffB); PG8_STAGE(PG8_SA(0, 0), a2, voffA);
            PG8_WAIT_V(8); PG8_WAIT_L(0); PG8_BAR; PG8_MMA(1, 0, At, B0); PG8_MMA(1, 1, At, B1); PG8_BAR; PG8_SCHED;
            PG8_LDB(B0, 1, 0); PG8_LDB(B1, 1, 1); PG8_SCHED; PG8_LDA(At, 1, 0); PG8_STAGE(PG8_SA(0, 1), a2 + hstep, voffA);
            PG8_WAIT_V(8); PG8_WAIT_L(0); PG8_BAR; PG8_MMA(0, 0, At, B0); PG8_MMA(0, 1, At, B1); PG8_BAR; PG8_SCHED;
            PG8_LDA(At, 1, 1); PG8_STAGE(PG8_SB(1, 0), b3, voffB); PG8_STAGE(PG8_SB(1, 1), b3 + hstep, voffB); PG8_STAGE(PG8_SA(1, 0), a3, voffA);
            PG8_WAIT_V(8); PG8_WAIT_L(0); PG8_BAR; PG8_MMA(1, 0, At, B0); PG8_MMA(1, 1, At, B1); PG8_BAR; PG8_SCHED;
            } else {
            PG8_LDB(B0, 0, 0); PG8_SCHED; PG8_LDA(At, 0, 0); PG8_STAGE(PG8_SA(1, 1), a1 + hstep, voffA);
            PG8_WAIT_L(8); PG8_BAR; PG8_WAIT_L(0); PG8_MMA(0, 0, At, B0); PG8_BAR; PG8_SCHED;
            PG8_LDB(B1, 0, 1); PG8_STAGE(PG8_SB(0, 0), b2, voffB);
            PG8_BAR; PG8_WAIT_L(0); PG8_MMA(0, 1, At, B1); PG8_BAR;
            PG8_LDA(At, 0, 1); PG8_STAGE(PG8_SA(0, 0), a2, voffA);
            PG8_BAR; PG8_WAIT_L(0); PG8_MMA(1, 0, At, B0); PG8_BAR; PG8_SCHED;
            PG8_STAGE(PG8_SB(0, 1), b2 + hstep, voffB);
            PG8_WAIT_V(6); PG8_BAR; PG8_MMA(1, 1, At, B1); PG8_BAR;
            PG8_LDB(B0, 1, 0); PG8_SCHED; PG8_LDA(At, 1, 0); PG8_STAGE(PG8_SA(0, 1), a2 + hstep, voffA);
            PG8_WAIT_L(8); PG8_BAR; PG8_WAIT_L(0); PG8_MMA(0, 0, At, B0); PG8_BAR; PG8_SCHED;
            PG8_LDB(B1, 1, 1); PG8_STAGE(PG8_SB(1, 0), b3, voffB);
            PG8_BAR; PG8_WAIT_L(0); PG8_MMA(0, 1, At, B1); PG8_BAR;
            PG8_LDA(At, 1, 1); PG8_STAGE(PG8_SA(1, 0), a3, voffA);
            PG8_BAR; PG8_WAIT_L(0); PG8_MMA(1, 0, At, B0); PG8_BAR; PG8_SCHED;
            PG8_STAGE(PG8_SB(1, 1), b3 + hstep, voffB);
            PG8_WAIT_V(6); PG8_BAR; PG8_MMA(1, 1, At, B1); PG8_BAR;
            }
        }
        if constexpr (ALIGN_EPI) { if (wr == 0) PG8_BAR; }
        if constexpr (!Epi::AFTER_DRAIN) { E(acc, cur, wr, wc, fr, fq); S.done(cur); }
        if (!has_next) break;
#pragma unroll
        for (int a = 0; a < 2; ++a)
#pragma unroll
            for (int b = 0; b < 2; ++b)
#pragma unroll
                for (int m = 0; m < 4; ++m)
#pragma unroll
                    for (int n = 0; n < 2; ++n) acc[a][b][m][n] = (f32x4){0.f, 0.f, 0.f, 0.f};
        cur = nxt; cA = nA; cB = nB; ++ui;
        if constexpr (ALIGN_EPI) { if (wr == 1) PG8_BAR; }
    }
    PG8_WAIT_V(0);
    if constexpr (!ALIGN_EPI) { if (wr == 0) PG8_BAR; }
    PG8_BAR;
    if constexpr (Epi::AFTER_DRAIN) { E.fused(acc, cur, wr, wc, fr, fq, lds, wid, lane); S.done(cur); }
#undef PG8_SA
#undef PG8_SB
#undef PG8_STAGE
#undef PG8_LDA
#undef PG8_LDB
#undef PG8_MMA
#undef PG8_WAIT_V
#undef PG8_WAIT_L
#undef PG8_BAR
#undef PG8_SCHED
}
}

namespace att {
#define ATT_LAS __attribute__((address_space(3)))
typedef unsigned short bf16_t;
using bf16x8 = __attribute__((ext_vector_type(8))) short;
using s16x4  = __attribute__((ext_vector_type(4))) short;
using f32x16 = __attribute__((ext_vector_type(16))) float;
using u32x4  = __attribute__((ext_vector_type(4))) unsigned;
using f32x4v = __attribute__((ext_vector_type(4))) float;
constexpr int NW = 8, QBLK = 32, KVBLK = 64, DV = 128, LDQ = 1024, SEQ = 4096;
constexpr int SHM_V = KVBLK * DV * 2;
constexpr int NRING = 4;
constexpr int LDS_V = 0, LDS_K = NRING * SHM_V, LDS_BYTES = LDS_K + NRING * 16384;
#define ATT_SBAR() __builtin_amdgcn_sched_barrier(0)
__device__ __forceinline__ int crow(int r, int hi) { return (r & 3) + 8 * (r >> 2) + 4 * hi; }
__device__ __forceinline__ unsigned cvtpk(float lo, float hi) { unsigned r; asm volatile("v_cvt_pk_bf16_f32 %0, %1, %2" : "=v"(r) : "v"(lo), "v"(hi)); return r; }
template <int DQK> __device__ __forceinline__ int kswz(int row, int colB) {
  if constexpr (DQK == 128) return row * 256 + (colB ^ ((row & 15) << 4));
  else return row * 128 + (colB ^ (((row >> 1) & 7) << 4));
}
constexpr float THRL = 11.5f;
__device__ __forceinline__ void check_tile(const bool force, f32x16& p0, f32x16& p1, float& m_ref, float& l_reg, f32x16& negm, f32x16 (&o)[4], ATT_LAS float* al_l, const int r32, const int hi) {
  float pmax = p0[0];
#pragma unroll
  for (int r = 1; r < 16; ++r) pmax = fmaxf(pmax, p0[r]);
#pragma unroll
  for (int r = 0; r < 16; ++r) pmax = fmaxf(pmax, p1[r]);
  { auto rr = __builtin_amdgcn_permlane32_swap(__float_as_uint(pmax), __float_as_uint(pmax), false, false);
    pmax = fmaxf(__uint_as_float(rr[0]), __uint_as_float(rr[1])); }
  if (force || __builtin_expect(__any(pmax > THRL), 0)) {
    const float dl = force ? pmax : fmaxf(pmax, 0.f);
    m_ref += dl;
#pragma unroll
    for (int r = 0; r < 16; ++r) { p0[r] -= dl; p1[r] -= dl; }
#pragma unroll
    for (int r = 0; r < 16; ++r) negm[r] = -m_ref;
    if (!force) {
      const float al = __builtin_amdgcn_exp2f(-dl); l_reg *= al;
      if (hi == 0) al_l[r32] = al; asm volatile("s_waitcnt lgkmcnt(0)" ::: "memory");
#pragma unroll
      for (int d = 0; d < 4; ++d)
#pragma unroll
        for (int r = 0; r < 16; ++r) o[d][r] *= al_l[crow(r, hi)];
    }
  }
}
template <bool PRB> __device__ __forceinline__ void sm_tile(f32x16& p0, f32x16& p1, float& l_reg, bf16x8& pa0, bf16x8& pa1, bf16x8& pa2, bf16x8& pa3) {
#pragma unroll
  for (int r = 0; r < 16; ++r) p0[r] = __builtin_amdgcn_exp2f(p0[r]);
#pragma unroll
  for (int r = 0; r < 16; ++r) p1[r] = __builtin_amdgcn_exp2f(p1[r]);
#ifdef PROBE_EXP
  if constexpr (PRB) { f32x16 t0 = p0; _Pragma("unroll") for (int i = 0; i < PROBE_EXP; ++i) { _Pragma("unroll") for (int r = 0; r < 16; ++r) t0[r] = __builtin_amdgcn_exp2f(t0[r]); } asm volatile("" :: "v"(t0)); }
#endif
  float ps = 0;
#pragma unroll
  for (int r = 0; r < 16; ++r) ps += p0[r];
#pragma unroll
  for (int r = 0; r < 16; ++r) ps += p1[r];
  { auto rr = __builtin_amdgcn_permlane32_swap(__float_as_uint(ps), __float_as_uint(ps), false, false);
    ps = __uint_as_float(rr[0]) + __uint_as_float(rr[1]); }
  l_reg += ps;
#define ATT_PK4(P, BASE, OUT) do { u32x4 w = {cvtpk(P[BASE + 0], P[BASE + 1]), cvtpk(P[BASE + 2], P[BASE + 3]), cvtpk(P[BASE + 4], P[BASE + 5]), cvtpk(P[BASE + 6], P[BASE + 7])}; OUT = __builtin_bit_cast(bf16x8, w); } while (0)
  ATT_PK4(p0, 0, pa0); ATT_PK4(p0, 8, pa1); ATT_PK4(p1, 0, pa2); ATT_PK4(p1, 8, pa3);
#undef ATT_PK4
}
template <int DQK> __device__ __forceinline__ void qkt(f32x16& p0, f32x16& p1, const ATT_LAS char* Ks, const bf16x8* qr, int r32, int hi) {
  p0 = f32x16{}; p1 = f32x16{};
#pragma unroll
  for (int d0 = 0; d0 < DQK / 16; ++d0) { const int cb = (d0 * 16 + hi * 8) * 2;
    const bf16x8 b0 = *reinterpret_cast<const ATT_LAS bf16x8*>(Ks + kswz<DQK>(r32, cb));
    const bf16x8 b1 = *reinterpret_cast<const ATT_LAS bf16x8*>(Ks + kswz<DQK>(32 + r32, cb));
    p0 = __builtin_amdgcn_mfma_f32_32x32x16_bf16(b0, qr[d0], p0, 0, 0, 0);
    p1 = __builtin_amdgcn_mfma_f32_32x32x16_bf16(b1, qr[d0], p1, 0, 0, 0); }
}
__device__ __forceinline__ int v_st(int k, int c) { const int kk = k; return ((kk >> 3) * 4 + (c >> 5)) * 512 + ((kk & 7) * 32 + (c & 31)) * 2; }
__device__ __forceinline__ int v_rd_base(int lane) { return ((lane & 3) << 3) | (((lane >> 2) & 3) << 6) | (((lane >> 4) & 1) << 5) | (((lane >> 5) & 1) << 8); }
constexpr int v_rd_off(int d0, int ks, int half) { return d0 * 512 + ks * 4096 + half * 2048; }
template <int OFF> __device__ __forceinline__ s16x4 tr_read(int vb) {
  s16x4 r; asm volatile("ds_read_b64_tr_b16 %0, %1 offset:%2" : "=&v"(r) : "v"(vb), "i"(OFF) : "memory"); return r;
}
template <int D0> __device__ __forceinline__ void pv_one(f32x16& od, int vb, bf16x8 pa0, bf16x8 pa1, bf16x8 pa2, bf16x8 pa3) {
  const s16x4 l0 = tr_read<v_rd_off(D0, 0, 0)>(vb), h0 = tr_read<v_rd_off(D0, 0, 1)>(vb), l1 = tr_read<v_rd_off(D0, 1, 0)>(vb), h1 = tr_read<v_rd_off(D0, 1, 1)>(vb);
  const s16x4 l2 = tr_read<v_rd_off(D0, 2, 0)>(vb), h2 = tr_read<v_rd_off(D0, 2, 1)>(vb), l3 = tr_read<v_rd_off(D0, 3, 0)>(vb), h3 = tr_read<v_rd_off(D0, 3, 1)>(vb);
  asm volatile("s_waitcnt lgkmcnt(0)" ::: "memory"); ATT_SBAR();
#define ATT_PK(L, H) (bf16x8){L[0], L[1], L[2], L[3], H[0], H[1], H[2], H[3]}
  od = __builtin_amdgcn_mfma_f32_32x32x16_bf16(pa0, ATT_PK(l0, h0), od, 0, 0, 0);
  od = __builtin_amdgcn_mfma_f32_32x32x16_bf16(pa1, ATT_PK(l1, h1), od, 0, 0, 0);
  od = __builtin_amdgcn_mfma_f32_32x32x16_bf16(pa2, ATT_PK(l2, h2), od, 0, 0, 0);
  od = __builtin_amdgcn_mfma_f32_32x32x16_bf16(pa3, ATT_PK(l3, h3), od, 0, 0, 0);
#undef ATT_PK
}
__device__ __forceinline__ void pv_d0(f32x16* o, int vb, bf16x8 pa0, bf16x8 pa1, bf16x8 pa2, bf16x8 pa3) {
  pv_one<0>(o[0], vb, pa0, pa1, pa2, pa3); pv_one<1>(o[1], vb, pa0, pa1, pa2, pa3); pv_one<2>(o[2], vb, pa0, pa1, pa2, pa3); pv_one<3>(o[3], vb, pa0, pa1, pa2, pa3);
}

template <int OFF> __device__ __forceinline__ bf16x8 rdk(int addr) {
  bf16x8 r; asm volatile("ds_read_b128 %0, %1 offset:%2" : "=v"(r) : "v"(addr), "i"(OFF) : "memory"); return r;
}
#ifndef ATT_MPRIO
#define ATT_MPRIO 2
#endif
#define ATT_MF(A, B, C) __builtin_amdgcn_mfma_f32_32x32x16_bf16(A, B, C, 0, 0, 0)
#define ATT_PKV(L, H) (bf16x8){L[0], L[1], L[2], L[3], H[0], H[1], H[2], H[3]}
#define ATT_WAITL(n) do { asm volatile("s_waitcnt lgkmcnt(" #n ")" ::: "memory"); ATT_SBAR(); } while (0)
template <int DQK, int KB, int VB, bool HASQ, bool HASV, class DT>
__device__ __forceinline__ void mblock(DT& dmy, f32x16& p0, f32x16& p1, const f32x16& negm, f32x16 (&o)[4], const bf16x8 (&qr)[DQK / 16], const int (&kaddr)[DQK / 16], const int vaddr,
                                       const bf16x8 pa0, const bf16x8 pa1, const bf16x8 pa2, const bf16x8 pa3) {
  constexpr int KH = 32 * 2 * DQK;
  bf16x8 kA0, kA1, kA2, kA3, kB0, kB1, kB2, kB3; s16x4 vA0, vA1, vA2, vA3, vA4, vA5, vA6, vA7, vB0, vB1, vB2, vB3, vB4, vB5, vB6, vB7;
#define ATT_IK(S, d) do { k##S##0 = rdk<KB>(kaddr[d]); k##S##1 = rdk<KB + KH>(kaddr[d]); k##S##2 = rdk<KB>(kaddr[d + 1]); k##S##3 = rdk<KB + KH>(kaddr[d + 1]); } while (0)
#define ATT_IV(S, b) do { v##S##0 = tr_read<VB + v_rd_off(b, 0, 0)>(vaddr); v##S##1 = tr_read<VB + v_rd_off(b, 0, 1)>(vaddr); v##S##2 = tr_read<VB + v_rd_off(b, 1, 0)>(vaddr); v##S##3 = tr_read<VB + v_rd_off(b, 1, 1)>(vaddr); \
    v##S##4 = tr_read<VB + v_rd_off(b, 2, 0)>(vaddr); v##S##5 = tr_read<VB + v_rd_off(b, 2, 1)>(vaddr); v##S##6 = tr_read<VB + v_rd_off(b, 3, 0)>(vaddr); v##S##7 = tr_read<VB + v_rd_off(b, 3, 1)>(vaddr); } while (0)
#define ATT_QK0(S, d) do { p0 = ATT_MF(k##S##0, qr[d], negm); p1 = ATT_MF(k##S##1, qr[d], negm); p0 = ATT_MF(k##S##2, qr[d + 1], p0); p1 = ATT_MF(k##S##3, qr[d + 1], p1); ATT_SBAR(); } while (0)
#define ATT_QK(S, d) do { p0 = ATT_MF(k##S##0, qr[d], p0); p1 = ATT_MF(k##S##1, qr[d], p1); p0 = ATT_MF(k##S##2, qr[d + 1], p0); p1 = ATT_MF(k##S##3, qr[d + 1], p1); ATT_SBAR(); } while (0)
#define ATT_PV(S, b) do { o[b] = ATT_MF(pa0, ATT_PKV(v##S##0, v##S##1), o[b]); o[b] = ATT_MF(pa1, ATT_PKV(v##S##2, v##S##3), o[b]); o[b] = ATT_MF(pa2, ATT_PKV(v##S##4, v##S##5), o[b]); o[b] = ATT_MF(pa3, ATT_PKV(v##S##6, v##S##7), o[b]); ATT_SBAR(); } while (0)
  ATT_SBAR(); __builtin_amdgcn_s_setprio(ATT_MPRIO);
  if constexpr (HASQ && HASV) {
    if constexpr (DQK == 128) {
      ATT_IK(A, 0); ATT_IK(B, 2);
      ATT_WAITL(4); ATT_QK0(A, 0); ATT_IK(A, 4);
      ATT_WAITL(4); ATT_QK(B, 2); ATT_IK(B, 6);
      ATT_WAITL(4); ATT_QK(A, 4); ATT_IV(A, 0);
      ATT_WAITL(8); ATT_QK(B, 6); ATT_IV(B, 1);
    } else {
      ATT_IK(A, 0); ATT_IK(B, 2);
      ATT_WAITL(4); ATT_QK0(A, 0); ATT_IV(A, 0);
      ATT_WAITL(8); ATT_QK(B, 2); ATT_IV(B, 1);
    }
    ATT_WAITL(8); ATT_PV(A, 0); ATT_IV(A, 2);
    ATT_WAITL(8); ATT_PV(B, 1); ATT_IV(B, 3);
    ATT_WAITL(8); ATT_PV(A, 2);
    ATT_WAITL(0); ATT_PV(B, 3);
#ifdef PROBE_MFMA
    if constexpr (sizeof(DT) > 4) { _Pragma("unroll") for (int i = 0; i < PROBE_MFMA; ++i) dmy = ATT_MF(pa0, pa1, dmy); ATT_SBAR(); }
#endif
  } else if constexpr (HASQ) {
    ATT_IK(A, 0); ATT_IK(B, 2);
    if constexpr (DQK == 128) {
      ATT_WAITL(4); ATT_QK0(A, 0); ATT_IK(A, 4);
      ATT_WAITL(4); ATT_QK(B, 2); ATT_IK(B, 6);
      ATT_WAITL(4); ATT_QK(A, 4);
      ATT_WAITL(0); ATT_QK(B, 6);
    } else {
      ATT_WAITL(4); ATT_QK0(A, 0);
      ATT_WAITL(0); ATT_QK(B, 2);
    }
  } else {
    ATT_IV(A, 0); ATT_IV(B, 1);
    ATT_WAITL(8); ATT_PV(A, 0); ATT_IV(A, 2);
    ATT_WAITL(8); ATT_PV(B, 1); ATT_IV(B, 3);
    ATT_WAITL(8); ATT_PV(A, 2);
    ATT_WAITL(0); ATT_PV(B, 3);
  }
  __builtin_amdgcn_s_setprio(0);
#undef ATT_IK
#undef ATT_IV
#undef ATT_QK0
#undef ATT_QK
#undef ATT_PV
}

#ifdef PROBE_T
__device__ __forceinline__ unsigned long long stamp_() { unsigned long long t; __builtin_amdgcn_sched_barrier(0); asm volatile("s_memtime %0\n\ts_waitcnt lgkmcnt(0)" : "=s"(t) :: "memory"); __builtin_amdgcn_sched_barrier(0); return t; }
#define TS(v) const unsigned long long v = stamp_()
#define TACC(k, d) do { if (PROBE_T == (k)) tacc += (d); } while (0)
#else
#define TS(v)
#define TACC(k, d)
#endif
__device__ __forceinline__ void dma16(const __amdgpu_buffer_rsrc_t srd, const unsigned voff, const unsigned soff, const unsigned m0v) {
  asm volatile("s_nop 4\n\ts_mov_b32 m0, %0\n\ts_nop 0\n\tbuffer_load_dwordx4 %1, %2, %3 offen lds" :: "s"(m0v), "v"(voff), "s"(srd), "s"(soff) : "m0", "memory");
}
#define ATT_VMW(n) asm volatile("s_waitcnt vmcnt(" #n ")" ::: "memory")
#define ATT_BAR() do { asm volatile("s_waitcnt lgkmcnt(0)\n\ts_barrier" ::: "memory"); ATT_SBAR(); } while (0)
template <int DQK, int LDKV> struct DmaGeo {
  static constexpr int ROWB = LDKV * 2, SHM_K = 64 * DQK * 2;
  unsigned voffV, voffK, ldsV, ldsK; int w4;
  __device__ __forceinline__ void init(ATT_LAS char* lds, int lane, int wid) {
    w4 = wid & 3; ldsV = (unsigned)(size_t)(lds + LDS_V); ldsK = (unsigned)(size_t)(lds + LDS_K);
    voffV = (unsigned)((8 * (w4 >> 1) + ((lane & 31) >> 2)) * ROWB + 128 * (w4 & 1) + 64 * (lane >> 5) + 16 * (lane & 3));
    if constexpr (DQK == 128) voffK = (unsigned)((4 * w4 + (lane >> 4)) * ROWB + ((((lane & 15) ^ (lane >> 4)) ^ (4 * w4)) << 4));
    else voffK = (unsigned)((8 * w4 + (lane >> 3)) * ROWB + ((((lane & 7) ^ (lane >> 4)) ^ (4 * (w4 & 1))) << 4));
  }
  __device__ __forceinline__ void dmaV(const __amdgpu_buffer_rsrc_t srd, int t) const { const unsigned sb = (unsigned)t * (KVBLK * ROWB), mb = ldsV + (unsigned)(t & 3) * SHM_V + (unsigned)w4 * 1024u;
#pragma unroll
    for (int q = 0; q < 4; ++q) dma16(srd, voffV, sb + q * 16 * ROWB, mb + q * 4096u); }
  __device__ __forceinline__ void dmaK(const __amdgpu_buffer_rsrc_t srd, int t) const { const unsigned sb = (unsigned)t * (KVBLK * ROWB), mb = ldsK + (unsigned)(t & 3) * SHM_K + (unsigned)w4 * 1024u;
    if constexpr (DQK == 128) {
#pragma unroll
      for (int q = 0; q < 4; ++q) dma16(srd, voffK, sb + q * 16 * ROWB, mb + q * 4096u); }
    else {
#pragma unroll
      for (int q = 0; q < 2; ++q) dma16(srd, voffK, sb + q * 32 * ROWB, mb + q * 4096u); } }
};
template <int DQK, int LDKV>
__device__ __forceinline__ void attn_prefetch(bf16x8 (&qr)[DQK / 16], const bf16_t* Qb, const bf16_t* Kh, const bf16_t* Vh, ATT_LAS char* lds) {
  int tid_ = threadIdx.x; asm volatile("" : "+v"(tid_));
  const int tid = tid_, lane = tid & 63, r32 = lane & 31, hi = lane >> 5; const int wid = __builtin_amdgcn_readfirstlane(tid >> 6);
  const bf16_t* Qw = Qb + (long)(wid * QBLK + r32) * LDQ + hi * 8;
#pragma unroll
  for (int d0 = 0; d0 < DQK / 16; ++d0) qr[d0] = *reinterpret_cast<const bf16x8*>(Qw + d0 * 16);
  if ((wid >> 2) != 0) {
    DmaGeo<DQK, LDKV> G; G.init(lds, lane, wid);
    const __amdgpu_buffer_rsrc_t srdV = __builtin_amdgcn_make_buffer_rsrc((void*)Vh, (short)0, SEQ * LDKV * 2, 0x00020000), srdK = __builtin_amdgcn_make_buffer_rsrc((void*)Kh, (short)0, SEQ * LDKV * 2, 0x00020000);
    G.dmaK(srdK, 0); G.dmaK(srdK, 1); G.dmaV(srdV, 0); G.dmaK(srdK, 2); G.dmaV(srdV, 1);
  }
}
template <int DQK, int LDKV>
__device__ __forceinline__ void attn_core(bf16x8 (&qr)[DQK / 16], const bf16_t* Kh, const bf16_t* Vh, ATT_LAS char* lds, ATT_LAS float* wsf, f32x16 (&o)[4],
                                          const bool has_next, const bf16_t* Qb_n, const bf16_t* Kh_n, const bf16_t* Vh_n, unsigned long long& tacc) {
  int tid_ = threadIdx.x; asm volatile("" : "+v"(tid_));
  const int tid = tid_, lane = tid & 63, r32 = lane & 31, hi = lane >> 5; const int wid = __builtin_amdgcn_readfirstlane(tid >> 6); const int grp = wid >> 2;
  ATT_LAS float* ws = wsf + wid * 64; ATT_LAS float* li_l = ws; ATT_LAS float* al_l = ws + 32;
  constexpr int SHM_K = 64 * DQK * 2, NT = SEQ / KVBLK;
  DmaGeo<DQK, LDKV> G; G.init(lds, lane, wid);
  float m_ref = 0.f, l_reg = 0.f; f32x16 negm = f32x16{}; float dmy = 0.f;
#pragma unroll
  for (int d = 0; d < 4; ++d) o[d] = f32x16{};
  int kaddr[DQK / 16];
#pragma unroll
  for (int d0 = 0; d0 < DQK / 16; ++d0) kaddr[d0] = (int)G.ldsK + kswz<DQK>(r32, (d0 * 16 + hi * 8) * 2);
  const int vaddr = (int)G.ldsV + v_rd_base(lane);
  const __amdgpu_buffer_rsrc_t srdV = __builtin_amdgcn_make_buffer_rsrc((void*)Vh, (short)0, SEQ * LDKV * 2, 0x00020000), srdK = __builtin_amdgcn_make_buffer_rsrc((void*)Kh, (short)0, SEQ * LDKV * 2, 0x00020000);
#define ATT_STGK(j) do { if ((j) + 2 < NT) { if constexpr (DQK == 128) ATT_VMW(8); else ATT_VMW(6); } else ATT_VMW(0); if ((j) + 3 < NT) G.dmaK(srdK, (j) + 3); if ((j) + 2 < NT) G.dmaV(srdV, (j) + 2); } while (0)
#define ATT_STGV(j) do { } while (0)
#define ATT_SBLK(t) do { ATT_SBAR(); if (((t) & 7) == 0) check_tile((t) == 0, p0, p1, m_ref, l_reg, negm, o, al_l, r32, hi); sm_tile<false>(p0, p1, l_reg, pa0, pa1, pa2, pa3); ATT_SBAR(); } while (0)
#define ATT_M(R, HQ, HV) mblock<DQK, (R) * SHM_K, (((R) + 3) & 3) * SHM_V, HQ, HV>(dmy, p0, p1, negm, o, qr, kaddr, vaddr, pa0, pa1, pa2, pa3)
  f32x16 p0, p1; bf16x8 pa0 = {}, pa1 = {}, pa2 = {}, pa3 = {};
  static_assert(NT % 4 == 0 && NT >= 8, "tile count: a multiple of 4");
  ATT_BAR();
  if (grp == 0) {
    ATT_BAR();
    ATT_M(0, true, false); ATT_BAR(); ATT_SBLK(0); ATT_STGV(0); ATT_BAR();
    ATT_M(1, true, true); ATT_BAR(); ATT_SBLK(1); ATT_STGV(1); ATT_BAR();
    ATT_M(2, true, true); ATT_BAR(); ATT_SBLK(2); ATT_STGV(2); ATT_BAR();
    ATT_M(3, true, true); ATT_BAR(); ATT_SBLK(3); ATT_STGV(3); ATT_BAR();
    for (int j = 4; j < NT; j += 4) {
      TS(t0); ATT_M(0, true, true); TS(t1); ATT_BAR(); TS(t2); ATT_SBLK(j); TS(t2b); ATT_STGV(j); TS(t3); ATT_BAR(); TS(t4); TACC(1, t1 - t0); TACC(2, t2 - t1); TACC(9, t2b - t2); TACC(10, t3 - t2b); TACC(4, t4 - t3);
      ATT_M(1, true, true); ATT_BAR(); ATT_SBLK(j + 1); ATT_STGV(j + 1); ATT_BAR();
      ATT_M(2, true, true); ATT_BAR(); ATT_SBLK(j + 2); ATT_STGV(j + 2); ATT_BAR();
      ATT_M(3, true, true); ATT_BAR(); ATT_SBLK(j + 3); ATT_STGV(j + 3); ATT_BAR();
    }
    ATT_M(0, false, true); ATT_BAR();
    ATT_BAR();
  } else {
    if constexpr (DQK == 128) ATT_VMW(16); else ATT_VMW(12);
    ATT_BAR();
    ATT_STGK(0); ATT_BAR(); ATT_M(0, true, false); ATT_BAR();
    ATT_SBLK(0); ATT_STGK(1); ATT_BAR(); ATT_M(1, true, true); ATT_BAR();
    ATT_SBLK(1); ATT_STGK(2); ATT_BAR(); ATT_M(2, true, true); ATT_BAR();
    ATT_SBLK(2); ATT_STGK(3); ATT_BAR(); ATT_M(3, true, true); ATT_BAR();
    for (int j = 4; j < NT; j += 4) {
      TS(t0); ATT_SBLK(j - 1); TS(t1); ATT_STGK(j); TS(t2); ATT_BAR(); TS(t3); ATT_M(0, true, true); TS(t4); ATT_BAR(); TS(t5); TACC(5, t1 - t0); TACC(6, t2 - t1); TACC(7, t3 - t2); TACC(8, t4 - t3); TACC(11, t5 - t4);
      ATT_SBLK(j); ATT_STGK(j + 1); ATT_BAR(); ATT_M(1, true, true); ATT_BAR();
      ATT_SBLK(j + 1); ATT_STGK(j + 2); ATT_BAR(); ATT_M(2, true, true); ATT_BAR();
      ATT_SBLK(j + 2); ATT_STGK(j + 3); ATT_BAR(); ATT_M(3, true, true); ATT_BAR();
    }
    ATT_SBLK(NT - 1); ATT_BAR();
    ATT_M(0, false, true); ATT_BAR();
  }
  if (has_next) attn_prefetch<DQK, LDKV>(qr, Qb_n, Kh_n, Vh_n, lds);
  if (hi == 0) li_l[r32] = l_reg; asm volatile("s_waitcnt lgkmcnt(0)" ::: "memory");
#pragma unroll
  for (int r = 0; r < 16; ++r) { const float rl = __builtin_amdgcn_rcpf(li_l[crow(r, hi)]);
#pragma unroll
    for (int d = 0; d < 4; ++d) o[d][r] *= rl; }
#undef ATT_STGV
#undef ATT_STGK
#undef ATT_SBLK
#undef ATT_M
}
__device__ __forceinline__ void store_o(const f32x16 (&v)[4], bf16_t* Ob, ATT_LAS char* lds) {
  int tid_ = threadIdx.x; asm volatile("" : "+v"(tid_));
  const int tid = tid_, lane = tid & 63, r32 = lane & 31, hi = lane >> 5; const int wid = __builtin_amdgcn_readfirstlane(tid >> 6);
  ATT_LAS bf16_t* stg = (ATT_LAS bf16_t*)(lds + LDS_V + 2 * SHM_V + wid * 4096);
#pragma unroll
  for (int ps = 0; ps < 2; ++ps) {
#pragma unroll
    for (int r8 = 0; r8 < 8; ++r8) { const int r = 8 * ps + r8, lrow = crow(r, hi) - 16 * ps;
#pragma unroll
      for (int d0 = 0; d0 < 4; ++d0) { const unsigned b = cvtpk(v[d0][r], 0.f); stg[lrow * 128 + d0 * 32 + r32] = (bf16_t)(b & 0xffffu); } }
    asm volatile("s_waitcnt lgkmcnt(0)" ::: "memory");
#pragma unroll
    for (int i = 0; i < 4; ++i) { const int row = i * 4 + (lane >> 4), ch = lane & 15;
      const u32x4 w = *(const ATT_LAS u32x4*)(stg + row * 128 + ch * 8);
      *(u32x4*)(Ob + (long)(wid * QBLK + 16 * ps + row) * 1024 + ch * 8) = w; }
    asm volatile("s_waitcnt lgkmcnt(0)" ::: "memory");
  }
}
}

constexpr int NWAVES = 8;
constexpr int BATCH = 4, SEQ = 4096, DM = 1024, M = BATCH * SEQ, DFF = 2816, MODW = 6 * DM;
constexpr float EPS = 1e-6f, LAM_INIT0 = 0.2f;
constexpr int NPHASE = 13;
#ifndef MK_N_LAUNCHES
#define MK_N_LAUNCHES 1
#endif
constexpr size_t MiB = 1u << 20;
constexpr size_t WS_CTL = 0, CTL_ZERO_BYTES = 64 * 1024;
constexpr size_t WS_BIAS = 256 * 1024;
constexpr size_t WS_STAT = 1 * MiB + 768 * 1024;
constexpr size_t WS_MOD = 1 * MiB;
constexpr size_t WS_CSA = 1 * MiB + 256 * 1024;
constexpr size_t WS_CSB = 1 * MiB + 512 * 1024;
constexpr size_t WS_GQK = WS_CSB + 16384;
constexpr size_t WS_WAQKV = 2 * MiB, WS_WAO = 8 * MiB, WS_WIN0 = 10 * MiB, WS_WOUT0 = 21 * MiB;
constexpr size_t WS_WBQKV = 26 * MiB + 512 * 1024, WS_WBO = 29 * MiB + 512 * 1024, WS_WIN1 = 31 * MiB + 512 * 1024, WS_WOUT1 = 42 * MiB + 512 * 1024;
constexpr size_t WS_H = 48 * MiB, WS_O = 80 * MiB, WS_Q = 112 * MiB, WS_K = 144 * MiB, WS_V = 176 * MiB, WS_END = 208 * MiB;
constexpr size_t WS_ACT = WS_Q;
static_assert(WS_ACT + (size_t)M * DFF * 2 <= WS_END, "act overlay");
constexpr int RING_BYTES = 131072;
constexpr int EPI_OFF = RING_BYTES;
constexpr int MISC_OFF = RING_BYTES + 8192;
constexpr int LDS_BYTES = 147456;
static_assert(MISC_OFF + 128 <= LDS_BYTES, "LDS map");

#define GAS __attribute__((address_space(1)))
#define LAS __attribute__((address_space(3)))
typedef unsigned short bf16;
typedef unsigned v4u __attribute__((ext_vector_type(4)));
typedef unsigned v2u __attribute__((ext_vector_type(2)));
typedef float f32x4 __attribute__((ext_vector_type(4)));
typedef GAS unsigned gu32;
#define RLX_AGENT __ATOMIC_RELAXED, __HIP_MEMORY_SCOPE_AGENT
#define LDS_WAIT() asm volatile("s_waitcnt lgkmcnt(0)" ::: "memory")
#define VM_WAIT() asm volatile("s_waitcnt vmcnt(0)" ::: "memory")
__device__ __forceinline__ unsigned f2bf(float f) { unsigned u = __builtin_bit_cast(unsigned, f); return (u + 0x7fffu + ((u >> 16) & 1u)) >> 16; }
__device__ __forceinline__ unsigned pk2(float lo, float hi) { return f2bf(lo) | (f2bf(hi) << 16); }

#define XB_TMO      128
#define XB_XCNT(j)  (256  + 64 * (j))
#define XB_XSUB(j)  (1280 + 64 * (j))
#define XB_XGEN(j)  (2304 + 64 * (j))
#define XB_TOP      3328
#define XB_TOPGEN   3392
#define XCD_BAR_WORDS 3456
#define XB_SPIN_CAP (1u << 18)

__device__ __forceinline__ unsigned xb_ld(unsigned* p)              { return __hip_atomic_load(p, __ATOMIC_RELAXED, __HIP_MEMORY_SCOPE_AGENT); }
__device__ __forceinline__ unsigned xb_add(unsigned* p, unsigned v) { return __hip_atomic_fetch_add(p, v, __ATOMIC_RELAXED, __HIP_MEMORY_SCOPE_AGENT); }
__device__ __forceinline__ unsigned xb_xcc_id() { return (unsigned)__builtin_amdgcn_s_getreg((3 << 11) | 20) & 0xFu; }
#define XB_SPIN(cond, bar) do { unsigned _sp = 0; while (cond) { __builtin_amdgcn_s_sleep(1); \
    if ((++_sp & 255u) == 0u) { if (xb_ld(&(bar)[XB_TMO])) break; if (_sp > XB_SPIN_CAP) { atomicAdd(&(bar)[XB_TMO], 1u); break; } } } } while (0)

struct XcdBarrier {
    unsigned* bar; unsigned x;
    volatile LAS unsigned* st;
};

__device__ __forceinline__ XcdBarrier xcd_barrier_post(unsigned* bar, volatile LAS unsigned* st) {
    XcdBarrier b; b.bar = bar; b.x = xb_xcc_id(); b.st = st;
    if (threadIdx.x == 0) (void)xb_add(&bar[XB_XCNT(b.x)], 1u);
    return b;
}
__device__ __forceinline__ void xcd_barrier_complete(unsigned* bar, unsigned x, unsigned& nloc, unsigned& nx) {
    const unsigned G = gridDim.x * gridDim.y * gridDim.z;
    unsigned sum, cnt, mine, sp = 0u;
    for (;;) {
        sum = 0u; cnt = 0u; mine = 0u;
#pragma unroll
        for (unsigned j = 0; j < 16; ++j) { const unsigned c = xb_ld(&bar[XB_XCNT(j)]); sum += c; cnt += (c > 0u) ? 1u : 0u; mine = (j == x) ? c : mine; }
        if (sum == G) break;
        __builtin_amdgcn_s_sleep(1);
        if ((++sp & 255u) == 0u) { if (xb_ld(&bar[XB_TMO])) break; if (sp > XB_SPIN_CAP) { atomicAdd(&bar[XB_TMO], 1u); break; } }
    }
    nloc = mine > 0u ? mine : 1u; nx = cnt > 0u ? cnt : 1u;
}

__device__ __forceinline__ void xcd_barrier(const XcdBarrier& b) {
    asm volatile("s_waitcnt vmcnt(0)" ::: "memory");
    __syncthreads();
    if (threadIdx.x == 0) {
        unsigned* bar = b.bar;
        __builtin_amdgcn_s_waitcnt(0);
        unsigned nloc = b.st[0], nx = b.st[1];
        if (nloc == 0u) { xcd_barrier_complete(bar, b.x, nloc, nx); b.st[0] = nloc; b.st[1] = nx; }
        const unsigned old = xb_add(&bar[XB_XSUB(b.x)], 1u);
        const unsigned gen = old / nloc;
        if (old + 1u == (gen + 1u) * nloc) {
            __builtin_amdgcn_fence(__ATOMIC_RELEASE, "agent");
            asm volatile("s_waitcnt vmcnt(0)" ::: "memory");
            const unsigned og = xb_add(&bar[XB_TOP], 1u);
            const unsigned tg = og / nx;
            if (og + 1u == (tg + 1u) * nx) xb_add(&bar[XB_TOPGEN], 1u);
            else XB_SPIN(xb_ld(&bar[XB_TOPGEN]) == tg, bar);
            __builtin_amdgcn_fence(__ATOMIC_ACQUIRE, "agent");
            xb_add(&bar[XB_XGEN(b.x)], 1u);
            asm volatile("s_waitcnt vmcnt(0)" ::: "memory");
        } else {
            XB_SPIN(xb_ld(&bar[XB_XGEN(b.x)]) == gen, bar);
            __builtin_amdgcn_fence(__ATOMIC_ACQUIRE, "agent");
            asm volatile("s_waitcnt vmcnt(0)" ::: "memory");
        }
    }
    __syncthreads();
}


struct Frame {
    LAS unsigned char* lds;
    volatile LAS unsigned* MISC;
    int tid, lane, wave, vcu, G;
};
__device__ __forceinline__ float wave_sum(float v) {
#pragma unroll
    for (int o = 1; o < 64; o <<= 1) v += __shfl_xor(v, o);
    return v;
}
__device__ const float FREQ_A[8] = {1.000000000e+00f, 1.939227432e-01f, 3.760603070e-02f, 7.292664610e-03f, 1.414213562e-03f, 2.742481884e-04f, 5.318296098e-05f, 1.031338616e-05f};
__device__ const float FREQ_B[32] = {1.000000000e+00f, 7.498942614e-01f, 5.623413324e-01f, 4.216965139e-01f, 3.162277639e-01f, 2.371373773e-01f, 1.778279394e-01f, 1.333521307e-01f, 1.000000015e-01f, 7.498941571e-02f, 5.623413250e-02f, 4.216965288e-02f, 3.162277490e-02f, 2.371373773e-02f, 1.778279431e-02f, 1.333521493e-02f, 9.999999776e-03f, 7.498941850e-03f, 5.623413250e-03f, 4.216964822e-03f, 3.162277630e-03f, 2.371373586e-03f, 1.778279431e-03f, 1.333521446e-03f, 1.000000047e-03f, 7.498942432e-04f, 5.623413017e-04f, 4.216965172e-04f, 3.162277571e-04f, 2.371373703e-04f, 1.778279402e-04f, 1.333521504e-04f};
__device__ __forceinline__ void sincos_acc(float a, float& c, float& s) {
    const double TWO_PI = 6.283185307179586476925286766559, x0 = (double)a;
    const double n = __builtin_rint(x0 * (1.0 / TWO_PI)), x = x0 - n * TWO_PI, x2 = x * x;
    double ts = 1.0, tc = 1.0;
#pragma unroll
    for (int k = 14; k >= 1; --k) { ts = 1.0 - x2 * ts * (1.0 / (double)((2 * k) * (2 * k + 1))); tc = 1.0 - x2 * tc * (1.0 / (double)((2 * k - 1) * (2 * k))); }
    s = (float)(x * ts); c = (float)tc;
}
__device__ __forceinline__ int colmap(int kind, int n) {
    if (kind == 1) { if (n >= 2048) return n; const int p = n & 63, d = p < 16 ? ((p & 1) ? (p >> 1) + 8 : (p >> 1)) : p; return (n & ~63) + d; }
    if (kind == 2) { if (n >= 1280) return n; const int p = n & 127, pr = p >> 1, first = pr < 32 ? pr : pr + 32; return (n & ~127) + ((p & 1) ? first + 32 : first); }
    if (kind == 3) { const int t = n >> 8, r = n & 255; return r < 128 ? t * 128 + r : DFF + t * 128 + (r - 128); }
    return n;
}
__device__ __forceinline__ void transpose_item(const float* W, int K, int N, bf16* WT, int kind, LAS float* scr, int item, int lane) {
    const int nblk = N / 32, kb = item / nblk, nb = item % nblk, k0 = 64 * kb, n0 = 32 * nb;
    const int src = colmap(kind, n0 + (lane & 31));
#pragma unroll 8
    for (int i = 0; i < 32; ++i) { const int kk = 2 * i + (lane >> 5); scr[kk * 33 + (lane & 31)] = W[(size_t)(k0 + kk) * N + src]; }
    LDS_WAIT(); asm volatile("" ::: "memory");
    const int c = lane & 7;
#pragma unroll
    for (int j = 0; j < 4; ++j) { const int n = (lane >> 3) + 8 * j; const LAS float* s = scr + (8 * c) * 33 + n;
        v4u o; o.x = pk2(s[0 * 33], s[1 * 33]); o.y = pk2(s[2 * 33], s[3 * 33]); o.z = pk2(s[4 * 33], s[5 * 33]); o.w = pk2(s[6 * 33], s[7 * 33]);
        *(GAS v4u*)(WT + (size_t)(n0 + n) * K + k0 + 8 * c) = o; }
    LDS_WAIT(); asm volatile("" ::: "memory");
}
struct Args { const float* in[20]; float* out; unsigned char* ws; int ph_lo, ph_hi; };

__device__ __forceinline__ void p0_prologue(Frame& F, const Args& a) {
    unsigned char* ws = a.ws;
    {
        LAS float* scr = (LAS float*)(F.lds + F.wave * 16384);
        const int gw = F.vcu * NWAVES + F.wave, NGW = F.G * NWAVES;
        constexpr int I0 = (DM / 64) * (3072 / 32), I1 = (DM / 64) * (DM / 32), I2 = (DM / 64) * (2 * DFF / 32), I3 = (DFF / 64) * (DM / 32), I4 = (DM / 64) * (1536 / 32);
        constexpr int NITEMS = I0 + I1 + I2 + I3 + I4 + I1 + I2 + I3;
        for (int it = gw; it < NITEMS; it += NGW) {
            int r = it;
            if (r < I0) { transpose_item(a.in[6], DM, 3072, (bf16*)(ws + WS_WAQKV), 1, scr, r, F.lane); continue; } r -= I0;
            if (r < I1) { transpose_item(a.in[7], DM, DM, (bf16*)(ws + WS_WAO), 0, scr, r, F.lane); continue; } r -= I1;
            if (r < I2) { transpose_item(a.in[17], DM, 2 * DFF, (bf16*)(ws + WS_WIN0), 3, scr, r, F.lane); continue; } r -= I2;
            if (r < I3) { transpose_item(a.in[18], DFF, DM, (bf16*)(ws + WS_WOUT0), 0, scr, r, F.lane); continue; } r -= I3;
            if (r < I4) { transpose_item(a.in[13], DM, 1536, (bf16*)(ws + WS_WBQKV), 2, scr, r, F.lane); continue; } r -= I4;
            if (r < I1) { transpose_item(a.in[14], DM, DM, (bf16*)(ws + WS_WBO), 0, scr, r, F.lane); continue; } r -= I1;
            if (r < I2) { transpose_item(a.in[17] + (size_t)DM * 2 * DFF, DM, 2 * DFF, (bf16*)(ws + WS_WIN1), 3, scr, r, F.lane); continue; } r -= I2;
            transpose_item(a.in[18] + (size_t)DFF * DM, DFF, DM, (bf16*)(ws + WS_WOUT1), 0, scr, r, F.lane);
        }
    }
    __syncthreads();
    {
        LAS float* cond = (LAS float*)F.lds;
        LAS float* part = (LAS float*)(F.lds + 16384);
        const float* c = a.in[1]; float* mod = (float*)(ws + WS_MOD);
        for (int i = F.tid; i < BATCH * DM; i += NWAVES * 64) { const float v = c[i]; cond[i] = v / (1.0f + __expf(-v)); }
        __syncthreads();
        for (int task = F.vcu; task < 2 * (MODW / 64); task += F.G) {
            const int L = task / (MODW / 64), n0 = (task % (MODW / 64)) * 64;
            const float* W = a.in[2] + (size_t)L * DM * MODW + n0 + F.lane;
            float acc0 = 0.f, acc1 = 0.f, acc2 = 0.f, acc3 = 0.f;
            const int kb = F.wave * 128;
#pragma unroll 8
            for (int k = 0; k < 128; ++k) { const float w = W[(size_t)(kb + k) * MODW];
                acc0 += cond[kb + k] * w; acc1 += cond[DM + kb + k] * w; acc2 += cond[2 * DM + kb + k] * w; acc3 += cond[3 * DM + kb + k] * w; }
            part[(F.wave * 4 + 0) * 64 + F.lane] = acc0; part[(F.wave * 4 + 1) * 64 + F.lane] = acc1; part[(F.wave * 4 + 2) * 64 + F.lane] = acc2; part[(F.wave * 4 + 3) * 64 + F.lane] = acc3;
            __syncthreads();
            if (F.tid < 256) { const int b = F.tid >> 6, l = F.tid & 63; float s = 0.f;
#pragma unroll
                for (int w = 0; w < 8; ++w) s += part[(w * 4 + b) * 64 + l];
                mod[((size_t)L * BATCH + b) * MODW + n0 + l] = s + a.in[3][(size_t)L * MODW + n0 + l]; }
            __syncthreads();
        }
    }
    {
        float* csa = (float*)(ws + WS_CSA); float* csb = (float*)(ws + WS_CSB);
        if (F.vcu == 0 && F.tid < 256) ((float*)(ws + WS_GQK))[F.tid] = F.tid < 128 ? a.in[15][F.tid] : a.in[16][F.tid - 128];
        for (int e = F.vcu * (NWAVES * 64) + F.tid; e < SEQ * 8 + 64 * 32; e += F.G * NWAVES * 64) {
            float cc, ss;
            if (e < SEQ * 8) { const int t = e >> 3, i = e & 7; sincos_acc((float)t * FREQ_A[i], cc, ss); csa[t * 16 + i] = cc; csa[t * 16 + 8 + i] = ss; }
            else { const int e2 = e - SEQ * 8, p = e2 >> 5, i = e2 & 31; sincos_acc((float)p * FREQ_B[i], cc, ss); csb[p * 64 + i] = cc; csb[p * 64 + 32 + i] = ss; }
        }
    }
}
__device__ __forceinline__ void bias_tasks(Frame& F, const Args& a) {
    unsigned char* ws = a.ws;
    LAS float* shl = (LAS float*)F.lds;
    LAS float* part = (LAS float*)(F.lds + 16384);
    const float* mod = (const float*)(ws + WS_MOD); float* bias = (float*)(ws + WS_BIAS);
    constexpr int T0 = 2 * DFF / 64, T1 = 1536 / 64;
    for (int task = F.vcu; task < 2 * T0 + T1; task += F.G) {
        const float* W; const float* sh; float* out; int N, kind, n0;
        if (task < T0) { W = a.in[17]; N = 2 * DFF; kind = 3; n0 = task * 64; sh = mod + 3 * DM; out = bias; }
        else if (task < T0 + T1) { W = a.in[13]; N = 1536; kind = 2; n0 = (task - T0) * 64; sh = mod + (size_t)BATCH * MODW; out = bias + 4 * 2 * DFF; }
        else { W = a.in[17] + (size_t)DM * 2 * DFF; N = 2 * DFF; kind = 3; n0 = (task - T0 - T1) * 64; sh = mod + (size_t)BATCH * MODW + 3 * DM; out = bias + 4 * 2 * DFF + 4 * 1536; }
        for (int i = F.tid; i < BATCH * DM; i += NWAVES * 64) shl[i] = sh[(size_t)(i >> 10) * MODW + (i & 1023)];
        __syncthreads();
        const float* Wc = W + colmap(kind, n0 + F.lane);
        float acc0 = 0.f, acc1 = 0.f, acc2 = 0.f, acc3 = 0.f;
        const int kb = F.wave * 128;
#pragma unroll 8
        for (int k = 0; k < 128; ++k) { const float w = Wc[(size_t)(kb + k) * N];
            acc0 += shl[kb + k] * w; acc1 += shl[DM + kb + k] * w; acc2 += shl[2 * DM + kb + k] * w; acc3 += shl[3 * DM + kb + k] * w; }
        part[(F.wave * 4 + 0) * 64 + F.lane] = acc0; part[(F.wave * 4 + 1) * 64 + F.lane] = acc1; part[(F.wave * 4 + 2) * 64 + F.lane] = acc2; part[(F.wave * 4 + 3) * 64 + F.lane] = acc3;
        __syncthreads();
        if (F.tid < 256) { const int b = F.tid >> 6, l = F.tid & 63; float s = 0.f;
#pragma unroll
            for (int w = 0; w < 8; ++w) s += part[(w * 4 + b) * 64 + l];
            out[(size_t)b * N + n0 + l] = s; }
        __syncthreads();
    }
}
__device__ __forceinline__ void norm_rows(Frame& F, const float* x, const float* g, const float* shift, const float* scale, bf16* h) {
    const int gw = F.vcu * NWAVES + F.wave, NGW = F.G * NWAVES;
    for (int m = gw; m < M; m += NGW) {
        const GAS f32x4* xr = (const GAS f32x4*)(x + (size_t)m * DM) + F.lane;
        f32x4 v[4]; float s = 0.f;
#pragma unroll
        for (int j = 0; j < 4; ++j) { v[j] = xr[64 * j]; s += (v[j].x * v[j].x + v[j].y * v[j].y) + (v[j].z * v[j].z + v[j].w * v[j].w); }
        const float rstd = 1.0f / sqrtf(wave_sum(s) * (1.f / DM) + EPS);
        const int b = m / SEQ; const float* sh = shift + (size_t)b * MODW; const float* sc = scale + (size_t)b * MODW;
        GAS v2u* o8 = (GAS v2u*)(h + (size_t)m * DM) + F.lane;
#pragma unroll
        for (int j = 0; j < 4; ++j) { const int col = 4 * F.lane + 256 * j;
            const f32x4 gg = *(const f32x4*)(g + col), s1 = *(const f32x4*)(sc + col), s0 = *(const f32x4*)(sh + col);
            const f32x4 y = ((v[j] * rstd) * gg) * (s1 + 1.0f) + s0;
            v2u w; w.x = pk2(y.x, y.y); w.y = pk2(y.z, y.w); o8[64 * j] = w; }
    }
}
__device__ __forceinline__ void final_norm(Frame& F, float* x, const float* g) {
    const int gw = F.vcu * NWAVES + F.wave, NGW = F.G * NWAVES;
    for (int m = gw; m < M; m += NGW) {
        GAS f32x4* xr = (GAS f32x4*)(x + (size_t)m * DM) + F.lane;
        f32x4 v[4]; float s = 0.f;
#pragma unroll
        for (int j = 0; j < 4; ++j) { v[j] = xr[64 * j]; s += (v[j].x * v[j].x + v[j].y * v[j].y) + (v[j].z * v[j].z + v[j].w * v[j].w); }
        const float rstd = 1.0f / sqrtf(wave_sum(s) * (1.f / DM) + EPS);
#pragma unroll
        for (int j = 0; j < 4; ++j) { const f32x4 gg = *(const f32x4*)(g + 4 * F.lane + 256 * j); xr[64 * j] = (v[j] * rstd) * gg; }
    }
}
__device__ __forceinline__ void attn_phase_A(unsigned long long& tacc, Frame& F, const bf16* Q, const bf16* K, const bf16* V, bf16* O, float* scr, const float* lq1, const float* lk1, const float* lq2, const float* lk2, const float* subg) {
    const float lam = __expf(wave_sum(lq1[F.lane] * lk1[F.lane])) - __expf(wave_sum(lq2[F.lane] * lk2[F.lane])) + LAM_INIT0;
    const int wid = F.wave;
    LAS char* lds = (LAS char*)F.lds; LAS float* wsf = (LAS float*)(F.lds + EPI_OFF);
#define A_PTRS(uid_, c_, Qp, Kp, Vp) const int bh_ = ((uid_) & 255) >> 3, qb_ = (((uid_) & 7) << 1) | ((uid_) >> 8), b_ = bh_ >> 3, h_ = bh_ & 7; \
        const bf16* Qp = Q + ((size_t)b_ * SEQ + (size_t)qb_ * 256) * DM + h_ * 128 + (c_) * 64; const bf16* Kp = K + (size_t)b_ * SEQ * DM + h_ * 128 + (c_) * 64; const bf16* Vp = V + (size_t)b_ * SEQ * DM + h_ * 128
    att::bf16x8 qr[4];
    if (F.vcu < 512) { A_PTRS(F.vcu, 0, Q0, K0, V0); att::attn_prefetch<64, 1024>(qr, Q0, K0, V0, lds); }
    for (int uid = F.vcu; uid < 512; uid += F.G) {
        const int bh = (uid & 255) >> 3, qb = ((uid & 7) << 1) | (uid >> 8), b = bh >> 3, h = bh & 7;
        const size_t row0 = (size_t)b * SEQ + (size_t)qb * 256, krow0 = (size_t)b * SEQ;
#pragma unroll 1
        for (int c = 0; c < 2; ++c) {
            att::f32x16 o[4];
            const int nuid = c == 0 ? uid : uid + F.G, nc = c ^ 1; const bool has_next = nuid < 512;
            A_PTRS(has_next ? nuid : uid, nc, Qn, Kn, Vn);
            att::attn_core<64, 1024>(qr, K + krow0 * DM + h * 128 + c * 64, V + krow0 * DM + h * 128, lds, wsf, o, has_next, Qn, Kn, Vn, tacc);
            int ln = threadIdx.x & 63; asm volatile("" : "+v"(ln));
            att::f32x4v* sw = (att::f32x4v*)scr + ((size_t)(uid * 8 + wid) * 16) * 64 + ln;
            if (c == 0) {
#pragma unroll
                for (int r = 0; r < 16; ++r) sw[r * 64] = (att::f32x4v){o[0][r], o[1][r], o[2][r], o[3][r]};
            } else {
                float gs[4];
#pragma unroll
                for (int d0 = 0; d0 < 4; ++d0) gs[d0] = subg[d0 * 32 + (ln & 31)] * (1.0f - LAM_INIT0);
#pragma unroll
                for (int r = 0; r < 16; ++r) { const att::f32x4v o0 = sw[r * 64]; float ss = 0.f;
#pragma unroll
                    for (int d0 = 0; d0 < 4; ++d0) { const float v = o0[d0] - lam * o[d0][r]; o[d0][r] = v; ss += v * v; }
                    ss += __shfl_xor(ss, 1); ss += __shfl_xor(ss, 2); ss += __shfl_xor(ss, 4); ss += __shfl_xor(ss, 8); ss += __shfl_xor(ss, 16);
                    const float rs = 1.0f / sqrtf(ss * (1.0f / 128.0f) + EPS);
#pragma unroll
                    for (int d0 = 0; d0 < 4; ++d0) o[d0][r] *= rs * gs[d0];
                    if ((r & 3) == 3) asm volatile("" ::: "memory"); }
                att::store_o(o, O + row0 * DM + h * 128, lds);
            }
        }
    }
#undef A_PTRS
}
__device__ __forceinline__ void attn_phase_B(unsigned long long& tacc, Frame& F, const bf16* Q, const bf16* K, const bf16* V, bf16* O) {
    LAS char* lds = (LAS char*)F.lds; LAS float* wsf = (LAS float*)(F.lds + EPI_OFF);
#define B_PTRS(uid_, Qp, Kp, Vp, Op) const int grp_ = ((uid_) & 255) >> 5, w_ = (((uid_) & 31) << 1) | ((uid_) >> 8), b_ = grp_ >> 1, kvh_ = grp_ & 1, hq_ = kvh_ * 4 + (w_ >> 4), qb_ = w_ & 15; \
        const bf16* Qp = Q + ((size_t)b_ * SEQ + (size_t)qb_ * 256) * DM + hq_ * 128; const bf16* Kp = K + (size_t)b_ * SEQ * 256 + kvh_ * 128; const bf16* Vp = V + (size_t)b_ * SEQ * 256 + kvh_ * 128; \
        bf16* Op = O + ((size_t)b_ * SEQ + (size_t)qb_ * 256) * DM + hq_ * 128
    att::bf16x8 qr[8];
    if (F.vcu < 512) { B_PTRS(F.vcu, Q0, K0, V0, O0); (void)O0; att::attn_prefetch<128, 256>(qr, Q0, K0, V0, lds); }
    for (int uid = F.vcu; uid < 512; uid += F.G) {
        B_PTRS(uid, Qc, Kc, Vc, Oc); (void)Qc;
        const bool has_next = uid + F.G < 512;
        const int nuid = has_next ? uid + F.G : uid;
        const int ngrp = (nuid & 255) >> 5, nw = ((nuid & 31) << 1) | (nuid >> 8), nb = ngrp >> 1, nkvh = ngrp & 1, nhq = nkvh * 4 + (nw >> 4), nqb = nw & 15;
        att::f32x16 o[4];
        att::attn_core<128, 256>(qr, Kc, Vc, lds, wsf, o, has_next, Q + ((size_t)nb * SEQ + (size_t)nqb * 256) * DM + nhq * 128, K + (size_t)nb * SEQ * 256 + nkvh * 128, V + (size_t)nb * SEQ * 256 + nkvh * 128, tacc);
        att::store_o(o, Oc, lds);
    }
#undef B_PTRS
}

#ifndef PHMASK
#define PHMASK 0xFFFF
#endif
#define KIND(b) (((PHMASK) >> (b)) & 1)
#ifndef REPMASK
#define REPMASK 0
#endif
#define REP(b) for (int rep_ = 0; rep_ < 1 + (((REPMASK) >> (b)) & 1); ++rep_)
constexpr bool USE_BAR = (MK_N_LAUNCHES != NPHASE);
#define IN(k) (lo <= (k) && (k) < hi)
#define SEAM(k) do { if (USE_BAR && IN((k) + 1)) xcd_barrier(bar); } while (0)
__device__ __forceinline__ void refresh(Frame& F) { int t = threadIdx.x; asm volatile("" : "+v"(t)); F.tid = t; F.lane = t & 63; F.wave = __builtin_amdgcn_readfirstlane(t >> 6); }

template <int L>
__device__ __forceinline__ void layer_phases(Frame& F, const Args& args, const int lo, const int hi, const XcdBarrier& bar) {
    constexpr int pb = (L == 0) ? 1 : 6;
    unsigned char* ws = args.ws;
    const float* x = args.in[0]; float* out = args.out;
    const float* modL = (const float*)(ws + WS_MOD) + (size_t)L * BATCH * MODW;
    const float* xin = (L == 0) ? x : (const float*)out;
    bf16 *H = (bf16*)(ws + WS_H), *O = (bf16*)(ws + WS_O), *Qb = (bf16*)(ws + WS_Q), *ACT = (bf16*)(ws + WS_ACT);
    float* stat = (float*)(ws + WS_STAT); const float* biasb = (const float*)(ws + WS_BIAS);
    LAS float* escr = (LAS float*)(F.lds + EPI_OFF);
    if constexpr (L == 0) { if (KIND(1) && IN(pb)) { refresh(F); REP(1) { bias_tasks(F, args); norm_rows(F, xin, args.in[4], modL, modL + DM, H); } SEAM(pb); } }
    if (IN(pb + 1)) {
        if constexpr (L == 0) { if (KIND(2)) REP(2) { pg8::Gemm g{H, (const bf16*)(ws + WS_WAQKV), M, 3072, DM}; pg8::StaticOrder S; S.init(M, 3072, F.G, (int)blockIdx.x);
            pg8::EpiQkvA E{Qb, (size_t)(WS_K - WS_Q) / 2, (const float*)(ws + WS_CSA)};
            pg8::gemm_phase<pg8::EpiQkvA, pg8::StaticOrder, true, true>(F.lds, g, S, E); } }
        else { if (KIND(3)) REP(3) { pg8::Gemm g{H, (const bf16*)(ws + WS_WBQKV), M, 1536, DM}; pg8::StaticOrder S; S.init(M, 1536, F.G, (int)blockIdx.x);
            pg8::EpiQkvB E{stat, biasb + 4 * 2 * DFF, Qb, (size_t)(WS_K - WS_Q) / 2, (const float*)(ws + WS_GQK), (const float*)(ws + WS_CSB), escr};
            pg8::gemm_phase<pg8::EpiQkvB, pg8::StaticOrder, true, true>(F.lds, g, S, E); } }
        SEAM(pb + 1);
    }
    if (IN(pb + 2)) {
        refresh(F); unsigned long long tacc = 0;
#ifdef PROBE_T
        const unsigned long long ph0_ = __builtin_amdgcn_s_memtime();
#endif
        bf16 *Kb = (bf16*)(ws + WS_K), *Vb = (bf16*)(ws + WS_V);
#ifdef PROBE_CLK
        unsigned long long t0_ = __builtin_amdgcn_s_memtime(), r0_ = __builtin_amdgcn_s_memrealtime();
#endif
        if constexpr (L == 0) { if (KIND(4)) REP(4) attn_phase_A(tacc, F, Qb, Kb, Vb, O, out, args.in[8], args.in[9], args.in[10], args.in[11], args.in[12]); }
        else { if (KIND(5)) REP(5) attn_phase_B(tacc, F, Qb, Kb, Vb, O); }
#ifdef PROBE_T
        if (PROBE_T == 24) tacc = 2 * (L == 0 ? 2 : 1) * (__builtin_amdgcn_s_memtime() - ph0_);
        if (L == PROBE_L && blockIdx.x == PROBE_BLK && threadIdx.x == ((PROBE_T <= 4 || PROBE_T == 9 || PROBE_T == 10 || PROBE_T >= 12) ? 0 : 256)) ((float*)(ws + WS_GQK))[300] = (PROBE_T >= 20) ? (float)tacc * (1.0f / (2 * (L == 0 ? 2 : 1))) * 1e-5f : (float)tacc * (1.0f / (2 * 15 * (L == 0 ? 2 : 1))) * 0.001f;
#endif
#ifdef PROBE_CLK
        if (L == PROBE_CLK && blockIdx.x == 0 && threadIdx.x == 0) { const unsigned long long t1_ = __builtin_amdgcn_s_memtime(), r1_ = __builtin_amdgcn_s_memrealtime(); ((float*)(ws + WS_GQK))[300] = (float)(t1_ - t0_) / (float)(r1_ - r0_) * 0.1f; ((float*)(ws + WS_GQK))[301] = (float)(r1_ - r0_) * 0.01f; }
#endif
        SEAM(pb + 2);
    }
    if (KIND(6) && IN(pb + 3)) { pg8::Gemm g{O, (const bf16*)(ws + (L == 0 ? WS_WAO : WS_WBO)), M, DM, DM}; pg8::StaticOrder S; S.init(M, DM, F.G, (int)blockIdx.x);
        pg8::EpiResid<true> E{xin, out, modL + 2 * DM, args.in[5] + L * DM, modL + 4 * DM, H, stat, escr};
        pg8::gemm_phase<pg8::EpiResid<true>, pg8::StaticOrder, true, true>(F.lds, g, S, E);
        SEAM(pb + 3); }
    if (KIND(8) && IN(pb + 4)) { pg8::Gemm g{H, (const bf16*)(ws + (L == 0 ? WS_WIN0 : WS_WIN1)), M, 2 * DFF, DM}; pg8::StaticOrder S; S.init(M, 2 * DFF, F.G, (int)blockIdx.x);
        pg8::EpiSwiglu E{ACT, DFF, stat, biasb + (L == 0 ? 0 : 4 * 2 * DFF + 4 * 1536)};
        REP(8) pg8::gemm_phase<pg8::EpiSwiglu, pg8::StaticOrder, true, true>(F.lds, g, S, E);
        SEAM(pb + 4); }
    if (KIND(9) && IN(pb + 5)) { pg8::Gemm g{ACT, (const bf16*)(ws + (L == 0 ? WS_WOUT0 : WS_WOUT1)), M, DM, DFF}; pg8::StaticOrder S; S.init(M, DM, F.G, (int)blockIdx.x);
        if constexpr (L == 0) { pg8::EpiResid<true> E{out, out, modL + 5 * DM, args.in[4] + DM, modL + (size_t)BATCH * MODW + DM, H, stat, escr};
            pg8::gemm_phase<pg8::EpiResid<true>, pg8::StaticOrder, true, true>(F.lds, g, S, E); }
        else { pg8::EpiResid<false> E{out, out, modL + 5 * DM, nullptr, nullptr, nullptr, nullptr, escr};
            pg8::gemm_phase<pg8::EpiResid<false>, pg8::StaticOrder, true, true>(F.lds, g, S, E); }
        SEAM(pb + 5); }
}

__global__ void __launch_bounds__(NWAVES * 64, 2) mk_fwd(Args args) {
    extern __shared__ __attribute__((aligned(16))) unsigned char lds[];
    Frame F;
    F.lds = (LAS unsigned char*)lds;
    F.MISC = (volatile LAS unsigned*)(F.lds + MISC_OFF);
    F.tid = threadIdx.x; F.lane = F.tid & 63; F.wave = __builtin_amdgcn_readfirstlane(F.tid >> 6);
    F.G = gridDim.x; { const int bx = blockIdx.x; F.vcu = (F.G % 8 == 0) ? (bx % 8) * (F.G / 8) + bx / 8 : bx; }
    if (F.tid < 32) F.MISC[F.tid] = 0u;
    __syncthreads();
    const int lo = args.ph_lo, hi = args.ph_hi;
    XcdBarrier bar; bar.bar = (unsigned*)(args.ws + WS_CTL); bar.x = 0; bar.st = nullptr;
    if (USE_BAR) bar = xcd_barrier_post((unsigned*)(args.ws + WS_CTL), F.MISC + 8);
    if (KIND(0) && IN(0)) { REP(0) { p0_prologue(F, args); __syncthreads(); } SEAM(0); }
    layer_phases<0>(F, args, lo, hi, bar);
    layer_phases<1>(F, args, lo, hi, bar);
    if (KIND(10) && IN(12)) { refresh(F); final_norm(F, args.out, args.in[19]);
#if defined(PROBE_CLK) || defined(PROBE_T)
        if (F.vcu == 0) { __syncthreads(); if (threadIdx.x == 0) { args.out[0] += 0.05f * ((const float*)(args.ws + WS_GQK))[300]; } }
#endif
    }
}
#undef IN
#undef SEAM

extern "C" void kernel_launch(void* const* d_in, const int* in_sizes, int n_in, void* d_out, int out_size, void* d_ws, size_t ws_size, hipStream_t stream) {
    static int grid = 0;
    if (grid == 0) {
        if (n_in != 20 || in_sizes[0] != M * DM || out_size != M * DM || ws_size < WS_END) { fprintf(stderr, "kernel_launch: unexpected shapes (n_in %d, in0 %d, out %d, ws %zu)\n", n_in, n_in > 0 ? in_sizes[0] : -1, out_size, ws_size); grid = -1; return; }
        int dev = 0, cus = 0, per_cu = 0;
        if (hipGetDevice(&dev) != hipSuccess || hipDeviceGetAttribute(&cus, hipDeviceAttributeMultiprocessorCount, dev) != hipSuccess) { grid = -1; return; }
        if (hipFuncSetAttribute((const void*)mk_fwd, hipFuncAttributeMaxDynamicSharedMemorySize, LDS_BYTES) != hipSuccess) { fprintf(stderr, "kernel_launch: hipFuncSetAttribute failed\n"); grid = -1; return; }
        if (hipOccupancyMaxActiveBlocksPerMultiprocessor(&per_cu, (const void*)mk_fwd, NWAVES * 64, LDS_BYTES) != hipSuccess || per_cu < 1) { fprintf(stderr, "kernel_launch: occupancy query says %d blocks per CU\n", per_cu); grid = -1; (void)hipGetLastError(); return; }
        grid = cus;
    }
    if (grid < 0) return;
    if (hipMemsetAsync((char*)d_ws + WS_CTL, 0, CTL_ZERO_BYTES, stream) != hipSuccess) return;
    Args a{};
    for (int i = 0; i < 20; ++i) a.in[i] = (const float*)d_in[i];
    a.out = (float*)d_out; a.ws = (unsigned char*)d_ws;
    constexpr int NL = MK_N_LAUNCHES;
    for (int li = 0; li < NL; ++li) {
        a.ph_lo = li * NPHASE / NL; a.ph_hi = (li + 1) * NPHASE / NL;
        hipLaunchKernelGGL(mk_fwd, dim3(grid), dim3(NWAVES * 64), LDS_BYTES, stream, a);
        const hipError_t le = hipPeekAtLastError();
        if (le != hipSuccess) { fprintf(stderr, "kernel_launch: launch %d failed: %s\n", li, hipGetErrorName(le)); break; }
    }
}
```
